# Optimizing an MI355X kernel written in HIP

```python
import math
import jax, jax.numpy as jnp
from jax import lax
import numpy as np

D_MODEL = 1024
BATCH = 8
SEQ = 4096
DEPTH = 1

GRID_W = 64
HEAD_DIM = 64
N_Q_HEADS = 8
N_KV_HEADS = 2
GQA_GROUP = N_Q_HEADS // N_KV_HEADS
ATTN_W = N_Q_HEADS * HEAD_DIM
KV_W = N_KV_HEADS * HEAD_DIM
Q_BLOCK = 128
ROPE_THETA = 10000.0
SSD_HEAD_DIM = 64
SSD_HEADS = 8
SSD_W = SSD_HEADS * SSD_HEAD_DIM
SSD_GROUPS = 2
HEADS_PER_GROUP = SSD_HEADS // SSD_GROUPS
D_STATE = 64
D_CONV = 7
CONV_CH = SSD_W + 2 * SSD_GROUPS * D_STATE
CHUNK = 128
SPLIT_SIZES = (ATTN_W, KV_W, KV_W, SSD_W, CONV_CH, 2 * SSD_HEADS, 2 * D_MODEL)
IN_PROJ = sum(SPLIT_SIZES)
N_EXPERT_GROUPS = 4
EXPERTS_PER_GROUP = 4
N_EXPERTS = N_EXPERT_GROUPS * EXPERTS_PER_GROUP
TOP_K_IN_GROUP = 2
D_EXPERT = 512
EPS = 1e-6

kernel_name = "hybrid_gqa_ssd_hiermoe_block"


def rmsnorm(x, w):
    xf = x.astype(jnp.float32)
    xf = xf * lax.rsqrt(jnp.mean(xf * xf, axis=-1, keepdims=True) + EPS)
    return xf.astype(x.dtype) * w


def rotate_half(u):
    u1, u2 = jnp.split(u, 2, axis=-1)
    return jnp.concatenate([-u2, u1], axis=-1)


def axial_rope_tables(seq_len, dtype):
    rows = seq_len // GRID_W
    row = jnp.repeat(jnp.arange(rows, dtype=jnp.int32), GRID_W)
    col = jnp.tile(jnp.arange(GRID_W, dtype=jnp.int32), rows)
    half = HEAD_DIM // 2
    inv_freq = ROPE_THETA ** (-jnp.arange(0, half, 2, dtype=jnp.float32) / half)
    ang_r = row.astype(jnp.float32)[:, None] * inv_freq[None, :]
    ang_c = col.astype(jnp.float32)[:, None] * inv_freq[None, :]
    cos = jnp.concatenate([jnp.cos(ang_r), jnp.cos(ang_r), jnp.cos(ang_c), jnp.cos(ang_c)], axis=-1)
    sin = jnp.concatenate([jnp.sin(ang_r), jnp.sin(ang_r), jnp.sin(ang_c), jnp.sin(ang_c)], axis=-1)
    return cos.astype(dtype), sin.astype(dtype)


def apply_axial_rope(x, cos, sin):
    xr, xc = jnp.split(x, 2, axis=-1)
    rot = jnp.concatenate([rotate_half(xr), rotate_half(xc)], axis=-1)
    return x * cos[None, :, None, :] + rot * sin[None, :, None, :]


def gqa_attention(q, k, v, q_norm_w, k_norm_w, cos, sin):
    b, s = q.shape[0], q.shape[1]
    q = apply_axial_rope(rmsnorm(q, q_norm_w), cos, sin)
    k = apply_axial_rope(rmsnorm(k, k_norm_w), cos, sin)
    scale = 1.0 / math.sqrt(HEAD_DIM)
    nb = s // Q_BLOCK
    qb = jnp.moveaxis(q.reshape(b, nb, Q_BLOCK, N_KV_HEADS, GQA_GROUP, HEAD_DIM), 1, 0)

    def one_block(qblk):
        scores = jnp.einsum('bqkgd,bskd->bkgqs', qblk, k).astype(jnp.float32) * scale
        p = jax.nn.softmax(scores, axis=-1).astype(v.dtype)
        return jnp.einsum('bkgqs,bskd->bqkgd', p, v)

    o = lax.map(one_block, qb)
    return jnp.moveaxis(o, 0, 1).reshape(b, s, ATTN_W)


def depthwise_centred_conv(u, w, bias):
    pad = (D_CONV - 1) // 2
    y = lax.conv_general_dilated(u, w[:, None, :], window_strides=(1,), padding=[(pad, pad)],
                                 dimension_numbers=('NWC', 'WIO', 'NWC'),
                                 feature_group_count=u.shape[-1])
    return y + bias


def ssd_chunked(x, dt, a, bm, cm):
    b, L, h, p = x.shape
    n = bm.shape[-1]
    c = L // CHUNK
    xc = x.reshape(b, c, CHUNK, h, p)
    dtc = dt.reshape(b, c, CHUNK, h)
    bc = bm.reshape(b, c, CHUNK, h, n)
    cc = cm.reshape(b, c, CHUNK, h, n)
    a_cum = jnp.cumsum(dtc * a, axis=2)
    seg = a_cum[:, :, :, None, :] - a_cum[:, :, None, :, :]
    tril = jnp.tril(jnp.ones((CHUNK, CHUNK), dtype=bool))[None, None, :, :, None]
    decay = jnp.exp(jnp.where(tril, seg, -jnp.inf))
    xdt = xc * dtc[..., None]
    cb = jnp.einsum('bcihn,bcjhn->bcijh', cc, bc)
    y_diag = jnp.einsum('bcijh,bcjhp->bcihp', cb * decay, xdt)
    decay_to_end = jnp.exp(a_cum[:, :, -1:, :] - a_cum)
    states = jnp.einsum('bcjhn,bcjhp->bchpn', bc * decay_to_end[..., None], xdt)
    chunk_decay = jnp.exp(a_cum[:, :, -1, :])

    def step(carry, inp):
        s_c, d_c = inp
        return carry * d_c[:, :, None, None] + s_c, carry

    h0 = jnp.zeros((b, h, p, n), dtype=x.dtype)
    _, states_in = lax.scan(step, h0, (jnp.moveaxis(states, 1, 0), jnp.moveaxis(chunk_decay, 1, 0)))
    states_in = jnp.moveaxis(states_in, 0, 1)
    y_off = jnp.einsum('bcihn,bchpn->bcihp', cc, states_in) * jnp.exp(a_cum)[..., None]
    return (y_diag + y_off).reshape(b, L, h, p)


def bidirectional_ssd(z, xbc, dt_raw, conv_w, conv_b, dt_bias, a_log, d_skip, norm_w):
    b, s = xbc.shape[0], xbc.shape[1]
    xbc = jax.nn.silu(depthwise_centred_conv(xbc, conv_w, conv_b))
    xs, bm, cm = jnp.split(xbc, [SSD_W, SSD_W + SSD_GROUPS * D_STATE], axis=-1)
    f32 = jnp.float32
    xs = xs.reshape(b, s, SSD_HEADS, SSD_HEAD_DIM).astype(f32)
    bm = jnp.repeat(bm.reshape(b, s, SSD_GROUPS, D_STATE), HEADS_PER_GROUP, axis=2).astype(f32)
    cm = jnp.repeat(cm.reshape(b, s, SSD_GROUPS, D_STATE), HEADS_PER_GROUP, axis=2).astype(f32)
    dt = jax.nn.softplus(dt_raw.reshape(b, s, 2, SSD_HEADS).astype(f32) + dt_bias.astype(f32))
    a = -jnp.exp(a_log.astype(f32))
    y_fwd = ssd_chunked(xs, dt[:, :, 0], a[0], bm, cm)
    flip = lambda u: jnp.flip(u, axis=1)
    y_bwd = flip(ssd_chunked(flip(xs), flip(dt[:, :, 1]), a[1], flip(bm), flip(cm)))
    y = y_fwd + y_bwd + d_skip.astype(f32)[None, None, :, None] * xs
    y = y.reshape(b, s, SSD_W).astype(z.dtype)
    return rmsnorm(y * jax.nn.silu(z), norm_w)


def hierarchical_moe(h, w_rg, b_rg, w_re, b_re, w1, w3, w2):
    b, s, d = h.shape
    t = h.reshape(b * s, d)
    p_group = jax.nn.softmax((t @ w_rg + b_rg).astype(jnp.float32), axis=-1)
    g_val, g_idx = lax.top_k(p_group, 1)
    fine = (t @ w_re + b_re).astype(jnp.float32).reshape(-1, N_EXPERT_GROUPS, EXPERTS_PER_GROUP)
    fine_sel = jnp.take_along_axis(fine, g_idx[:, :, None], axis=1)[:, 0]
    e_val, e_idx = lax.top_k(jax.nn.softmax(fine_sel, axis=-1), TOP_K_IN_GROUP)
    e_val = e_val / jnp.sum(e_val, axis=-1, keepdims=True)
    within = jnp.sum(jax.nn.one_hot(e_idx, EXPERTS_PER_GROUP, dtype=jnp.float32) * e_val[..., None], axis=1)
    combine = (jax.nn.one_hot(g_idx[:, 0], N_EXPERT_GROUPS, dtype=jnp.float32)[:, :, None]
               * within[:, None, :] * g_val[:, :, None]).reshape(-1, N_EXPERTS).astype(t.dtype)
    out = jnp.zeros_like(t)
    for e in range(N_EXPERTS):
        y_e = (jax.nn.silu(t @ w1[e]) * (t @ w3[e])) @ w2[e]
        out = out + combine[:, e:e + 1] * y_e
    return out.reshape(b, s, d)


def setup_inputs(seed: int = 0) -> dict:
    key = jax.random.key(seed)
    ks = jax.random.split(key, 24)
    f32 = jnp.float32
    L = DEPTH

    def nrm(k, shape, fan_in):
        return jax.random.normal(k, shape, f32) * (fan_in ** -0.5)

    def gain(k, shape):
        return 1.0 + 0.02 * jax.random.normal(k, shape, f32)

    dt0 = jnp.exp(jax.random.uniform(ks[9], (L, 2, SSD_HEADS), f32, math.log(1e-3), math.log(1e-1)))
    dt_bias = dt0 + jnp.log(-jnp.expm1(-dt0))
    return {
        "x": jax.random.normal(ks[0], (BATCH, SEQ, D_MODEL), f32),
        "norm_mix_w": gain(ks[1], (L, D_MODEL)),
        "w_in": nrm(ks[2], (L, D_MODEL, IN_PROJ), D_MODEL),
        "b_gate": 0.02 * jax.random.normal(ks[3], (L, 2 * D_MODEL), f32),
        "q_norm_w": gain(ks[4], (L, HEAD_DIM)),
        "k_norm_w": gain(ks[5], (L, HEAD_DIM)),
        "w_attn_o": nrm(ks[6], (L, ATTN_W, D_MODEL), ATTN_W),
        "conv_w": nrm(ks[7], (L, D_CONV, CONV_CH), D_CONV),
        "conv_b": 0.02 * jax.random.normal(ks[8], (L, CONV_CH), f32),
        "dt_bias": dt_bias,
        "a_log": jnp.log(jax.random.uniform(ks[10], (L, 2, SSD_HEADS), f32, 1.0, 16.0)),
        "d_skip": 1.0 + 0.1 * jax.random.normal(ks[11], (L, SSD_HEADS), f32),
        "ssd_norm_w": gain(ks[12], (L, SSD_W)),
        "w_ssd_o": nrm(ks[13], (L, SSD_W, D_MODEL), SSD_W),
        "w_out": nrm(ks[14], (L, D_MODEL, D_MODEL), D_MODEL),
        "norm_ffn_w": gain(ks[15], (L, D_MODEL)),
        "w_router_group": nrm(ks[16], (L, D_MODEL, N_EXPERT_GROUPS), D_MODEL),
        "b_router_group": 0.01 * jax.random.normal(ks[17], (L, N_EXPERT_GROUPS), f32),
        "w_router_expert": nrm(ks[18], (L, D_MODEL, N_EXPERTS), D_MODEL),
        "b_router_expert": 0.01 * jax.random.normal(ks[19], (L, N_EXPERTS), f32),
        "w1": nrm(ks[20], (L, N_EXPERTS, D_MODEL, D_EXPERT), D_MODEL),
        "w3": nrm(ks[21], (L, N_EXPERTS, D_MODEL, D_EXPERT), D_MODEL),
        "w2": nrm(ks[22], (L, N_EXPERTS, D_EXPERT, D_MODEL), D_EXPERT),
    }


def reference(x, norm_mix_w, w_in, b_gate, q_norm_w, k_norm_w, w_attn_o, conv_w, conv_b,
              dt_bias, a_log, d_skip, ssd_norm_w, w_ssd_o, w_out, norm_ffn_w,
              w_router_group, b_router_group, w_router_expert, b_router_expert, w1, w3, w2):
    b, s, _ = x.shape
    cos, sin = axial_rope_tables(s, x.dtype)
    split_at = [int(v) for v in np.cumsum(SPLIT_SIZES)[:-1]]
    for l in range(DEPTH):
        h = rmsnorm(x, norm_mix_w[l])
        proj = h @ w_in[l]
        q, k, v, z, xbc, dt_raw, gates = jnp.split(proj, split_at, axis=-1)
        q = q.reshape(b, s, N_Q_HEADS, HEAD_DIM)
        k = k.reshape(b, s, N_KV_HEADS, HEAD_DIM)
        v = v.reshape(b, s, N_KV_HEADS, HEAD_DIM)
        attn = gqa_attention(q, k, v, q_norm_w[l], k_norm_w[l], cos, sin)
        ssd = bidirectional_ssd(z, xbc, dt_raw, conv_w[l], conv_b[l], dt_bias[l],
                                a_log[l], d_skip[l], ssd_norm_w[l])
        g_attn, g_ssd = jnp.split(jax.nn.sigmoid(gates + b_gate[l]), 2, axis=-1)
        merged = g_attn * (attn @ w_attn_o[l]) + g_ssd * (ssd @ w_ssd_o[l])
        x = x + merged @ w_out[l]
        h2 = rmsnorm(x, norm_ffn_w[l])
        x = x + hierarchical_moe(h2, w_router_group[l], b_router_group[l], w_router_expert[l],
                                 b_router_expert[l], w1[l], w3[l], w2[l])
    return x
```

```cpp
#include <hip/hip_runtime.h>
#include <hip/hip_cooperative_groups.h>
#include <cstdio>
#include <cstdint>
namespace cg = cooperative_groups;

#ifndef ONE_LAUNCH
#define ONE_LAUNCH 0
#endif

__device__ __forceinline__ int tid_opaque() { int t = threadIdx.x; asm volatile("" : "+v"(t)); return t; }
#ifndef USE_PG8
#define USE_PG8 1
#endif
#ifndef MOE2_SPLIT_TAIL
#define MOE2_SPLIT_TAIL 1
#endif
#ifndef W13_IN_WOUT
#define W13_IN_WOUT 1
#endif
#ifndef FUSE_GATHER
#define FUSE_GATHER 1
#endif
typedef unsigned short bf16_t;
typedef short bf16x8 __attribute__((ext_vector_type(8)));
typedef float f32x4 __attribute__((ext_vector_type(4)));
typedef float f32x16 __attribute__((ext_vector_type(16)));
typedef unsigned u32x4 __attribute__((ext_vector_type(4)));
typedef unsigned u32x2 __attribute__((ext_vector_type(2)));

constexpr int BATCH = 8, SEQ = 4096, DM = 1024, T = BATCH * SEQ;
constexpr int NQH = 8, NKVH = 2, HD = 64, ATTN_W = 512, KV_W = 128;
constexpr int SSD_W = 512, SSD_H = 8, SSD_G = 2, DSTATE = 64, DCONV = 7, CONV_CH = 768, CHUNK = 128, NCHUNK = SEQ / CHUNK;
constexpr int IN_PROJ = 4112, NPROJ = 4352;
constexpr int NE = 16, NG = 4, EPG = 4, DE = 512;
constexpr int NBUCKET = 24;
constexpr int TS = T + NBUCKET * 256;
constexpr int NRT = T / 128;
constexpr float EPS = 1e-6f;
constexpr float C2 = 0.125f * 1.4426950408889634f;

constexpr size_t MiB = 1u << 20;
constexpr size_t al(size_t x) { return (x + 255) & ~(size_t)255; }
constexpr size_t WS_CTL = 0;
constexpr size_t WS_WIN = 1 * MiB;
constexpr size_t WS_WA = WS_WIN + al((size_t)NPROJ * DM * 2);
constexpr size_t WS_WS = WS_WA + al((size_t)DM * 512 * 2);
constexpr size_t WS_WO = WS_WS + al((size_t)DM * 512 * 2);
constexpr size_t WS_W13 = WS_WO + al((size_t)DM * DM * 2);
constexpr size_t WS_W2P = WS_W13 + al((size_t)NE * 1024 * DM * 2);
constexpr size_t WS_H = WS_W2P + al((size_t)NBUCKET * DM * 1024 * 2);
constexpr size_t WS_YD = WS_H;
constexpr size_t WS_CC = WS_H + (size_t)T * 512 * 2;
constexpr size_t WS_QO = WS_H + al((size_t)T * DM * 2);
constexpr size_t WS_XBC = WS_QO + al((size_t)T * 512 * 2);
constexpr size_t WS_SSD = WS_XBC;
constexpr size_t WS_K = WS_XBC + al((size_t)T * 768 * 2);
constexpr size_t WS_V = WS_K + al((size_t)T * 128 * 2);
constexpr size_t WS_Z = WS_V + al((size_t)T * 128 * 2);
constexpr size_t WS_G = WS_Z + al((size_t)T * 512 * 2);
constexpr size_t WS_HID = WS_G;
constexpr size_t WS_X1B = WS_QO;
constexpr size_t WS_DT = WS_G + al((size_t)T * 2048 * 2);
constexpr size_t WS_ACUM = WS_DT + al((size_t)T * 16 * 4);
constexpr size_t WS_ROUTE = WS_ACUM + al((size_t)T * 16 * 4);
constexpr size_t WS_ST = WS_ROUTE + 2 * MiB;
constexpr size_t WS_MERGED = WS_ST;
constexpr size_t WS_XS = WS_ST;
constexpr size_t WS_END = WS_ST + al((size_t)TS * DM * 2);
static_assert((size_t)2 * BATCH * NCHUNK * 8 * 64 * 64 * 4 <= (size_t)TS * DM * 2, "ST fits in the XS region");
static_assert(WS_END <= (size_t)512 * MiB, "workspace map exceeds 512 MiB");
static_assert(WS_X1B + (size_t)T * DM * 2 <= WS_G, "x1 (bf16) overlay");
constexpr size_t RT_BUCKET = 0;
constexpr size_t RT_RANK = RT_BUCKET + (size_t)T * 4;
constexpr size_t RT_WA = RT_RANK + (size_t)T * 4;
constexpr size_t RT_WB = RT_WA + (size_t)T * 4;
constexpr size_t RT_CNT = RT_WB + (size_t)T * 4;
constexpr size_t RT_PERM = RT_CNT + al((size_t)NRT * NBUCKET * 4);
constexpr size_t RT_TB = RT_PERM + al((size_t)TS * 4);
constexpr size_t RT_SWA = RT_TB + 1024;
constexpr size_t RT_SWB = RT_SWA + al((size_t)TS * 4);
constexpr size_t RT_WRT = RT_SWB + al((size_t)TS * 4);
constexpr size_t RT_RSTD = RT_WRT + al((size_t)32 * DM * 2);
constexpr size_t RT_SRS = RT_RSTD + al((size_t)T * 4);
static_assert(RT_SRS + al((size_t)TS * 4) <= 2 * MiB, "routing records");
static_assert(RT_WRT + 65536 <= 2 * MiB, "routing records");

struct Params {
    const float *x, *norm_mix_w, *w_in, *b_gate, *q_norm_w, *k_norm_w, *w_attn_o, *conv_w, *conv_b, *dt_bias, *a_log, *d_skip, *ssd_norm_w, *w_ssd_o, *w_out,
        *norm_ffn_w, *w_rg, *b_rg, *w_re, *b_re, *w1, *w3, *w2;
    float* out; unsigned char* ws;
};

__device__ __forceinline__ unsigned f2bf(float f) { unsigned u = __builtin_bit_cast(unsigned, f); return (u + 0x7fffu + ((u >> 16) & 1u)) >> 16; }
__device__ __forceinline__ float bf2f(unsigned short b) { return __builtin_bit_cast(float, (unsigned)b << 16); }
__device__ __forceinline__ unsigned pk2(float lo, float hi) { return f2bf(lo) | (f2bf(hi) << 16); }
template <int CTRL> __device__ __forceinline__ float dpp_f(float v) { return __builtin_bit_cast(float, __builtin_amdgcn_update_dpp(0, __builtin_bit_cast(int, v), CTRL, 0xf, 0xf, false)); }
__device__ __forceinline__ float row16_sum(float v) { v += dpp_f<0x121>(v); v += dpp_f<0x122>(v); v += dpp_f<0x124>(v); v += dpp_f<0x128>(v); return v; }
__device__ __forceinline__ float half32_sum(float v) { v = row16_sum(v); const unsigned u = __builtin_bit_cast(unsigned, v);
    auto rr = __builtin_amdgcn_permlane16_swap(u, u, false, false); return __builtin_bit_cast(float, (unsigned)rr[0]) + __builtin_bit_cast(float, (unsigned)rr[1]); }
__device__ __forceinline__ float wave_sum(float v) { v = half32_sum(v); const unsigned u = __builtin_bit_cast(unsigned, v);
    auto rr = __builtin_amdgcn_permlane32_swap(u, u, false, false); return __builtin_bit_cast(float, (unsigned)rr[0]) + __builtin_bit_cast(float, (unsigned)rr[1]); }
__device__ __forceinline__ float silu_f(float v) { return v / (1.f + __expf(-v)); }
__device__ __forceinline__ float sigmoid_f(float v) { return 1.f / (1.f + __expf(-v)); }
__device__ __forceinline__ float softplus_f(float v) { return v > 20.f ? v : log1pf(__expf(v)); }

template <class T_> __device__ __forceinline__ T_* wsp(const Params& p, size_t off) { return (T_*)(p.ws + off); }

namespace gm2 {
#define PG8_LAS __attribute__((address_space(3)))
constexpr int BM = 256, BK = 64, TILE_B = BM * BK * 2, STAGE_B = 2 * TILE_B, LDS_NEED = 2 * STAGE_B;
__device__ __forceinline__ int lds_byte(int r, int c) { const int st = (r >> 4) * 2 + (c >> 5), ob = (r & 15) * 64 + (c & 31) * 2; return st * 1024 + (ob ^ (((ob >> 9) & 1) << 5)); }
__device__ __forceinline__ void stage_rc(int b, int& R, int& C) { const int st = b >> 10, sb = b & 1023, swz = sb ^ (((sb >> 9) & 1) << 5); R = (st >> 1) * 16 + swz / 64; C = (st & 1) * 32 + (swz % 64) / 2; }
__device__ __forceinline__ int perm32(int rho) { const int n = rho >> 4, i = rho & 15; return 8 * (i >> 2) + 4 * n + (i & 3); }
struct Unit { int pm, pn, aux; };
typedef float f32x2_t __attribute__((ext_vector_type(2))); typedef __bf16 bf16x2_t __attribute__((ext_vector_type(2)));
__device__ __forceinline__ unsigned cvt_pk_bf16(float lo, float hi) { f32x2_t v = {lo, hi}; bf16x2_t b = __builtin_convertvector(v, bf16x2_t); return __builtin_bit_cast(unsigned, b); }

template <class Epi, class Sched>
__device__ __forceinline__ void gemm_phase(PG8_LAS unsigned char* lds, const int K, const Sched& S, const Epi& E) {
    int tid_ = threadIdx.x; asm volatile("" : "+v"(tid_));
    const int tid = tid_, wid = __builtin_amdgcn_readfirstlane(tid >> 6), lane = tid & 63, wr = wid >> 2, wc = wid & 3, fr = lane & 15, fq = lane >> 4;
    const int nt = K / BK;
    unsigned voffA[4], voffB[4];
#pragma unroll
    for (int i = 0; i < 4; ++i) { int R, C; stage_rc(tid * 16 + i * 8192, R, C); const int Rb = Epi::PERM ? ((R & ~31) + perm32(R & 31)) : R;
        voffA[i] = (unsigned)(R * K + C) * 2u; voffB[i] = (unsigned)(Rb * K + C) * 2u; }
    const unsigned ldsw = (unsigned)wid * 1024u;
    const int aoff = lds_byte(wr * 128 + fr, fq * 8), boff = lds_byte(wc * 64 + fr, fq * 8);
#ifndef GM2_REGSTAGE
#define GM2_REGSTAGE 0
#endif
#if GM2_REGSTAGE
#define GM2_STAGE(buf, abase, bbase, kt) do { _Pragma("unroll") for (int _i = 0; _i < 4; ++_i) { \
        const u32x4 va_ = *(const u32x4*)((abase) + (size_t)(kt) * (BK * 2) + voffA[_i]); const u32x4 vb_ = *(const u32x4*)((bbase) + (size_t)(kt) * (BK * 2) + voffB[_i]); \
        *(PG8_LAS u32x4*)(lds + (buf) * STAGE_B + ldsw + _i * 8192 + lane * 16) = va_; *(PG8_LAS u32x4*)(lds + (buf) * STAGE_B + TILE_B + ldsw + _i * 8192 + lane * 16) = vb_; } } while (0)
#else
#define GM2_STAGE(buf, abase, bbase, kt) do { _Pragma("unroll") for (int _i = 0; _i < 4; ++_i) { \
        __builtin_amdgcn_global_load_lds((const unsigned*)((abase) + (size_t)(kt) * (BK * 2) + voffA[_i]), (PG8_LAS unsigned*)(lds + (buf) * STAGE_B + ldsw + _i * 8192), 16, 0, 0); \
        __builtin_amdgcn_global_load_lds((const unsigned*)((bbase) + (size_t)(kt) * (BK * 2) + voffB[_i]), (PG8_LAS unsigned*)(lds + (buf) * STAGE_B + TILE_B + ldsw + _i * 8192), 16, 0, 0); } } while (0)
#endif
#define GM2_WAIT_V0() asm volatile("s_waitcnt vmcnt(0)" ::: "memory")
    Unit cur, nxt;
    if (!S.next(0, cur)) return;
    const char* cA = S.abase(cur); const char* cB = S.bbase(cur);
    GM2_STAGE(0, cA, cB, 0); GM2_WAIT_V0(); __syncthreads();
    for (int ui = 0;; ++ui) {
        const bool has_next = S.next(ui + 1, nxt);
        const char* nA = has_next ? S.abase(nxt) : cA; const char* nB = has_next ? S.bbase(nxt) : cB;
        f32x4 acc[8][4];
#pragma unroll
        for (int m = 0; m < 8; ++m)
#pragma unroll
            for (int n = 0; n < 4; ++n) acc[m][n] = (f32x4){0.f, 0.f, 0.f, 0.f};
        for (int t = 0; t < nt; ++t) {
            const int cb = t & 1;
            if (t + 1 < nt) { GM2_STAGE(cb ^ 1, cA, cB, t + 1); }
            else if (has_next) { GM2_STAGE(cb ^ 1, nA, nB, 0); }
#pragma unroll
            for (int ks = 0; ks < 2; ++ks) {
                bf16x8 At[8], Bf[4];
#pragma unroll
                for (int n = 0; n < 4; ++n) Bf[n] = *(const PG8_LAS bf16x8*)(lds + cb * STAGE_B + TILE_B + boff + n * 2048 + ks * 1024);
#pragma unroll
                for (int m = 0; m < 8; ++m) At[m] = *(const PG8_LAS bf16x8*)(lds + cb * STAGE_B + aoff + m * 2048 + ks * 1024);
#pragma unroll
                for (int m = 0; m < 8; ++m)
#pragma unroll
                    for (int n = 0; n < 4; ++n) acc[m][n] = __builtin_amdgcn_mfma_f32_16x16x32_bf16(Bf[n], At[m], acc[m][n], 0, 0, 0);
                __builtin_amdgcn_sched_group_barrier(0x100, 6, 0);
#pragma unroll
                for (int m = 0; m < 6; ++m) { __builtin_amdgcn_sched_group_barrier(0x008, 4, 0); __builtin_amdgcn_sched_group_barrier(0x100, 1, 0); }
                __builtin_amdgcn_sched_group_barrier(0x008, 8, 0);
                __builtin_amdgcn_sched_barrier(0);
            }
            GM2_WAIT_V0(); __syncthreads();
        }
        { int fr2 = fr, fq2 = fq; asm volatile("" : "+v"(fr2), "+v"(fq2)); E(acc, cur, wr, wc, fr2, fq2); }
        if (!has_next) break;
        cur = nxt; cA = nA; cB = nB;
    }
#undef GM2_STAGE
#undef GM2_WAIT_V0
}

struct SchedProj {
    int vcu, G; const char* A; const char* B; size_t tstep;
    __device__ __forceinline__ bool next(int i, Unit& u) const { const int uid = vcu + i * G; if (uid >= 128 * 16) return false; u.pm = uid >> 4; u.pn = uid & 15; u.aux = 0; return true; }
    __device__ __forceinline__ const char* abase(const Unit& u) const { return A + (size_t)u.pm * tstep; }
    __device__ __forceinline__ const char* bbase(const Unit& u) const { return B + (size_t)u.pn * tstep; }
};
struct SchedMerged {
    int vcu, G; const char *A0, *A1, *B0, *B1; size_t tstep;
    __device__ __forceinline__ bool next(int i, Unit& u) const { const int tile = vcu + (i >> 1) * G; if (tile >= 512) return false; u.pm = tile >> 2; u.pn = tile & 3; u.aux = i & 1; return true; }
    __device__ __forceinline__ const char* abase(const Unit& u) const { return (u.aux ? A1 : A0) + (size_t)u.pm * tstep; }
    __device__ __forceinline__ const char* bbase(const Unit& u) const { return (u.aux ? B1 : B0) + (size_t)u.pn * tstep; }
};
struct SchedWout {
    int vcu, G; const char *A, *B; size_t tstep;
    __device__ __forceinline__ bool next(int i, Unit& u) const { const int tile = vcu + i * G; if (tile >= 512) return false; u.pm = tile >> 2; u.pn = tile & 3; u.aux = 0; return true; }
    __device__ __forceinline__ const char* abase(const Unit& u) const { return A + (size_t)u.pm * tstep; }
    __device__ __forceinline__ const char* bbase(const Unit& u) const { return B + (size_t)u.pn * tstep; }
};
__device__ __forceinline__ void pair_of2(int pidx, int& a, int& b) { a = pidx < 3 ? 0 : (pidx < 5 ? 1 : 2); b = pidx < 3 ? pidx + 1 : (pidx < 5 ? pidx - 1 : 3); }
struct SchedMoe1 {
    int vcu, G, ntile; const int* tbk; const char *A, *W13; size_t tstep;
    __device__ __forceinline__ bool next(int i, Unit& u) const { const int uid = vcu + i * G; if (uid >= ntile * 8) return false; u.pm = uid >> 3; u.pn = uid & 7; u.aux = __builtin_amdgcn_readfirstlane(tbk[u.pm]); return true; }
    __device__ __forceinline__ const char* abase(const Unit& u) const { return A + (size_t)u.pm * tstep; }
    __device__ __forceinline__ const char* bbase(const Unit& u) const { const int g = u.aux / 6; int a, b; pair_of2(u.aux % 6, a, b); const int e = g * 4 + (u.pn < 4 ? a : b);
        return W13 + ((size_t)e * 1024 + (size_t)(u.pn & 3) * 256) * (1024 * 2); }
};
struct SchedMoe2 {
    int vcu, G, ntile; const int* tbk; const char *A, *W2P; size_t tstep;
    __device__ __forceinline__ bool next(int i, Unit& u) const { const int uid = vcu + i * G; if (uid >= ntile * 4) return false; u.pm = uid >> 2; u.pn = uid & 3; u.aux = __builtin_amdgcn_readfirstlane(tbk[u.pm]); return true; }
    __device__ __forceinline__ const char* abase(const Unit& u) const { return A + (size_t)u.pm * tstep; }
    __device__ __forceinline__ const char* bbase(const Unit& u) const { return W2P + ((size_t)u.aux * 1024 + (size_t)u.pn * 256) * (1024 * 2); }
};

__device__ __forceinline__ float silu_e(float v) { return v * __builtin_amdgcn_rcpf(1.f + __builtin_amdgcn_exp2f(-1.4426950408889634f * v)); }
__device__ __forceinline__ float sigm_e(float v) { return __builtin_amdgcn_rcpf(1.f + __builtin_amdgcn_exp2f(-1.4426950408889634f * v)); }
__device__ __forceinline__ float bflo(unsigned w) { return __builtin_bit_cast(float, w << 16); }
__device__ __forceinline__ float bfhi(unsigned w) { return __builtin_bit_cast(float, w & 0xffff0000u); }
__device__ __forceinline__ u32x4 pack8(const f32x4& v0, const f32x4& v1) { u32x4 w; w.x = cvt_pk_bf16(v0[0], v0[1]); w.y = cvt_pk_bf16(v0[2], v0[3]); w.z = cvt_pk_bf16(v1[0], v1[1]); w.w = cvt_pk_bf16(v1[2], v1[3]); return w; }
__device__ __forceinline__ float softplus_e(float v) {
    const float e = __builtin_amdgcn_exp2f(1.4426950408889634f * fminf(v, 20.f));
    const float s = e * (1.f - e * (0.5f - e * 0.33333334f));
    const float l = 0.6931471805599453f * __builtin_amdgcn_logf(1.f + e);
    const float r = e < 0.03f ? s : l;
    return v > 20.f ? v : r;
}
struct EpiInProj {
    static constexpr bool PERM = true;
    unsigned char* ws; const float* b_gate;
    template <int LD, bool ACT> static __device__ __forceinline__ void store_plain(const f32x4 (&acc)[8][4], bf16_t* base, int row0) {
#pragma unroll
        for (int m = 0; m < 8; ++m) { bf16_t* rp = base + (size_t)(row0 + m * 16) * LD;
#pragma unroll
            for (int n2 = 0; n2 < 2; ++n2) { f32x4 v0 = acc[m][2 * n2], v1 = acc[m][2 * n2 + 1];
                if (ACT) {
#pragma unroll
                    for (int e = 0; e < 4; ++e) { v0[e] = silu_e(v0[e]); v1[e] = silu_e(v1[e]); } }
                *(u32x4*)(rp + n2 * 32) = pack8(v0, v1); }
            if (m & 1) asm volatile("" ::: "memory"); }
    }
    __device__ __forceinline__ void operator()(const f32x4 (&acc)[8][4], const Unit& u, int wr, int wc, int fr, int fq) const {
        const int row0 = u.pm * BM + wr * 128 + fr, pn = u.pn, lc = wc * 64 + 8 * fq;
        if (pn >= 8) {
            const int colt = (pn - 8) * BM + lc; bf16_t* G = (bf16_t*)(ws + WS_G);
            f32x4 bv[2][2];
#pragma unroll
            for (int n2 = 0; n2 < 2; ++n2) { bv[n2][0] = *(const f32x4*)(b_gate + colt + n2 * 32); bv[n2][1] = *(const f32x4*)(b_gate + colt + n2 * 32 + 4); }
#pragma unroll
            for (int m = 0; m < 8; ++m) { bf16_t* rp = G + (size_t)(row0 + m * 16) * 2048 + colt;
#pragma unroll
                for (int n2 = 0; n2 < 2; ++n2) { f32x4 v0 = acc[m][2 * n2] + bv[n2][0], v1 = acc[m][2 * n2 + 1] + bv[n2][1];
#pragma unroll
                    for (int e = 0; e < 4; ++e) { v0[e] = sigm_e(v0[e]); v1[e] = sigm_e(v1[e]); }
                    *(u32x4*)(rp + n2 * 32) = pack8(v0, v1); }
                if (m & 1) asm volatile("" ::: "memory"); }
        } else if (pn < 2) store_plain<512, false>(acc, (bf16_t*)(ws + WS_QO) + pn * BM + lc, row0);
        else if (pn == 2) { if (wc < 2) store_plain<128, false>(acc, (bf16_t*)(ws + WS_K) + lc, row0); else store_plain<128, false>(acc, (bf16_t*)(ws + WS_V) + (lc - 128), row0); }
        else if (pn < 5) store_plain<512, true>(acc, (bf16_t*)(ws + WS_Z) + (pn - 3) * BM + lc, row0);
        else store_plain<768, false>(acc, (bf16_t*)(ws + WS_XBC) + (pn - 5) * BM + lc, row0);
    }
};
struct EpiMerged {
    static constexpr bool PERM = true;
    const bf16_t* G; bf16_t* MG;
    __device__ __forceinline__ void operator()(const f32x4 (&acc)[8][4], const Unit& u, int wr, int wc, int fr, int fq) const {
        const int row0 = u.pm * BM + wr * 128 + fr, col0 = u.pn * BM + wc * 64 + 8 * fq, goff = u.aux ? 0 : 1024;
#pragma unroll
        for (int m = 0; m < 8; ++m) { const size_t row = (size_t)(row0 + m * 16);
#pragma unroll
            for (int n2 = 0; n2 < 2; ++n2) { const int col = col0 + n2 * 32;
                const u32x4 gv = *(const u32x4*)(G + row * 2048 + goff + col);
                f32x4 v0 = acc[m][2 * n2], v1 = acc[m][2 * n2 + 1];
                v0[0] *= bflo(gv.x); v0[1] *= bfhi(gv.x); v0[2] *= bflo(gv.y); v0[3] *= bfhi(gv.y); v1[0] *= bflo(gv.z); v1[1] *= bfhi(gv.z); v1[2] *= bflo(gv.w); v1[3] *= bfhi(gv.w);
                bf16_t* dst = MG + row * 1024 + col;
                if (u.aux) { const u32x4 ov = *(const u32x4*)dst;
                    v0[0] += bflo(ov.x); v0[1] += bfhi(ov.x); v0[2] += bflo(ov.y); v0[3] += bfhi(ov.y); v1[0] += bflo(ov.z); v1[1] += bfhi(ov.z); v1[2] += bflo(ov.w); v1[3] += bfhi(ov.w); }
                *(u32x4*)dst = pack8(v0, v1); }
            asm volatile("" ::: "memory"); }
    }
};
struct EpiWout {
    static constexpr bool PERM = false;
    const float* x; float* out;
    __device__ __forceinline__ void operator()(const f32x4 (&acc)[8][4], const Unit& u, int wr, int wc, int fr, int fq) const {
        const int row0 = u.pm * BM + wr * 128 + fr, col0 = u.pn * BM + wc * 64 + 4 * fq;
#pragma unroll
        for (int m = 0; m < 8; ++m) { const size_t off = (size_t)(row0 + m * 16) * 1024 + col0;
#pragma unroll
            for (int n = 0; n < 4; ++n) *(f32x4*)(out + off + n * 16) = *(const f32x4*)(x + off + n * 16) + acc[m][n];
            if (m & 1) asm volatile("" ::: "memory"); }
    }
};
struct EpiMoe1 {
    static constexpr bool PERM = true;
    bf16_t* HID; const float* SWA; const float* SWB;
    __device__ __forceinline__ void operator()(const f32x4 (&acc)[8][4], const Unit& u, int wr, int wc, int fr, int fq) const {
        const int row0 = u.pm * BM + wr * 128 + fr, slot = u.pn >> 2, hc = slot * 512 + (u.pn & 3) * 128 + 32 * wc + 4 * fq;
        const float* SW = slot ? SWB : SWA;
#pragma unroll
        for (int m = 0; m < 8; ++m) { const size_t row = (size_t)(row0 + m * 16); const float w = SW[row];
#pragma unroll
            for (int n2 = 0; n2 < 2; ++n2) { const f32x4 v0 = acc[m][2 * n2], v1 = acc[m][2 * n2 + 1];
                float h0 = w * silu_e(v0[0]) * v0[1], h1 = w * silu_e(v0[2]) * v0[3], h2 = w * silu_e(v1[0]) * v1[1], h3 = w * silu_e(v1[2]) * v1[3];
                if (w == 0.f) { h0 = 0.f; h1 = 0.f; h2 = 0.f; h3 = 0.f; }
                u32x2 o; o.x = cvt_pk_bf16(h0, h1); o.y = cvt_pk_bf16(h2, h3);
                *(u32x2*)(HID + row * 1024 + hc + 16 * n2) = o; } }
    }
};
struct EpiMoe2 {
    static constexpr bool PERM = false;
    float* out; const int* perm;
    __device__ __forceinline__ void operator()(const f32x4 (&acc)[8][4], const Unit& u, int wr, int wc, int fr, int fq) const {
        const int row0 = u.pm * BM + wr * 128 + fr, col0 = u.pn * BM + wc * 64 + 4 * fq;
#pragma unroll
        for (int m = 0; m < 8; ++m) { const int tok = perm[row0 + m * 16];
            if (tok >= 0) { float* op = out + (size_t)tok * 1024 + col0;
#pragma unroll
                for (int n = 0; n < 4; ++n) { f32x4* q = (f32x4*)(op + n * 16); *q = *q + acc[m][n]; } } }
    }
};
}


#define GAS __attribute__((address_space(1)))
#define LAS __attribute__((address_space(3)))
typedef GAS unsigned gu32;
#define RLX_AGENT __ATOMIC_RELAXED, __HIP_MEMORY_SCOPE_AGENT
constexpr int CW_BAR = 4096;
constexpr int MISC_OFF = 147456 - 256;
#define XB_TMO      128
#define XB_XCNT(j)  (256  + 64 * (j))
#define XB_XSUB(j)  (1280 + 64 * (j))
#define XB_XGEN(j)  (2304 + 64 * (j))
#define XB_TOP      3328
#define XB_TOPGEN   3392
#define XCD_BAR_WORDS 3456
#define XB_SPIN_CAP (1u << 18)

__device__ __forceinline__ unsigned xb_ld(unsigned* p)              { return __hip_atomic_load(p, __ATOMIC_RELAXED, __HIP_MEMORY_SCOPE_AGENT); }
__device__ __forceinline__ unsigned xb_add(unsigned* p, unsigned v) { return __hip_atomic_fetch_add(p, v, __ATOMIC_RELAXED, __HIP_MEMORY_SCOPE_AGENT); }
__device__ __forceinline__ unsigned xb_xcc_id() { return (unsigned)__builtin_amdgcn_s_getreg((3 << 11) | 20) & 0xFu; }
#define XB_SPIN(cond, bar) do { unsigned _sp = 0; while (cond) { __builtin_amdgcn_s_sleep(1); \
    if ((++_sp & 255u) == 0u) { if (xb_ld(&(bar)[XB_TMO])) break; if (_sp > XB_SPIN_CAP) { atomicAdd(&(bar)[XB_TMO], 1u); break; } } } } while (0)

struct XcdBarrier {
    unsigned* bar; unsigned x;
    volatile LAS unsigned* st;
};

__device__ __forceinline__ XcdBarrier xcd_barrier_post(unsigned* bar, volatile LAS unsigned* st) {
    XcdBarrier b; b.bar = bar; b.x = xb_xcc_id(); b.st = st;
    if (threadIdx.x == 0) (void)xb_add(&bar[XB_XCNT(b.x)], 1u);
    return b;
}
__device__ __forceinline__ void xcd_barrier_complete(unsigned* bar, unsigned x, unsigned& nloc, unsigned& nx) {
    const unsigned G = gridDim.x * gridDim.y * gridDim.z;
    unsigned sum, cnt, mine, sp = 0u;
    for (;;) {
        sum = 0u; cnt = 0u; mine = 0u;
#pragma unroll
        for (unsigned j = 0; j < 16; ++j) { const unsigned c = xb_ld(&bar[XB_XCNT(j)]); sum += c; cnt += (c > 0u) ? 1u : 0u; mine = (j == x) ? c : mine; }
        if (sum == G) break;
        __builtin_amdgcn_s_sleep(1);
        if ((++sp & 255u) == 0u) { if (xb_ld(&bar[XB_TMO])) break; if (sp > XB_SPIN_CAP) { atomicAdd(&bar[XB_TMO], 1u); break; } }
    }
    nloc = mine > 0u ? mine : 1u; nx = cnt > 0u ? cnt : 1u;
}

__device__ __forceinline__ void xcd_barrier(const XcdBarrier& b) {
    asm volatile("s_waitcnt vmcnt(0)" ::: "memory");
    __syncthreads();
    if (threadIdx.x == 0) {
        unsigned* bar = b.bar;
        __builtin_amdgcn_s_waitcnt(0);
        unsigned nloc = b.st[0], nx = b.st[1];
        if (nloc == 0u) { xcd_barrier_complete(bar, b.x, nloc, nx); b.st[0] = nloc; b.st[1] = nx; }
        const unsigned old = xb_add(&bar[XB_XSUB(b.x)], 1u);
        const unsigned gen = old / nloc;
        if (old + 1u == (gen + 1u) * nloc) {
            __builtin_amdgcn_fence(__ATOMIC_RELEASE, "agent");
            asm volatile("s_waitcnt vmcnt(0)" ::: "memory");
            const unsigned og = xb_add(&bar[XB_TOP], 1u);
            const unsigned tg = og / nx;
            if (og + 1u == (tg + 1u) * nx) xb_add(&bar[XB_TOPGEN], 1u);
            else XB_SPIN(xb_ld(&bar[XB_TOPGEN]) == tg, bar);
            __builtin_amdgcn_fence(__ATOMIC_ACQUIRE, "agent");
            xb_add(&bar[XB_XGEN(b.x)], 1u);
            asm volatile("s_waitcnt vmcnt(0)" ::: "memory");
        } else {
            XB_SPIN(xb_ld(&bar[XB_XGEN(b.x)]) == gen, bar);
            __builtin_amdgcn_fence(__ATOMIC_ACQUIRE, "agent");
            asm volatile("s_waitcnt vmcnt(0)" ::: "memory");
        }
    }
    __syncthreads();
}

struct TrJob { const float* W; int ldw, K, sc0, ncols; bf16_t* dst; int ldd, dr0, dstride, dk0; bf16_t* dst2; int dk2; bf16_t* dst3; int dk3; const float* ks = nullptr; };
__device__ __forceinline__ int tr_items(const TrJob& j) { return (j.K / 64) * ((j.ncols + 31) / 32); }
constexpr int tr_items_c(int K, int ncols) { return (K / 64) * ((ncols + 31) / 32); }
__device__ __forceinline__ void tr_item(const TrJob& j, int item, float* scr  , int lane) {
    const int nblk = (j.ncols + 31) / 32, kb = item / nblk, nb = item % nblk, k0 = 64 * kb, n0 = 32 * nb;
    const int nvalid = min(32, j.ncols - n0);
    {
        f32x4 v[8]; const int n4 = 4 * (lane & 7), kr = lane >> 3; const float* src = j.W + (size_t)(k0 + kr) * j.ldw + j.sc0 + n0 + (n4 < nvalid ? n4 : 0);
#pragma unroll
        for (int i = 0; i < 8; ++i) v[i] = *(const f32x4*)(src + (size_t)(8 * i) * j.ldw);
#pragma unroll
        for (int i = 0; i < 8; ++i) { float* d = scr + (8 * i + kr) * 33 + n4; d[0] = v[i][0]; d[1] = v[i][1]; d[2] = v[i][2]; d[3] = v[i][3]; }
    }
    __builtin_amdgcn_s_waitcnt(0xc07f); asm volatile("" ::: "memory");
    const int c = lane & 7;
    f32x4 ka = {1.f, 1.f, 1.f, 1.f}, kc = ka;
    if (j.ks) { ka = *(const f32x4*)(j.ks + k0 + 8 * c); kc = *(const f32x4*)(j.ks + k0 + 8 * c + 4); }
#pragma unroll
    for (int jj = 0; jj < 4; ++jj) { const int n = (lane >> 3) + 8 * jj; const float* s = scr + (8 * c) * 33 + n;
        u32x4 o; o.x = pk2(s[0 * 33] * ka[0], s[1 * 33] * ka[1]); o.y = pk2(s[2 * 33] * ka[2], s[3 * 33] * ka[3]); o.z = pk2(s[4 * 33] * kc[0], s[5 * 33] * kc[1]); o.w = pk2(s[6 * 33] * kc[2], s[7 * 33] * kc[3]);
        if (n < nvalid) { const size_t ro = (size_t)(j.dr0 + (n0 + n) * j.dstride) * j.ldd + k0 + 8 * c; *(u32x4*)(j.dst + ro + j.dk0) = o;
            if (j.dst2) *(u32x4*)(j.dst2 + ro + j.dk2) = o; if (j.dst3) *(u32x4*)(j.dst3 + ro + j.dk3) = o; } }
    __builtin_amdgcn_s_waitcnt(0xc07f); asm volatile("" ::: "memory");
}
__device__ __forceinline__ void pair_of(int pidx, int& a, int& b) {
    a = pidx < 3 ? 0 : (pidx < 5 ? 1 : 2); b = pidx < 3 ? pidx + 1 : (pidx < 5 ? pidx - 1 : 3);
}
constexpr int TR_WIN = 2064, TR_EARLY = 3088, TR_W2 = TR_EARLY + 32 * 256, TR_TOTAL = TR_W2 + 16 * 256;
__device__ __forceinline__ void tr_mkjob(const Params& p, int g, TrJob& j, int& it) {
    bf16_t* WinT = wsp<bf16_t>(p, WS_WIN);
    if (g < 1024) { it = g; j = TrJob{p.w_in, IN_PROJ, DM, 0, 2048, WinT, DM, 0, 1, 0, nullptr, 0, nullptr, 0}; }
    else if (g < 2048) { it = g - 1024; j = TrJob{p.w_in, IN_PROJ, DM, 2064, 2048, WinT, DM, 2048, 1, 0, nullptr, 0, nullptr, 0}; }
    else if (g < 2064) { it = g - 2048; j = TrJob{p.w_in, IN_PROJ, DM, 2048, 16, WinT, DM, 4096, 1, 0, nullptr, 0, nullptr, 0}; }
    else if (g < 2320) { it = g - 2064; j = TrJob{p.w_attn_o, DM, 512, 0, DM, wsp<bf16_t>(p, WS_WA), 512, 0, 1, 0, nullptr, 0, nullptr, 0}; }
    else if (g < 2576) { it = g - 2320; j = TrJob{p.w_ssd_o, DM, 512, 0, DM, wsp<bf16_t>(p, WS_WS), 512, 0, 1, 0, nullptr, 0, nullptr, 0}; }
    else if (g < TR_EARLY) { it = g - 2576; j = TrJob{p.w_out, DM, DM, 0, DM, wsp<bf16_t>(p, WS_WO), DM, 0, 1, 0, nullptr, 0, nullptr, 0}; }
    else { const int q = (g - TR_EARLY) >> 8, e = q & 15; it = (g - TR_EARLY) & 255;
        if (q < 16) j = TrJob{p.w1 + (size_t)e * DM * DE, DE, DM, 0, DE, wsp<bf16_t>(p, WS_W13) + (size_t)e * 1024 * DM, DM, 0, 2, 0, nullptr, 0, nullptr, 0, p.norm_ffn_w};
        else if (q < 32) j = TrJob{p.w3 + (size_t)e * DM * DE, DE, DM, 0, DE, wsp<bf16_t>(p, WS_W13) + (size_t)e * 1024 * DM, DM, 1, 2, 0, nullptr, 0, nullptr, 0, p.norm_ffn_w};
        else j = TrJob{p.w2 + (size_t)e * DE * DM, DM, DE, 0, DM, wsp<bf16_t>(p, WS_W2P) + (size_t)e * 1024 * 512, 512, 0, 1, 0, nullptr, 0, nullptr, 0}; }
}
static_assert(tr_items_c(DM, 2048) == 1024 && tr_items_c(DM, 16) == 16 && tr_items_c(512, DM) == 256 && tr_items_c(DM, DM) == 512 && tr_items_c(DM, DE) == 256 && tr_items_c(DE, DM) == 256, "item counts of the flat transpose table");
__device__ __forceinline__ void phase_tr_range(const Params& p, float* scr, int lane, int g0, int g1, int w, int nw) {
    for (int g = g0 + w; g < g1; g += nw) { TrJob j; int it; tr_mkjob(p, g, j, it); tr_item(j, it, scr, lane); }
}
__device__ __forceinline__ void phase_p0(const Params& p, unsigned char* lds) {
    const int tid = tid_opaque(), lane = tid & 63, wave = tid >> 6;
    float* scr = (float*)lds + wave * (64 * 33);
    const int gw = blockIdx.x * 8 + wave, NGW = gridDim.x * 8;
    bf16_t* WinT = wsp<bf16_t>(p, WS_WIN);
    phase_tr_range(p, scr, lane, 0, TR_WIN, gw, NGW);
    { bf16_t* WRT = (bf16_t*)(p.ws + WS_ROUTE + RT_WRT);
      for (int i = blockIdx.x * 512 + tid; i < 32 * DM; i += gridDim.x * 512) { const int n = i >> 10, k = i & 1023;
          const float v = n < 4 ? p.w_rg[k * 4 + n] : (n < 20 ? p.w_re[k * 16 + (n - 4)] : 0.f); WRT[i] = (bf16_t)f2bf(v * p.norm_ffn_w[k]); } }
    { u32x4 z = {0u, 0u, 0u, 0u}; u32x4* d = (u32x4*)(WinT + (size_t)4112 * DM); const int n16 = (NPROJ - 4112) * DM * 2 / 16;
      for (int i = blockIdx.x * 512 + tid; i < n16; i += gridDim.x * 512) d[i] = z; }
    bf16_t* H = wsp<bf16_t>(p, WS_H);
    {
        const f32x4* wr = (const f32x4*)p.norm_mix_w;
        f32x4 w4[4];
#pragma unroll
        for (int jj = 0; jj < 4; ++jj) w4[jj] = wr[2 * lane + (jj & 1) + 128 * (jj >> 1)];
        for (int m = gw; m + 3 * NGW < T; m += 4 * NGW) {
            f32x4 v[4][4];
#pragma unroll
            for (int r = 0; r < 4; ++r) { const f32x4* xr = (const f32x4*)(p.x + (size_t)(m + r * NGW) * DM);
#pragma unroll
                for (int jj = 0; jj < 4; ++jj) v[r][jj] = xr[2 * lane + (jj & 1) + 128 * (jj >> 1)]; }
            __builtin_amdgcn_sched_barrier(0);
#pragma unroll
            for (int r = 0; r < 4; ++r) { float s = 0.f;
#pragma unroll
                for (int jj = 0; jj < 4; ++jj) s += (v[r][jj].x * v[r][jj].x + v[r][jj].y * v[r][jj].y) + (v[r][jj].z * v[r][jj].z + v[r][jj].w * v[r][jj].w);
                const float rstd = 1.f / sqrtf(wave_sum(s) * (1.f / DM) + EPS);
                u32x4* o16 = (u32x4*)(H + (size_t)(m + r * NGW) * DM);
#pragma unroll
                for (int hf = 0; hf < 2; ++hf) { const f32x4 a = v[r][2 * hf], b = v[r][2 * hf + 1], wa = w4[2 * hf], wb = w4[2 * hf + 1];
                    o16[lane + 64 * hf] = (u32x4){pk2(a.x * rstd * wa.x, a.y * rstd * wa.y), pk2(a.z * rstd * wa.z, a.w * rstd * wa.w), pk2(b.x * rstd * wb.x, b.y * rstd * wb.y), pk2(b.z * rstd * wb.z, b.w * rstd * wb.w)}; } }
        }
    }
}

template <class AF, class BF, class Epi>
__device__ __forceinline__ void gemm_naive(int M, int N, int K, const AF& af, const BF& bf, const Epi& epi) {
    const int lane = threadIdx.x & 63, gw = blockIdx.x * 8 + (threadIdx.x >> 6), NGW = gridDim.x * 8;
    const int tn = N / 32, nt = (M / 32) * tn, r = lane & 31, h = lane >> 5;
    for (int t = gw; t < nt; t += NGW) {
        const int pm = t / tn, pn = t % tn;
        const bf16_t* a = af(pm * 32 + r) + 8 * h; const bf16_t* b = bf(pm * 32, pn * 32 + r) + 8 * h;
        f32x16 acc = {0.f, 0.f, 0.f, 0.f, 0.f, 0.f, 0.f, 0.f, 0.f, 0.f, 0.f, 0.f, 0.f, 0.f, 0.f, 0.f};
        for (int k = 0; k < K; k += 16) { const bf16x8 av = *(const bf16x8*)(a + k), bv = *(const bf16x8*)(b + k); acc = __builtin_amdgcn_mfma_f32_32x32x16_bf16(av, bv, acc, 0, 0, 0); }
#pragma unroll
        for (int i = 0; i < 16; ++i) epi(pm * 32 + (i & 3) + 8 * (i >> 2) + 4 * h, pn * 32 + r, acc[i]);
    }
}

__device__ __forceinline__ void phase_p1(const Params& p) {
    const bf16_t* H = wsp<bf16_t>(p, WS_H); const bf16_t* W = wsp<bf16_t>(p, WS_WIN);
    bf16_t *QO = wsp<bf16_t>(p, WS_QO), *Kb = wsp<bf16_t>(p, WS_K), *Vb = wsp<bf16_t>(p, WS_V), *Z = wsp<bf16_t>(p, WS_Z), *XBC = wsp<bf16_t>(p, WS_XBC), *G = wsp<bf16_t>(p, WS_G);
    float* DT = wsp<float>(p, WS_DT); const float* b_gate = p.b_gate; const float* dt_bias = p.dt_bias;
    auto af = [=](int row) { return H + (size_t)row * DM; };
    auto bf = [=](int, int col) { return W + (size_t)col * DM; };
    auto epi = [=](int row, int c, float v) {
        if (c < 512) QO[(size_t)row * 512 + c] = (bf16_t)f2bf(v);
        else if (c < 640) Kb[(size_t)row * 128 + (c - 512)] = (bf16_t)f2bf(v);
        else if (c < 768) Vb[(size_t)row * 128 + (c - 640)] = (bf16_t)f2bf(v);
        else if (c < 1280) Z[(size_t)row * 512 + (c - 768)] = (bf16_t)f2bf(silu_f(v));
        else if (c < 2048) XBC[(size_t)row * 768 + (c - 1280)] = (bf16_t)f2bf(v);
        else if (c < 4096) G[(size_t)row * 2048 + (c - 2048)] = (bf16_t)f2bf(sigmoid_f(v + b_gate[c - 2048]));
        else if (c < 4112) DT[(size_t)row * 16 + (c - 4096)] = softplus_f(v + dt_bias[c - 4096]);
    };
    gemm_naive(T, NPROJ, DM, af, bf, epi);
}

__device__ __forceinline__ void phase_dt(const Params& p) {
    const bf16_t* H = wsp<bf16_t>(p, WS_H); const bf16_t* W = wsp<bf16_t>(p, WS_WIN) + (size_t)4096 * DM;
    float* DT = wsp<float>(p, WS_DT); const float* dt_bias = p.dt_bias;
    const int lane = tid_opaque() & 63, gw = blockIdx.x * 8 + (tid_opaque() >> 6), NGW = gridDim.x * 8, r = lane & 31, h = lane >> 5;
    const float bias = dt_bias[r & 15];
    for (int t = gw; t < T / 32; t += NGW) {
        const bf16_t* a = H + (size_t)(t * 32 + r) * DM + 8 * h; const bf16_t* b = W + (size_t)r * DM + 8 * h;
        f32x16 acc = {0.f, 0.f, 0.f, 0.f, 0.f, 0.f, 0.f, 0.f, 0.f, 0.f, 0.f, 0.f, 0.f, 0.f, 0.f, 0.f};
#pragma unroll 1
        for (int k0 = 0; k0 < DM; k0 += 256) {
            bf16x8 av[16], bv[16];
#pragma unroll
            for (int u = 0; u < 16; ++u) { av[u] = *(const bf16x8*)(a + k0 + 16 * u); bv[u] = *(const bf16x8*)(b + k0 + 16 * u); }
            __builtin_amdgcn_sched_barrier(0);
#pragma unroll
            for (int u = 0; u < 16; ++u) acc = __builtin_amdgcn_mfma_f32_32x32x16_bf16(av[u], bv[u], acc, 0, 0, 0);
            __builtin_amdgcn_sched_barrier(0);
        }
        if (r < 16) {
#pragma unroll
            for (int i = 0; i < 16; ++i) { const int row = t * 32 + (i & 3) + 8 * (i >> 2) + 4 * h; DT[(size_t)row * 16 + r] = softplus_f(acc[i] + bias); }
        }
    }
}
__device__ __forceinline__ void phase_p1_check(const Params& p) {
    const bf16_t* H = wsp<bf16_t>(p, WS_H); const bf16_t* W = wsp<bf16_t>(p, WS_WIN);
    bf16_t *QO = wsp<bf16_t>(p, WS_QO), *Kb = wsp<bf16_t>(p, WS_K), *Vb = wsp<bf16_t>(p, WS_V), *Z = wsp<bf16_t>(p, WS_Z), *XBC = wsp<bf16_t>(p, WS_XBC), *G = wsp<bf16_t>(p, WS_G);
    float* DT = wsp<float>(p, WS_DT); const float* b_gate = p.b_gate; const float* dt_bias = p.dt_bias;
    unsigned* ctl = (unsigned*)(p.ws + WS_CTL);
    auto af = [=](int row) { return H + (size_t)row * DM; };
    auto bf = [=](int, int col) { return W + (size_t)col * DM; };
    auto cmp2 = [=](float got, float want, int type, int row, int c) { if (!(fabsf(got - want) <= 0.03f + 0.03f * fabsf(want))) { if (c < 4096) ctl[8192 + (row >> 8) * 16 + (c >> 8)] = 1u; } };
    #define cmp(g_, w_, t_) cmp2(g_, w_, t_, row, c)
    auto epi = [=](int row, int c, float v) {
        if (c < 512) cmp(bf2f(QO[(size_t)row * 512 + c]), v, 0);
        else if (c < 640) cmp(bf2f(Kb[(size_t)row * 128 + (c - 512)]), v, 1);
        else if (c < 768) cmp(bf2f(Vb[(size_t)row * 128 + (c - 640)]), v, 2);
        else if (c < 1280) cmp(bf2f(Z[(size_t)row * 512 + (c - 768)]), silu_f(v), 3);
        else if (c < 2048) cmp(bf2f(XBC[(size_t)row * 768 + (c - 1280)]), v, 4);
        else if (c < 4096) cmp(bf2f(G[(size_t)row * 2048 + (c - 2048)]), sigmoid_f(v + b_gate[c - 2048]), 5);
        else if (c < 4112) cmp(DT[(size_t)row * 16 + (c - 4096)], softplus_f(v + dt_bias[c - 4096]), 6);
    };
    gemm_naive(T, NPROJ, DM, af, bf, epi);
}
#ifndef PROBE_SEL
#define PROBE_SEL 4
#endif
#ifndef PROBE_MODE
#define PROBE_MODE 1
#endif
__device__ __forceinline__ void phase_probe_out(const Params& p) {
    const unsigned* ctl = (const unsigned*)(p.ws + WS_CTL);
    __shared__ unsigned cnt[4];
    if (threadIdx.x == 0) { cnt[0] = 1000000u; cnt[1] = 0u; cnt[2] = 0u; cnt[3] = 0u; }
    __syncthreads();
    for (int i = threadIdx.x; i < 2048; i += 512) if (ctl[8192 + i]) { const unsigned v = (unsigned)(i & 255); atomicMin(&cnt[0], v); atomicMax(&cnt[1], v); atomicAdd(&cnt[2], 1u); atomicOr(&cnt[3], 1u << (i >> 8)); }
    __syncthreads();
#if PROBE_MODE == 0
    const float f = 1.f + (float)(cnt[0] + 1);
    const float V = 100.f * (float)(cnt[1] + 1);
#else
    const float f = 1.f + (float)(cnt[2]);
    const float V = 100.f * (float)(cnt[3] + 1);
#endif
    for (size_t i = (size_t)blockIdx.x * 512 + threadIdx.x; i < (size_t)T * DM; i += (size_t)gridDim.x * 512) p.out[i] = (i == 0) ? V : p.x[i] * f;
}
#undef cmp
__device__ __forceinline__ void phase_rope(const Params& p) {
    bf16_t* Kb = wsp<bf16_t>(p, WS_K);
    const int nth = gridDim.x * 512;
    for (int idx = blockIdx.x * 512 + tid_opaque(); idx < T * 2; idx += nth) {
        const int t = idx >> 1, hh = idx & 1;
        bf16_t* ptr = Kb + (size_t)t * 128 + hh * 64;
        const float* nw = p.k_norm_w;
        float x[64];
#pragma unroll
        for (int c = 0; c < 8; ++c) { const u32x4 v = *(const u32x4*)(ptr + 8 * c);
            x[8 * c + 0] = bf2f(v.x & 0xffff); x[8 * c + 1] = bf2f(v.x >> 16); x[8 * c + 2] = bf2f(v.y & 0xffff); x[8 * c + 3] = bf2f(v.y >> 16);
            x[8 * c + 4] = bf2f(v.z & 0xffff); x[8 * c + 5] = bf2f(v.z >> 16); x[8 * c + 6] = bf2f(v.w & 0xffff); x[8 * c + 7] = bf2f(v.w >> 16); }
        float ss = 0.f;
#pragma unroll
        for (int d = 0; d < 64; ++d) ss += x[d] * x[d];
        const float rstd = 1.f / sqrtf(ss * (1.f / 64.f) + EPS);
#pragma unroll
        for (int d = 0; d < 64; ++d) x[d] = x[d] * rstd * nw[d];
        const int pos = t % SEQ; const float frow = (float)(pos / 64), fcol = (float)(pos % 64);
        float o[64];
#pragma unroll
        for (int i = 0; i < 16; ++i) {
            const float inv = exp2f(-(float)i * (13.287712379549449f / 16.f));
            const float ar = frow * inv, ac = fcol * inv;
            const float cr = __cosf(ar), sr = __sinf(ar), cc = __cosf(ac), s2 = __sinf(ac);
            o[i] = x[i] * cr - x[i + 16] * sr; o[i + 16] = x[i + 16] * cr + x[i] * sr;
            o[32 + i] = x[32 + i] * cc - x[48 + i] * s2; o[48 + i] = x[48 + i] * cc + x[32 + i] * s2;
        }
#pragma unroll
        for (int c = 0; c < 8; ++c) { u32x4 v; v.x = pk2(o[8 * c], o[8 * c + 1]); v.y = pk2(o[8 * c + 2], o[8 * c + 3]); v.z = pk2(o[8 * c + 4], o[8 * c + 5]); v.w = pk2(o[8 * c + 6], o[8 * c + 7]);
            *(u32x4*)(ptr + 8 * c) = v; }
    }
}

__device__ __forceinline__ void phase_ssd_chunk_naive(const Params& p, unsigned char* lds) {
    const int tid = tid_opaque();
    bf16_t* xs = (bf16_t*)lds;
    bf16_t* Bs = xs + 128 * 256;
    bf16_t* Cs = Bs + 128 * 64;
    float* dts = (float*)(Cs + 128 * 64);
    float* cum = dts + 2 * 4 * 128;
    float* suf = cum + 4 * 128;
    const bf16_t* XBC = wsp<bf16_t>(p, WS_XBC); const float* DT = wsp<float>(p, WS_DT);
    bf16_t* YD = wsp<bf16_t>(p, WS_YD); bf16_t* CC = wsp<bf16_t>(p, WS_CC); float* ACUM = wsp<float>(p, WS_ACUM); float* ST = wsp<float>(p, WS_ST);
    for (int item = blockIdx.x; item < BATCH * NCHUNK * SSD_G; item += gridDim.x) {
        const int g = item & 1, c = (item >> 1) % NCHUNK, b = item / (2 * NCHUNK);
        const int t0 = b * SEQ + c * CHUNK;
        __syncthreads();
        for (int idx = tid; idx < 128 * 384; idx += 512) {
            const int i = idx / 384, cl = idx % 384;
            const int ch = cl < 256 ? 256 * g + cl : (cl < 320 ? 512 + 64 * g + (cl - 256) : 640 + 64 * g + (cl - 320));
            float acc = p.conv_b[ch];
#pragma unroll
            for (int k = 0; k < DCONV; ++k) { const int pos = c * CHUNK + i + k - 3;
                if (pos >= 0 && pos < SEQ) acc += p.conv_w[k * CONV_CH + ch] * bf2f(XBC[(size_t)(b * SEQ + pos) * CONV_CH + ch]); }
            const bf16_t v = (bf16_t)f2bf(silu_f(acc));
            if (cl < 256) xs[i * 256 + cl] = v; else if (cl < 320) Bs[i * 64 + (cl - 256)] = v; else { Cs[i * 64 + (cl - 320)] = v; CC[(size_t)(t0 + i) * 128 + 64 * g + (cl - 320)] = v; }
        }
        for (int idx = tid; idx < 2 * 4 * 128; idx += 512) { const int dir = idx >> 9, hl = (idx >> 7) & 3, i = idx & 127; dts[idx] = DT[(size_t)(t0 + i) * 16 + dir * 8 + 4 * g + hl]; }
        __syncthreads();
        if (tid < 4) { const int hl = tid; const float a = -__expf(p.a_log[4 * g + hl]); float s = 0.f;
            for (int i = 0; i < 128; ++i) { s += dts[hl * 128 + i] * a; cum[hl * 128 + i] = s; ACUM[(size_t)(t0 + i) * 16 + 4 * g + hl] = s; } }
        else if (tid >= 64 && tid < 68) { const int hl = tid - 64; const float a = -__expf(p.a_log[8 + 4 * g + hl]); float s = 0.f;
            for (int i = 127; i >= 0; --i) { s += dts[512 + hl * 128 + i] * a; suf[hl * 128 + i] = s; ACUM[(size_t)(t0 + i) * 16 + 8 + 4 * g + hl] = s; } }
        __syncthreads();
        {
            const int hl = tid >> 7, i = tid & 127, h = 4 * g + hl;
            float Cr[64], y[64];
#pragma unroll
            for (int n = 0; n < 64; ++n) { Cr[n] = bf2f(Cs[i * 64 + n]); y[n] = 0.f; }
            const float ci = cum[hl * 128 + i], si = suf[hl * 128 + i];
            for (int j = 0; j < 128; ++j) {
                float cb = 0.f;
#pragma unroll
                for (int n = 0; n < 64; ++n) cb += Cr[n] * bf2f(Bs[j * 64 + n]);
                float w = 0.f;
                if (j <= i) w += __expf(ci - cum[hl * 128 + j]) * dts[hl * 128 + j];
                if (j >= i) w += __expf(si - suf[hl * 128 + j]) * dts[512 + hl * 128 + j];
                const float s = cb * w;
#pragma unroll
                for (int q = 0; q < 64; ++q) y[q] += s * bf2f(xs[j * 256 + hl * 64 + q]);
            }
            const float dsk = p.d_skip[h];
#pragma unroll
            for (int q = 0; q < 64; q += 2) { const float y0 = y[q] + dsk * bf2f(xs[i * 256 + hl * 64 + q]), y1 = y[q + 1] + dsk * bf2f(xs[i * 256 + hl * 64 + q + 1]);
                *(unsigned*)(YD + (size_t)(t0 + i) * 512 + h * 64 + q) = pk2(y0, y1); }
        }
        {
            const int combo = tid >> 6, hl = combo & 3, dir = combo >> 2, n = tid & 63, h = 4 * g + hl;
            float acc[64];
#pragma unroll
            for (int q = 0; q < 64; ++q) acc[q] = 0.f;
            const float ref = dir == 0 ? cum[hl * 128 + 127] : suf[hl * 128 + 0];
            for (int j = 0; j < 128; ++j) {
                const float wj = __expf(ref - (dir == 0 ? cum[hl * 128 + j] : suf[hl * 128 + j])) * dts[dir * 512 + hl * 128 + j];
                const float bw = bf2f(Bs[j * 64 + n]) * wj;
#pragma unroll
                for (int q = 0; q < 64; ++q) acc[q] += bf2f(xs[j * 256 + hl * 64 + q]) * bw;
            }
            float* dst = ST + ((((size_t)dir * BATCH + b) * NCHUNK + c) * 8 + h) * 4096;
#pragma unroll
            for (int q = 0; q < 64; ++q) dst[q * 64 + n] = acc[q];
        }
    }
}

__device__ __forceinline__ void phase_scan(const Params& p) {
    bf16_t* ST = wsp<bf16_t>(p, WS_ST); const float* ACUM = wsp<float>(p, WS_ACUM);
    const int tid = tid_opaque();
    if (tid < 256) {
        for (int idx = blockIdx.x * 256 + tid; idx < 2 * BATCH * 8 * 512; idx += gridDim.x * 256) {
            const int e = (idx & 511) * 8, h = (idx >> 9) & 7, b = (idx >> 12) & 7, dir = idx >> 15;
            u32x4* base = (u32x4*)(ST + (((size_t)dir * BATCH + b) * NCHUNK * 8 + h) * 4096 + e);
            u32x4 s[NCHUNK]; float dec[NCHUNK];
#pragma unroll
            for (int k = 0; k < NCHUNK; ++k) { const int ck = dir ? NCHUNK - 1 - k : k; s[k] = base[(size_t)ck * 8 * 512]; }
#pragma unroll
            for (int k = 0; k < NCHUNK; ++k) { const int ck = dir ? NCHUNK - 1 - k : k; dec[k] = dir == 0 ? ACUM[(size_t)(b * SEQ + ck * CHUNK + 127) * 16 + h] : ACUM[(size_t)(b * SEQ + ck * CHUNK) * 16 + 8 + h]; }
            float c[8] = {0.f, 0.f, 0.f, 0.f, 0.f, 0.f, 0.f, 0.f};
#pragma unroll
            for (int k = 0; k < NCHUNK; ++k) { const int ck = dir ? NCHUNK - 1 - k : k;
                base[(size_t)ck * 8 * 512] = (u32x4){pk2(c[0], c[1]), pk2(c[2], c[3]), pk2(c[4], c[5]), pk2(c[6], c[7])};
                const float d = __expf(dec[k]); const u32x4 v = s[k];
                c[0] = c[0] * d + bf2f(v.x & 0xffff); c[1] = c[1] * d + bf2f(v.x >> 16); c[2] = c[2] * d + bf2f(v.y & 0xffff); c[3] = c[3] * d + bf2f(v.y >> 16);
                c[4] = c[4] * d + bf2f(v.z & 0xffff); c[5] = c[5] * d + bf2f(v.z >> 16); c[6] = c[6] * d + bf2f(v.w & 0xffff); c[7] = c[7] * d + bf2f(v.w >> 16); }
        }
    }
}

__device__ __forceinline__ void phase_attn_naive(const Params& p) {
    bf16_t* QO = wsp<bf16_t>(p, WS_QO); const bf16_t* Kb = wsp<bf16_t>(p, WS_K); const bf16_t* Vb = wsp<bf16_t>(p, WS_V);
    const int nth = gridDim.x * 512;
    for (int idx = blockIdx.x * 512 + tid_opaque(); idx < BATCH * NQH * SEQ; idx += nth) {
        const int qi = idx % SEQ, h = (idx / SEQ) % NQH, b = idx / (SEQ * NQH), kvh = h / 4;
        bf16_t* qp = QO + (size_t)(b * SEQ + qi) * 512 + h * 64;
        float q[64], o[64];
#pragma unroll
        for (int d = 0; d < 64; ++d) { q[d] = bf2f(qp[d]); o[d] = 0.f; }
        float m = -1e30f, l = 0.f;
        const bf16_t* kp = Kb + (size_t)b * SEQ * 128 + kvh * 64; const bf16_t* vp = Vb + (size_t)b * SEQ * 128 + kvh * 64;
        for (int j = 0; j < SEQ; ++j) {
            float s = 0.f;
#pragma unroll
            for (int c = 0; c < 8; ++c) { const u32x4 v = *(const u32x4*)(kp + (size_t)j * 128 + 8 * c);
                s += q[8 * c] * bf2f(v.x & 0xffff) + q[8 * c + 1] * bf2f(v.x >> 16) + q[8 * c + 2] * bf2f(v.y & 0xffff) + q[8 * c + 3] * bf2f(v.y >> 16)
                   + q[8 * c + 4] * bf2f(v.z & 0xffff) + q[8 * c + 5] * bf2f(v.z >> 16) + q[8 * c + 6] * bf2f(v.w & 0xffff) + q[8 * c + 7] * bf2f(v.w >> 16); }
            if (s > m) { const float f = exp2f(m - s); l *= f;
#pragma unroll
                for (int d = 0; d < 64; ++d) o[d] *= f;
                m = s; }
            const float pr = exp2f(s - m); l += pr;
#pragma unroll
            for (int c = 0; c < 8; ++c) { const u32x4 v = *(const u32x4*)(vp + (size_t)j * 128 + 8 * c);
                o[8 * c] += pr * bf2f(v.x & 0xffff); o[8 * c + 1] += pr * bf2f(v.x >> 16); o[8 * c + 2] += pr * bf2f(v.y & 0xffff); o[8 * c + 3] += pr * bf2f(v.y >> 16);
                o[8 * c + 4] += pr * bf2f(v.z & 0xffff); o[8 * c + 5] += pr * bf2f(v.z >> 16); o[8 * c + 6] += pr * bf2f(v.w & 0xffff); o[8 * c + 7] += pr * bf2f(v.w >> 16); }
        }
        const float il = 1.f / l;
#pragma unroll
        for (int d = 0; d < 64; d += 2) *(unsigned*)(qp + d) = pk2(o[d] * il, o[d + 1] * il);
    }
}

__device__ __forceinline__ void phase_ssd_final_naive(const Params& p, unsigned char* lds) {
    const int tid = tid_opaque();
    float* cs = (float*)lds;
    float* ssum = cs + 8 * 4096;
    const bf16_t* YD = wsp<bf16_t>(p, WS_YD); const bf16_t* CC = wsp<bf16_t>(p, WS_CC); const float* ACUM = wsp<float>(p, WS_ACUM); const float* ST = wsp<float>(p, WS_ST);
    const bf16_t* Z = wsp<bf16_t>(p, WS_Z); bf16_t* SSD = wsp<bf16_t>(p, WS_SSD);
    for (int item = blockIdx.x; item < BATCH * NCHUNK; item += gridDim.x) {
        const int c = item % NCHUNK, b = item / NCHUNK, t0 = b * SEQ + c * CHUNK;
        const int i = tid & 127, hq = tid >> 7, t = t0 + i;
        float ss = 0.f;
        for (int s = 0; s < 2; ++s) {
            __syncthreads();
            for (int idx = tid; idx < 8 * 4096; idx += 512) { const int mtx = idx >> 12, e = idx & 4095, hh = 2 * (mtx >> 1) + s, dir = mtx & 1;
                cs[idx] = ST[((((size_t)dir * BATCH + b) * NCHUNK + c) * 8 + hh) * 4096 + e]; }
            __syncthreads();
            const int h = 2 * hq + s, g = h >> 2;
            float Cr[64];
#pragma unroll
            for (int n = 0; n < 64; ++n) Cr[n] = bf2f(CC[(size_t)t * 128 + 64 * g + n]);
            const float ef = __expf(ACUM[(size_t)t * 16 + h]), eb = __expf(ACUM[(size_t)t * 16 + 8 + h]);
            const float* cf = cs + (hq * 2 + 0) * 4096; const float* cbk = cs + (hq * 2 + 1) * 4096;
#pragma unroll 2
            for (int q = 0; q < 64; ++q) {
                float af = 0.f, ab = 0.f;
#pragma unroll
                for (int n = 0; n < 64; ++n) { af += Cr[n] * cf[q * 64 + n]; ab += Cr[n] * cbk[q * 64 + n]; }
                const float y = bf2f(YD[(size_t)t * 512 + h * 64 + q]) + af * ef + ab * eb;
                const float v = y * bf2f(Z[(size_t)t * 512 + h * 64 + q]);
                SSD[(size_t)t * 512 + h * 64 + q] = (bf16_t)f2bf(v); ss += v * v;
            }
        }
        ssum[hq * 128 + i] = ss;
        __syncthreads();
        const float tot = ssum[i] + ssum[128 + i] + ssum[256 + i] + ssum[384 + i];
        const float rstd = 1.f / sqrtf(tot * (1.f / 512.f) + EPS);
        for (int q = 0; q < 128; q += 2) { const int col = 2 * hq * 64 + q;
            const unsigned u = *(const unsigned*)(SSD + (size_t)t * 512 + col);
            *(unsigned*)(SSD + (size_t)t * 512 + col) = pk2(bf2f(u & 0xffff) * rstd * p.ssd_norm_w[col], bf2f(u >> 16) * rstd * p.ssd_norm_w[col + 1]); }
    }
}

__device__ __forceinline__ void phase_merged_naive(const Params& p) {
    const bf16_t* AT = wsp<bf16_t>(p, WS_QO); const bf16_t* SS = wsp<bf16_t>(p, WS_SSD); const bf16_t* Wa = wsp<bf16_t>(p, WS_WA); const bf16_t* Wsd = wsp<bf16_t>(p, WS_WS);
    const bf16_t* G = wsp<bf16_t>(p, WS_G); bf16_t* MG = wsp<bf16_t>(p, WS_MERGED);
    const int lane = tid_opaque() & 63, gw = blockIdx.x * 8 + (tid_opaque() >> 6), NGW = gridDim.x * 8, r = lane & 31, h = lane >> 5;
    const int tn = DM / 32, nt = (T / 32) * tn;
    for (int t = gw; t < nt; t += NGW) {
        const int pm = t / tn, pn = t % tn;
        const bf16_t* a1 = AT + (size_t)(pm * 32 + r) * 512 + 8 * h; const bf16_t* a2 = SS + (size_t)(pm * 32 + r) * 512 + 8 * h;
        const bf16_t* b1 = Wa + (size_t)(pn * 32 + r) * 512 + 8 * h; const bf16_t* b2 = Wsd + (size_t)(pn * 32 + r) * 512 + 8 * h;
        f32x16 c1 = {0.f, 0.f, 0.f, 0.f, 0.f, 0.f, 0.f, 0.f, 0.f, 0.f, 0.f, 0.f, 0.f, 0.f, 0.f, 0.f}, c2 = c1;
        for (int k = 0; k < 512; k += 16) {
            c1 = __builtin_amdgcn_mfma_f32_32x32x16_bf16(*(const bf16x8*)(a1 + k), *(const bf16x8*)(b1 + k), c1, 0, 0, 0);
            c2 = __builtin_amdgcn_mfma_f32_32x32x16_bf16(*(const bf16x8*)(a2 + k), *(const bf16x8*)(b2 + k), c2, 0, 0, 0); }
#pragma unroll
        for (int i = 0; i < 16; ++i) { const int row = pm * 32 + (i & 3) + 8 * (i >> 2) + 4 * h, col = pn * 32 + r;
            const float ga = bf2f(G[(size_t)row * 2048 + col]), gs = bf2f(G[(size_t)row * 2048 + 1024 + col]);
            MG[(size_t)row * DM + col] = (bf16_t)f2bf(ga * c1[i] + gs * c2[i]); }
    }
}
__device__ __forceinline__ void phase_wout_naive(const Params& p) {
    const bf16_t* MG = wsp<bf16_t>(p, WS_MERGED); const bf16_t* Wo = wsp<bf16_t>(p, WS_WO); const float* x = p.x; float* out = p.out;
    auto af = [=](int row) { return MG + (size_t)row * DM; };
    auto bf = [=](int, int col) { return Wo + (size_t)col * DM; };
    auto epi = [=](int row, int col, float v) { out[(size_t)row * DM + col] = x[(size_t)row * DM + col] + v; };
    gemm_naive(T, DM, DM, af, bf, epi);
}

__device__ __forceinline__ void phase_route(const Params& p, unsigned char* lds) {
    const int tid = tid_opaque(), lane = tid & 63, wave = tid >> 6;
    float* lg = (float*)lds;
    int* bk_l = (int*)(lds + 128 * 32 * 4);
    const bf16_t* WRT = (const bf16_t*)(p.ws + WS_ROUTE + RT_WRT);
    int* tb = (int*)(p.ws + WS_ROUTE + RT_BUCKET); int* trk = (int*)(p.ws + WS_ROUTE + RT_RANK); float* twa = (float*)(p.ws + WS_ROUTE + RT_WA); float* twb = (float*)(p.ws + WS_ROUTE + RT_WB);
    int* cnt = (int*)(p.ws + WS_ROUTE + RT_CNT); float* RSTD = (float*)(p.ws + WS_ROUTE + RT_RSTD);
    float* rs_l = (float*)(lds + 128 * 32 * 4 + 512);
    const bf16_t* X1 = wsp<bf16_t>(p, WS_X1B);
    for (int tile = blockIdx.x; tile < NRT; tile += gridDim.x) {
        __syncthreads();
        { const int r0 = wave * 16;
            u32x4 v[16][2];
#pragma unroll
            for (int r = 0; r < 16; ++r) { const u32x4* xr = (const u32x4*)(X1 + (size_t)(tile * 128 + r0 + r) * DM) + lane; v[r][0] = xr[0]; v[r][1] = xr[64]; }
            __builtin_amdgcn_sched_barrier(0);
#pragma unroll
            for (int r = 0; r < 16; ++r) { float s = 0.f;
#pragma unroll
                for (int hf = 0; hf < 2; ++hf) { const float f0 = gm2::bflo(v[r][hf].x), f1 = gm2::bfhi(v[r][hf].x), f2 = gm2::bflo(v[r][hf].y), f3 = gm2::bfhi(v[r][hf].y),
                                                             f4 = gm2::bflo(v[r][hf].z), f5 = gm2::bfhi(v[r][hf].z), f6 = gm2::bflo(v[r][hf].w), f7 = gm2::bfhi(v[r][hf].w);
                    s += (f0 * f0 + f1 * f1) + (f2 * f2 + f3 * f3) + (f4 * f4 + f5 * f5) + (f6 * f6 + f7 * f7); }
                const float rstd = 1.f / sqrtf(wave_sum(s) * (1.f / DM) + EPS);
                if (lane == 0) { RSTD[tile * 128 + r0 + r] = rstd; rs_l[r0 + r] = rstd; } }
        }
        __syncthreads();
        {
            const int rt = wave & 3, kh = wave >> 2, r = lane & 31, hh = lane >> 5;
            const bf16_t* a = X1 + (size_t)(tile * 128 + rt * 32 + r) * DM + kh * 512 + 8 * hh; const bf16_t* b = WRT + (size_t)r * DM + kh * 512 + 8 * hh;
            f32x16 acc = {0.f, 0.f, 0.f, 0.f, 0.f, 0.f, 0.f, 0.f, 0.f, 0.f, 0.f, 0.f, 0.f, 0.f, 0.f, 0.f};
#pragma unroll 1
            for (int k0 = 0; k0 < 512; k0 += 256) {
                bf16x8 av[16], bv[16];
#pragma unroll
                for (int u = 0; u < 16; ++u) { av[u] = *(const bf16x8*)(a + k0 + 16 * u); bv[u] = *(const bf16x8*)(b + k0 + 16 * u); }
                __builtin_amdgcn_sched_barrier(0);
#pragma unroll
                for (int u = 0; u < 16; ++u) acc = __builtin_amdgcn_mfma_f32_32x32x16_bf16(av[u], bv[u], acc, 0, 0, 0);
                __builtin_amdgcn_sched_barrier(0);
            }
            if (kh == 1) {
#pragma unroll
                for (int i = 0; i < 16; ++i) lg[(rt * 32 + (i & 3) + 8 * (i >> 2) + 4 * hh) * 32 + r] = acc[i];
            }
            __syncthreads();
            if (kh == 0) {
#pragma unroll
                for (int i = 0; i < 16; ++i) lg[(rt * 32 + (i & 3) + 8 * (i >> 2) + 4 * hh) * 32 + r] += acc[i];
            }
        }
        __syncthreads();
        if (tid < 128) {
            const int m = tile * 128 + tid; const float* L = lg + tid * 32; const float rs = rs_l[tid];
            float gl[4]; float gm = -1e30f;
#pragma unroll
            for (int g = 0; g < 4; ++g) { gl[g] = L[g] * rs + p.b_rg[g]; gm = fmaxf(gm, gl[g]); }
            float gs = 0.f; int gi = 0; float gbest = -1e30f;
#pragma unroll
            for (int g = 0; g < 4; ++g) { const float e = __expf(gl[g] - gm); gs += e; if (gl[g] > gbest) { gbest = gl[g]; gi = g; } }
            const float gval = __expf(gbest - gm) / gs;
            float fl[4]; float fm = -1e30f;
#pragma unroll
            for (int e = 0; e < 4; ++e) { fl[e] = L[4 + 4 * gi + e] * rs + p.b_re[4 * gi + e]; fm = fmaxf(fm, fl[e]); }
            int i0 = 0; float b0 = -1e30f;
#pragma unroll
            for (int e = 0; e < 4; ++e) if (fl[e] > b0) { b0 = fl[e]; i0 = e; }
            int i1 = 0; float b1 = -1e30f;
#pragma unroll
            for (int e = 0; e < 4; ++e) if (e != i0 && fl[e] > b1) { b1 = fl[e]; i1 = e; }
            const float e0 = __expf(b0 - fm), e1 = __expf(b1 - fm); const float w0 = e0 / (e0 + e1) * gval, w1 = e1 / (e0 + e1) * gval;
            const int a = min(i0, i1), bb = max(i0, i1); const float wa = (i0 < i1) ? w0 : w1, wb = (i0 < i1) ? w1 : w0;
            const int pidx = a == 0 ? bb - 1 : (a == 1 ? bb + 1 : 5);
            const int bucket = gi * 6 + pidx;
            tb[m] = bucket; twa[m] = wa; twb[m] = wb; bk_l[tid] = bucket;
        }
        __syncthreads();
        if (tid < 128) { const int mine = bk_l[tid]; int rk = 0; for (int j = 0; j < tid; ++j) rk += (bk_l[j] == mine) ? 1 : 0; trk[tile * 128 + tid] = rk; }
        else if (tid < 128 + NBUCKET) { const int k = tid - 128; int n = 0; for (int j = 0; j < 128; ++j) n += (bk_l[j] == k) ? 1 : 0; cnt[tile * NBUCKET + k] = n; }
    }
}

__device__ __forceinline__ void phase_gather(const Params& p, unsigned char* lds) {
    const int tid = tid_opaque(), lane = tid & 63, wave = tid >> 6;
    int* cl = (int*)lds;
    int* start = cl + NRT * NBUCKET;
    int* tot = start + 32;
    int* mybase = tot + 32;
    const int* cnt = (const int*)(p.ws + WS_ROUTE + RT_CNT); const int* tb = (const int*)(p.ws + WS_ROUTE + RT_BUCKET); const int* trk = (const int*)(p.ws + WS_ROUTE + RT_RANK);
    int* perm = (int*)(p.ws + WS_ROUTE + RT_PERM); int* tbk = (int*)(p.ws + WS_ROUTE + RT_TB);
    float* swa = (float*)(p.ws + WS_ROUTE + RT_SWA); float* swb = (float*)(p.ws + WS_ROUTE + RT_SWB);
    const float* twa = (const float*)(p.ws + WS_ROUTE + RT_WA); const float* twb = (const float*)(p.ws + WS_ROUTE + RT_WB);
    const float* RSTD = (const float*)(p.ws + WS_ROUTE + RT_RSTD); float* srs = (float*)(p.ws + WS_ROUTE + RT_SRS);
    const bf16_t* H2 = wsp<bf16_t>(p, WS_H); bf16_t* XS = wsp<bf16_t>(p, WS_XS);
    for (int i = tid; i < NRT * NBUCKET; i += 512) cl[i] = cnt[i];
    __syncthreads();
    for (int k = wave; k < NBUCKET; k += 8) { int s = 0;
#pragma unroll
        for (int q = 0; q < NRT / 64; ++q) s += cl[(lane + 64 * q) * NBUCKET + k];
#pragma unroll
        for (int o = 1; o < 64; o <<= 1) s += __shfl_xor(s, o);
        if (lane == 0) tot[k] = s; }
    __syncthreads();
    if (tid == 0) { int s = 0; for (int k = 0; k < NBUCKET; ++k) { start[k] = s; s += (tot[k] + 255) & ~255; } start[NBUCKET] = s; }
    __syncthreads();
    if (blockIdx.x == 0) {
        for (int k = 0; k < NBUCKET; ++k) { const int lo = start[k] + tot[k], hi = start[k + 1]; for (int r = lo + tid; r < hi; r += 512) { perm[r] = -1; swa[r] = 0.f; swb[r] = 0.f; srs[r] = 0.f; } }
        const int ntile = start[NBUCKET] / 256;
        for (int t = tid; t < TS / 256; t += 512) { int bk = -1; if (t < ntile) { for (int k = 0; k < NBUCKET; ++k) if (t * 256 >= start[k] && t * 256 < start[k + 1]) bk = k; } tbk[t] = bk; }
        if (tid == 0) tbk[TS / 256] = ntile;
    }
    for (int tile = blockIdx.x; tile < NRT; tile += gridDim.x) {
        __syncthreads();
        for (int k = wave; k < NBUCKET; k += 8) { int s = 0;
#pragma unroll
            for (int q = 0; q < NRT / 64; ++q) { const int t = lane + 64 * q; s += (t < tile) ? cl[t * NBUCKET + k] : 0; }
#pragma unroll
            for (int o = 1; o < 64; o <<= 1) s += __shfl_xor(s, o);
            if (lane == 0) mybase[k] = start[k] + s; }
        __syncthreads();
#if USE_PG8 && FUSE_GATHER
        if (lane < 16) {
            const int m = tile * 128 + wave * 16 + lane;
            const int bkt = tb[m], rk = trk[m]; const float wa = twa[m], wb = twb[m], rs = RSTD[m];
            const int d = mybase[bkt] + rk;
            perm[d] = m; swa[d] = wa; swb[d] = wb; srs[d] = rs;
        }
#else
        {
            int dest[16];
#pragma unroll
            for (int q = 0; q < 16; ++q) { const int m = tile * 128 + wave * 16 + q; dest[q] = mybase[tb[m]] + trk[m]; }
#pragma unroll
            for (int q = 0; q < 16; ++q) { const int m = tile * 128 + wave * 16 + q; if (lane == 0) { perm[dest[q]] = m; swa[dest[q]] = twa[m]; swb[dest[q]] = twb[m]; } }
#if !(USE_PG8 && FUSE_GATHER)
#pragma unroll
            for (int q0 = 0; q0 < 16; q0 += 8) {
                u32x4 v0[8], v1[8];
#pragma unroll
                for (int q = 0; q < 8; ++q) { const u32x4* src = (const u32x4*)(H2 + (size_t)(tile * 128 + wave * 16 + q0 + q) * DM); v0[q] = src[lane]; v1[q] = src[64 + lane]; }
#pragma unroll
                for (int q = 0; q < 8; ++q) { u32x4* dst = (u32x4*)(XS + (size_t)dest[q0 + q] * DM); dst[lane] = v0[q]; dst[64 + lane] = v1[q]; }
            }
#endif
        }
#endif
    }
}

__device__ __forceinline__ void phase_moe1_naive(const Params& p) {
    const bf16_t* XS = wsp<bf16_t>(p, WS_XS); const bf16_t* W13 = wsp<bf16_t>(p, WS_W13); bf16_t* HID = wsp<bf16_t>(p, WS_HID);
    const int* perm = (const int*)(p.ws + WS_ROUTE + RT_PERM); const int* tbk = (const int*)(p.ws + WS_ROUTE + RT_TB);
    const float* twa = (const float*)(p.ws + WS_ROUTE + RT_WA); const float* twb = (const float*)(p.ws + WS_ROUTE + RT_WB);
    const int lane = tid_opaque() & 63, gw = blockIdx.x * 8 + (tid_opaque() >> 6), NGW = gridDim.x * 8, r = lane & 31, h = lane >> 5;
    const int nrows = tbk[TS / 256] * 256, tn = 1024 / 32, nt = (nrows / 32) * tn;
    for (int t = gw; t < nt; t += NGW) {
        const int pm = t / tn, pn = t % tn, bucket = tbk[pm / 8], g = bucket / 6; int a, b; pair_of(bucket % 6, a, b);
        const int slot = pn >> 4, e = g * 4 + (slot ? b : a), j0 = (pn & 15) * 32;
        const bf16_t* ap = XS + (size_t)(pm * 32 + r) * DM + 8 * h;
        const bf16_t* b1 = W13 + ((size_t)e * 1024 + 2 * (j0 + r)) * DM + 8 * h; const bf16_t* b3 = b1 + DM;
        f32x16 c1 = {0.f, 0.f, 0.f, 0.f, 0.f, 0.f, 0.f, 0.f, 0.f, 0.f, 0.f, 0.f, 0.f, 0.f, 0.f, 0.f}, c3 = c1;
        for (int k = 0; k < DM; k += 16) { const bf16x8 av = *(const bf16x8*)(ap + k);
            c1 = __builtin_amdgcn_mfma_f32_32x32x16_bf16(av, *(const bf16x8*)(b1 + k), c1, 0, 0, 0);
            c3 = __builtin_amdgcn_mfma_f32_32x32x16_bf16(av, *(const bf16x8*)(b3 + k), c3, 0, 0, 0); }
#pragma unroll
        for (int i = 0; i < 16; ++i) { const int row = pm * 32 + (i & 3) + 8 * (i >> 2) + 4 * h; const int tok = perm[row];
            const float w = tok < 0 ? 0.f : (slot ? twb[tok] : twa[tok]);
            HID[(size_t)row * 1024 + slot * 512 + j0 + r] = (bf16_t)f2bf(w * silu_f(c1[i]) * c3[i]); }
    }
}
__device__ __forceinline__ void phase_moe2_naive(const Params& p) {
    const bf16_t* HID = wsp<bf16_t>(p, WS_HID); const bf16_t* W2P = wsp<bf16_t>(p, WS_W2P); float* out = p.out;
    const int* perm = (const int*)(p.ws + WS_ROUTE + RT_PERM); const int* tbk = (const int*)(p.ws + WS_ROUTE + RT_TB);
    const int nrows = tbk[TS / 256] * 256;
    auto af = [=](int row) { return HID + (size_t)row * 1024; };
    auto bf = [=](int row0, int col) { return W2P + ((size_t)tbk[row0 / 256] * 1024 + col) * 1024; };
    auto epi = [=](int row, int col, float v) { const int tok = perm[row]; if (tok >= 0) out[(size_t)tok * DM + col] += v; };
    gemm_naive(nrows, DM, 1024, af, bf, epi);
}


#include <hip/hip_bf16.h>
namespace attn_body {
using bf16=__hip_bfloat16;
using bf16x8=__attribute__((ext_vector_type(8)))short;
using s16x4=__attribute__((ext_vector_type(4)))short;
using f32x16=__attribute__((ext_vector_type(16)))float;
using u32x4=__attribute__((ext_vector_type(4)))unsigned;
constexpr int BATCH=8,NHEAD=8,SEQ=4096,D=64,QP=512,KP=128;
constexpr int NW=8,QBLK=32,QB=QBLK*NW,KVBLK=64,NQB=SEQ/QB;
constexpr int ATTN_UNIT_ROWS=QB;
__device__ __forceinline__ int crow(int r,int hi){return (r&3)+8*(r>>2)+4*hi;}
#define SBAR() __builtin_amdgcn_sched_barrier(0)
__device__ __forceinline__ void cmask(f32x16&p0,f32x16&p1,int jb,int qrel,int hi){
  const float NEG=-INFINITY; int kb=64*jb+4*hi;
  #pragma unroll
  for(int r=0;r<16;++r){int kv=kb+(r&3)+8*(r>>2); if(kv>qrel)p0[r]=NEG; if(kv+32>qrel)p1[r]=NEG;}
}

constexpr int NSLOT=3, SLOTB=8192;
constexpr int LDS_K=0, LDS_V=NSLOT*SLOTB, LDS_WS=2*NSLOT*SLOTB, LDS_OST=LDS_WS+NW*64*4, LDS_BYTES=LDS_OST+NW*4096;
constexpr float C2=0.125f*1.4426950408889634f;
__device__ __forceinline__ void glds16(const void*gsrc,unsigned lds_dst){unsigned keep;
  asm volatile("s_mov_b32 %0, m0\n\ts_mov_b32 m0, %2\n\ts_nop 0\n\tglobal_load_lds_dwordx4 %1, off\n\ts_mov_b32 m0, %0":"=&s"(keep):"v"(gsrc),"s"(lds_dst):"memory");}
__device__ __forceinline__ float max3f(float a,float b,float c){float r;asm("v_max3_f32 %0, %1, %2, %3":"=v"(r):"v"(a),"v"(b),"v"(c));return r;}
__device__ __forceinline__ float max2f(float a,float b){float r;asm("v_max_f32_e32 %0, %1, %2":"=v"(r):"v"(a),"v"(b));return r;}
__device__ __forceinline__ float fadd_s(float a,float b){float r;asm("v_add_f32_e32 %0, %1, %2":"=v"(r):"v"(a),"v"(b));return r;}
__device__ __forceinline__ float fsub_s(float a,float b){float r;asm("v_sub_f32_e32 %0, %1, %2":"=v"(r):"v"(a),"v"(b));return r;}
typedef float f32x2_t __attribute__((ext_vector_type(2))); typedef __bf16 bf16x2_t __attribute__((ext_vector_type(2)));
__device__ __forceinline__ unsigned cvtpk_s(float lo,float hi){f32x2_t v={lo,hi};bf16x2_t b=__builtin_convertvector(v,bf16x2_t);return __builtin_bit_cast(unsigned,b);}
#define WAIT_BAR(N) asm volatile("s_waitcnt vmcnt(" #N ") lgkmcnt(0)\n\ts_barrier":::"memory")

__device__ __forceinline__ void qkt(f32x16&p0,f32x16&p1,const char*Kslot,const bf16x8*qr,const f32x16&negm,int r32,int hi){
  const char*kb=Kslot+hi*1024+r32*16;
  #pragma unroll
  for(int d0=0;d0<4;++d0){
    const bf16x8 b0=*reinterpret_cast<const bf16x8*>(kb+d0*2048);
    const bf16x8 b1=*reinterpret_cast<const bf16x8*>(kb+d0*2048+512);
    if(d0==0){p0=__builtin_amdgcn_mfma_f32_32x32x16_bf16(b0,qr[0],negm,0,0,0);p1=__builtin_amdgcn_mfma_f32_32x32x16_bf16(b1,qr[0],negm,0,0,0);}
    else{p0=__builtin_amdgcn_mfma_f32_32x32x16_bf16(b0,qr[d0],p0,0,0,0);p1=__builtin_amdgcn_mfma_f32_32x32x16_bf16(b1,qr[d0],p1,0,0,0);}}
}
typedef __attribute__((address_space(3))) const char* lds_cptr;
typedef short v4i16_t __attribute__((ext_vector_type(4)));
__device__ __forceinline__ void kload8(bf16x8*kf,lds_cptr kp){
  kf[0]=*(const __attribute__((address_space(3))) bf16x8*)(kp);      kf[1]=*(const __attribute__((address_space(3))) bf16x8*)(kp+512);
  kf[2]=*(const __attribute__((address_space(3))) bf16x8*)(kp+2048); kf[3]=*(const __attribute__((address_space(3))) bf16x8*)(kp+2560);
  kf[4]=*(const __attribute__((address_space(3))) bf16x8*)(kp+4096); kf[5]=*(const __attribute__((address_space(3))) bf16x8*)(kp+4608);
  kf[6]=*(const __attribute__((address_space(3))) bf16x8*)(kp+6144); kf[7]=*(const __attribute__((address_space(3))) bf16x8*)(kp+6656);
}
__device__ __forceinline__ void kload2(bf16x8*kf,lds_cptr kp,int j){ kf[2*j]=*(const __attribute__((address_space(3))) bf16x8*)(kp+j*2048); kf[2*j+1]=*(const __attribute__((address_space(3))) bf16x8*)(kp+j*2048+512); }
__device__ __forceinline__ s16x4 vtr(lds_cptr p){ return __builtin_bit_cast(s16x4,__builtin_amdgcn_ds_read_tr16_b64_v4i16((__attribute__((address_space(3))) v4i16_t*)p)); }
__device__ __forceinline__ float rowmax(const f32x16&p0,const f32x16&p1){
  float a=max3f(p0[0],p0[1],p1[0]),b=max3f(p0[2],p0[3],p1[1]);a=max3f(a,p1[2],p1[3]);
  #pragma unroll
  for(int r=4;r<16;r+=4){a=max3f(a,p0[r],p0[r+1]);b=max3f(b,p0[r+2],p0[r+3]);a=max3f(a,p1[r],p1[r+1]);b=max3f(b,p1[r+2],p1[r+3]);}
  const float m=max2f(a,b);
  auto rr=__builtin_amdgcn_permlane32_swap(__float_as_uint(m),__float_as_uint(m),false,false);
  return max2f(__uint_as_float(rr[0]),__uint_as_float(rr[1]));
}
__device__ __forceinline__ void pv(f32x16*o,int vb,bf16x8 pa0,bf16x8 pa1,bf16x8 pa2,bf16x8 pa3){
  #pragma unroll
  for(int d0=0;d0<2;++d0){s16x4 lo[4],hi[4];
    #pragma unroll
    for(int ks=0;ks<4;++ks){
      asm volatile("ds_read_b64_tr_b16 %0,%1 offset:%c2":"=&v"(lo[ks]):"v"(vb),"i"(d0*4096+ks*1024):"memory");
      asm volatile("ds_read_b64_tr_b16 %0,%1 offset:%c2":"=&v"(hi[ks]):"v"(vb),"i"(d0*4096+ks*1024+512):"memory");}
    asm volatile("s_waitcnt lgkmcnt(0)":::"memory");SBAR();
    #define PK(k) (bf16x8){lo[k][0],lo[k][1],lo[k][2],lo[k][3],hi[k][0],hi[k][1],hi[k][2],hi[k][3]}
    o[d0]=__builtin_amdgcn_mfma_f32_32x32x16_bf16(pa0,PK(0),o[d0],0,0,0);
    o[d0]=__builtin_amdgcn_mfma_f32_32x32x16_bf16(pa1,PK(1),o[d0],0,0,0);
    o[d0]=__builtin_amdgcn_mfma_f32_32x32x16_bf16(pa2,PK(2),o[d0],0,0,0);
    o[d0]=__builtin_amdgcn_mfma_f32_32x32x16_bf16(pa3,PK(3),o[d0],0,0,0);
    #undef PK
  }
}

#ifndef ATTN_STORE16
#define ATTN_STORE16(p,v) (*(u32x4*)(p)=(v))
#endif
template<int THRL> __device__ __forceinline__ void attn_unit(int b,int h,int qb,const bf16*Q,const bf16*__restrict__ K,const bf16*__restrict__ V,bf16*O,char*shm,const float*qnw){
  int tid_=threadIdx.x; asm volatile("":"+v"(tid_));
  const int tid=tid_,lane=tid&63,r32=lane&31,hi=lane>>5; const int wid=__builtin_amdgcn_readfirstlane(tid>>6);
  const long rowbase=(long)b*SEQ; const int q0=qb*QB;
  const bf16*Qw=Q+(rowbase+q0+wid*QBLK)*QP+h*D;
  const bf16*Kh=K+rowbase*KP+(h>>2)*D,*Vh=V+rowbase*KP+(h>>2)*D;
  const unsigned lds0=(unsigned)(uintptr_t)shm;
  float*wsf=(float*)(shm+LDS_WS)+wid*64;
  const bf16*ksrc=Kh+(long)lane*KP+wid*8;
  const bf16*vsrc=Vh+(long)(16*(wid&3)+(lane>>2))*KP+(wid>>2)*32+(lane&3)*8;
  const unsigned kdst=lds0+LDS_K+wid*1024, vdst=lds0+LDS_V+wid*1024;
  #define DMA_K(t,slot) glds16(ksrc+(long)(t)*KVBLK*KP,(unsigned)__builtin_amdgcn_readfirstlane(kdst+(slot)))
  #define DMA_V(t,slot) glds16(vsrc+(long)(t)*KVBLK*KP,(unsigned)__builtin_amdgcn_readfirstlane(vdst+(slot)))
  const int vb0=(int)(lds0+LDS_V)+((lane>>4)&1)*32+(lane&3)*8+(4*hi+((lane&15)>>2))*64;
  const char*Kbase=shm+LDS_K; bf16x8 kf[8];
  const lds_cptr shm3=(lds_cptr)shm; const lds_cptr kp0=shm3+LDS_K+hi*1024+r32*16; const lds_cptr vp0=shm3+LDS_V+((lane>>4)&1)*32+(lane&3)*8+(4*hi+((lane&15)>>2))*64;
  const int NT=SEQ/KVBLK;
  DMA_K(0,0);DMA_V(0,0);DMA_K(1,SLOTB);
  bf16x8 qr[4];
  #pragma unroll
  for(int d0=0;d0<4;++d0)qr[d0]=*reinterpret_cast<const bf16x8*>(&Qw[(long)r32*QP+d0*16+hi*8]);
  {
    float qf[4][8];
    #pragma unroll
    for(int d0=0;d0<4;++d0){
      #pragma unroll
      for(int j=0;j<8;++j)qf[d0][j]=__uint_as_float(((unsigned)(unsigned short)qr[d0][j])<<16);}
    float ss=0.f;
    #pragma unroll
    for(int d0=0;d0<4;++d0){
      #pragma unroll
      for(int j=0;j<8;++j)ss+=qf[d0][j]*qf[d0][j];}
    {auto rr=__builtin_amdgcn_permlane32_swap(__float_as_uint(ss),__float_as_uint(ss),false,false);ss=__uint_as_float(rr[0])+__uint_as_float(rr[1]);}
    const float rstd=1.0f/sqrtf(ss*(1.0f/64.0f)+1e-6f);
    #pragma unroll
    for(int d0=0;d0<4;++d0){
      #pragma unroll
      for(int j=0;j<8;++j)qf[d0][j]*=rstd*qnw[d0*16+hi*8+j];}
    const int pos=q0+wid*QBLK+r32; const float frow=(float)(pos>>6),fcol=(float)(pos&63);
    #pragma unroll
    for(int j=0;j<8;++j){
      const float inv=exp2f(-(float)(hi*8+j)*(13.287712379549449f/16.f));
      const float ar=frow*inv,ac=fcol*inv; const float cr=__cosf(ar),sr=__sinf(ar),cc=__cosf(ac),sc=__sinf(ac);
      const float a0=qf[0][j],a1=qf[1][j],a2=qf[2][j],a3=qf[3][j];
      qf[0][j]=(a0*cr-a1*sr)*C2; qf[1][j]=(a1*cr+a0*sr)*C2; qf[2][j]=(a2*cc-a3*sc)*C2; qf[3][j]=(a3*cc+a2*sc)*C2;}
    #pragma unroll
    for(int d0=0;d0<4;++d0){ u32x4 w={cvtpk_s(qf[d0][0],qf[d0][1]),cvtpk_s(qf[d0][2],qf[d0][3]),cvtpk_s(qf[d0][4],qf[d0][5]),cvtpk_s(qf[d0][6],qf[d0][7])}; qr[d0]=__builtin_bit_cast(bf16x8,w);}
  }
  float zf_=0.f;asm volatile("":"+v"(zf_));
  const f32x16 z16_={zf_,zf_,zf_,zf_,zf_,zf_,zf_,zf_,zf_,zf_,zf_,zf_,zf_,zf_,zf_,zf_};
  float mhat=0.f,l_reg=0.f;f32x16 o[2];o[0]=z16_;o[1]=z16_;f32x16 negm=z16_;asm volatile("":"+v"(negm));
  const int qrel=wid*QBLK+r32;
  #define CMASK(P0,P1,t) do{}while(0)
  bool resc=false;
  #define START(P0,P1) do{ const float rm=rowmax(P0,P1); resc=false; \
    { const float dl=rm; mhat=fadd_s(mhat,dl); \
      _Pragma("unroll") for(int r=0;r<16;++r){P0[r]=fsub_s(P0[r],dl);P1[r]=fsub_s(P1[r],dl);} \
      _Pragma("unroll") for(int r=0;r<16;++r)negm[r]=-mhat; asm volatile("":"+v"(negm)); } \
    _Pragma("unroll") for(int r=0;r<16;++r)P0[r]=__builtin_amdgcn_exp2f(P0[r]); }while(0)
  #define RESC() do{ if(resc){ asm volatile("s_waitcnt lgkmcnt(0)":::"memory"); \
      _Pragma("unroll") for(int d_=0;d_<2;++d_) _Pragma("unroll") for(int r=0;r<16;++r)o[d_][r]*=wsf[crow(r,hi)]; } }while(0)
  f32x16 pA0,pA1,pB0,pB1;
  int sl_prev=0,sl_cur=0,sl_next=SLOTB;
  #define ROT() do{sl_prev=sl_cur;sl_cur=sl_next;sl_next=(sl_next==(NSLOT-1)*SLOTB)?0:sl_next+SLOTB;}while(0)
  DMA_K(2,2*SLOTB);
  WAIT_BAR(3);
  qkt(pA0,pA1,Kbase,qr,negm,r32,hi);asm volatile("s_nop 15\n\ts_nop 7":"+v"(pA0),"+v"(pA1));CMASK(pA0,pA1,0);
  START(pA0,pA1);
  _Pragma("unroll") for(int r=0;r<16;++r)pA1[r]=__builtin_amdgcn_exp2f(pA1[r]);
  WAIT_BAR(0);
  DMA_K(3,0);DMA_V(1,SLOTB);
  ROT();
  kload8(kf,kp0+sl_cur);
  WAIT_BAR(2);
  s16x4 vlo[8],vhi[8]; u32x4 pw0,pw1,pw2,pw3;
  #define PKW(P,B) cvtpk_s(P[B],P[B+1])
  #define PAF(k) __builtin_bit_cast(bf16x8,pw##k)
  #define VFR(i) (bf16x8){vlo[i][0],vlo[i][1],vlo[i][2],vlo[i][3],vhi[i][0],vhi[i][1],vhi[i][2],vhi[i][3]}
  #define PIN(x) asm volatile("":"+v"(x))
  #define MX3(a,b,c) __builtin_fmaxf(__builtin_fmaxf((a),(b)),(c))
  #define GAPA(MF,A0,A1,A2,A3,W0,W1,PW) do{ MF; sacc+=A0; sacc+=A1; sacc+=A2; sacc+=A3; PIN(sacc); W0; W1; PIN(PW); SBAR(); }while(0)
  #define EX(v) __builtin_amdgcn_exp2f(v)
  #define GAPB(MF,X,B) do{ MF; X[B]=EX(X[B]); X[B+1]=EX(X[B+1]); X[B+2]=EX(X[B+2]); X[B+3]=EX(X[B+3]); PIN(X); SBAR(); }while(0)
  #define VRD(i) do{ vlo[i]=vtr(vp_+(((i)>>2)*4096+((i)&3)*1024)); vhi[i]=vtr(vp_+(((i)>>2)*4096+((i)&3)*1024+512)); }while(0)
  #define KRD(G,j) do{ if(G){ kload2(kf,kp0+sl_next,j); SBAR(); } }while(0)
  #define STEP(C0,C1,P0,P1,t,GK,GV,GL) do{ SBAR(); \
    const lds_cptr vp_=vp0+sl_prev; \
    VRD(0); SBAR(); float sacc=(P0[0]+P0[1]); \
    GAPA(C0=__builtin_amdgcn_mfma_f32_32x32x16_bf16(kf[0],qr[0],negm,0,0,0), P0[2],P0[3],P0[4],P0[5],     pw0[0]=PKW(P0,0), pw0[1]=PKW(P0,2), pw0); \
    VRD(4); SBAR(); GAPA(C1=__builtin_amdgcn_mfma_f32_32x32x16_bf16(kf[1],qr[0],negm,0,0,0), P0[6],P0[7],P0[8],P0[9],     pw0[2]=PKW(P0,4), pw0[3]=PKW(P0,6), pw0); \
    VRD(1); SBAR(); GAPA(C0=__builtin_amdgcn_mfma_f32_32x32x16_bf16(kf[2],qr[1],C0,0,0,0),   P0[10],P0[11],P0[12],P0[13], pw1[0]=PKW(P0,8), pw1[1]=PKW(P0,10), pw1); \
    VRD(5); SBAR(); GAPA(C1=__builtin_amdgcn_mfma_f32_32x32x16_bf16(kf[3],qr[1],C1,0,0,0),   P0[14],P0[15],P1[0],P1[1],   pw1[2]=PKW(P0,12),pw1[3]=PKW(P0,14), pw1); \
    VRD(2); SBAR(); GAPA(C0=__builtin_amdgcn_mfma_f32_32x32x16_bf16(kf[4],qr[2],C0,0,0,0),   P1[2],P1[3],P1[4],P1[5],     pw2[0]=PKW(P1,0), pw2[1]=PKW(P1,2), pw2); \
    VRD(6); SBAR(); GAPA(C1=__builtin_amdgcn_mfma_f32_32x32x16_bf16(kf[5],qr[2],C1,0,0,0),   P1[6],P1[7],P1[8],P1[9],     pw2[2]=PKW(P1,4), pw2[3]=PKW(P1,6), pw2); \
    VRD(3); SBAR(); GAPA(C0=__builtin_amdgcn_mfma_f32_32x32x16_bf16(kf[6],qr[3],C0,0,0,0),   P1[10],P1[11],P1[12],P1[13], pw3[0]=PKW(P1,8), pw3[1]=PKW(P1,10), pw3); \
    VRD(7); SBAR(); GAPA(C1=__builtin_amdgcn_mfma_f32_32x32x16_bf16(kf[7],qr[3],C1,0,0,0),   P1[14],P1[15],0.f,0.f,       pw3[2]=PKW(P1,12),pw3[3]=PKW(P1,14), pw3); \
    l_reg+=sacc; \
    if(GK){DMA_K((t)+3,sl_cur);} if(GV){DMA_V((t)+1,sl_next);} \
    CMASK(C0,C1,t); \
    { float a=MX3(C0[0],C0[1],C1[0]),b=MX3(C0[2],C0[3],C1[1]); a=MX3(a,C1[2],C1[3]); \
      _Pragma("unroll") for(int r=4;r<16;r+=4){a=MX3(a,C0[r],C0[r+1]);b=MX3(b,C0[r+2],C0[r+3]);a=MX3(a,C1[r],C1[r+1]);b=MX3(b,C1[r+2],C1[r+3]);} \
      float rm=__builtin_fmaxf(a,b); { auto rr=__builtin_amdgcn_permlane32_swap(__float_as_uint(rm),__float_as_uint(rm),false,false); rm=__builtin_fmaxf(__uint_as_float(rr[0]),__uint_as_float(rr[1])); } \
      resc=false; \
      if(__builtin_expect(__any(rm>(float)THRL),0)){ const float dl=__builtin_fmaxf(rm,0.f); mhat+=dl; \
        _Pragma("unroll") for(int r=0;r<16;++r){C0[r]-=dl;C1[r]-=dl;} \
        _Pragma("unroll") for(int r=0;r<16;++r)negm[r]=-mhat; asm volatile("":"+v"(negm)); \
        const float f=__builtin_amdgcn_exp2f(-dl); l_reg*=f; if(hi==0)wsf[r32]=f; resc=true; } } \
    SBAR(); \
    GAPB(o[0]=__builtin_amdgcn_mfma_f32_32x32x16_bf16(PAF(0),VFR(0),o[0],0,0,0), C0,0); \
    GAPB(o[1]=__builtin_amdgcn_mfma_f32_32x32x16_bf16(PAF(0),VFR(4),o[1],0,0,0), C0,4); \
    KRD(GL,0); GAPB(o[0]=__builtin_amdgcn_mfma_f32_32x32x16_bf16(PAF(1),VFR(1),o[0],0,0,0), C0,8); \
    KRD(GL,1); GAPB(o[1]=__builtin_amdgcn_mfma_f32_32x32x16_bf16(PAF(1),VFR(5),o[1],0,0,0), C0,12); \
    KRD(GL,2); GAPB(o[0]=__builtin_amdgcn_mfma_f32_32x32x16_bf16(PAF(2),VFR(2),o[0],0,0,0), C1,0); \
    KRD(GL,3); GAPB(o[1]=__builtin_amdgcn_mfma_f32_32x32x16_bf16(PAF(2),VFR(6),o[1],0,0,0), C1,4); \
    GAPB(o[0]=__builtin_amdgcn_mfma_f32_32x32x16_bf16(PAF(3),VFR(3),o[0],0,0,0), C1,8); \
    GAPB(o[1]=__builtin_amdgcn_mfma_f32_32x32x16_bf16(PAF(3),VFR(7),o[1],0,0,0), C1,12); \
    }while(0)
  int t=1;
  #undef CMASK
  #define CMASK(P0,P1,t) do{}while(0)
  for(;t+5<NT;t+=2){
    STEP(pB0,pB1,pA0,pA1,t,true,true,true);     WAIT_BAR(2); RESC(); ROT();
    STEP(pA0,pA1,pB0,pB1,t+1,true,true,true);   WAIT_BAR(2); RESC(); ROT();
  }
  #undef CMASK
  #define CMASK(P0,P1,t) do{}while(0)
  #define ENDW(tt) do{ if((tt)+3<NT){WAIT_BAR(2);} else if((tt)+2<NT){WAIT_BAR(1);} else {WAIT_BAR(0);} }while(0)
  for(;t+1<NT;t+=2){
    STEP(pB0,pB1,pA0,pA1,t,(t+3<NT),(t+1<NT),(t+1<NT));       ENDW(t);   RESC(); ROT();
    STEP(pA0,pA1,pB0,pB1,t+1,(t+4<NT),(t+2<NT),(t+2<NT));     ENDW(t+1); RESC(); ROT();
  }
  STEP(pB0,pB1,pA0,pA1,NT-1,false,false,false); RESC();
  { float sacc=pB0[0]+pB0[1]; _Pragma("unroll") for(int r=2;r<16;++r)sacc+=pB0[r]; _Pragma("unroll") for(int r=0;r<16;++r)sacc+=pB1[r]; l_reg+=sacc;
    pw0=(u32x4){PKW(pB0,0),PKW(pB0,2),PKW(pB0,4),PKW(pB0,6)};pw1=(u32x4){PKW(pB0,8),PKW(pB0,10),PKW(pB0,12),PKW(pB0,14)};pw2=(u32x4){PKW(pB1,0),PKW(pB1,2),PKW(pB1,4),PKW(pB1,6)};pw3=(u32x4){PKW(pB1,8),PKW(pB1,10),PKW(pB1,12),PKW(pB1,14)};
    SBAR(); pv(o,vb0+sl_cur,PAF(0),PAF(1),PAF(2),PAF(3)); }
  #undef PKW
  #undef PAF
  #undef VFR
  #undef PIN
  #undef MX3
  #undef GAPA
  #undef GAPB
  #undef EX
  #undef VRD
  #undef KRD
  #undef STEP
  #undef ENDW
  {auto rr=__builtin_amdgcn_permlane32_swap(__float_as_uint(l_reg),__float_as_uint(l_reg),false,false);l_reg=__uint_as_float(rr[0])+__uint_as_float(rr[1]);}
  if(hi==0)wsf[32+r32]=l_reg;asm volatile("s_waitcnt lgkmcnt(0)":::"memory");
  float rli[16];
  #pragma unroll
  for(int r=0;r<16;++r)rli[r]=__builtin_amdgcn_rcpf(wsf[32+crow(r,hi)]);
  bf16*Ow=O+(rowbase+q0+wid*QBLK)*QP+h*D;
  { bf16*stg=(bf16*)(shm+LDS_OST)+wid*2048;
    #pragma unroll
    for(int r=0;r<16;++r){const int orow=crow(r,hi);
      #pragma unroll
      for(int d0=0;d0<2;++d0)stg[orow*64+d0*32+r32]=__float2bfloat16(o[d0][r]*rli[r]);}
    asm volatile("s_waitcnt lgkmcnt(0)":::"memory");
    #pragma unroll
    for(int i=0;i<4;++i){const int row=i*8+(lane>>3),ch=lane&7; const u32x4 v=*(const u32x4*)(stg+row*64+ch*8); ATTN_STORE16(Ow+(long)row*QP+ch*8,v);} }
  asm volatile("s_waitcnt lgkmcnt(0)\n\ts_barrier":::"memory");
  #undef DMA_K
  #undef DMA_V
  #undef CMASK
  #undef START
  #undef RESC
  #undef ROT
}
constexpr int ATTN_LDS_BYTES=LDS_BYTES;
#undef SBAR
#undef WAIT_BAR
}

#ifndef NAIVE_ATTN
#define NAIVE_ATTN 0
#endif
__device__ __forceinline__ void attn_convert(const Params& p, unsigned char* lds) {
    const int tid = tid_opaque(), lane = tid & 63, wave = tid >> 6;
    phase_tr_range(p, (float*)lds + wave * (64 * 33), lane, TR_WIN, W13_IN_WOUT ? TR_EARLY : TR_W2, (int)blockIdx.x * 8 + wave, (int)gridDim.x * 8);
    __syncthreads();
}
__device__ __forceinline__ void phase_attn(const Params& p, unsigned char* lds) {
    const int G = gridDim.x, bx = blockIdx.x, vcu = (G % 8 == 0) ? (bx % 8) * (G / 8) + bx / 8 : bx;
    attn_body::bf16* QO = (attn_body::bf16*)(p.ws + WS_QO); const attn_body::bf16* Kb = (const attn_body::bf16*)(p.ws + WS_K); const attn_body::bf16* Vb = (const attn_body::bf16*)(p.ws + WS_V);
    constexpr int NU = BATCH * NQH * (SEQ / 256);
    const int nmine = (NU - vcu + G - 1) / G, slot = (vcu & 3) < nmine ? (vcu & 3) : 0;
    int i = 0;
    for (int u = vcu; u < NU; u += G, ++i) {
        if (i == slot) { attn_convert(p, lds); }
        const int bk = u >> 6, x = u & 63, b = bk >> 1, h = (bk & 1) * 4 + (x >> 4), qb = x & 15;
        attn_body::attn_unit<8>(b, h, qb, QO, Kb, Vb, QO, (char*)lds, p.q_norm_w);
    }
}

#ifndef RELAX_P1
#define RELAX_P1 true
#endif
#ifndef RELAX_WOUT
#define RELAX_WOUT true
#endif
#ifndef RELAX_MERGED
#define RELAX_MERGED true
#endif
#ifndef RELAX_MOE1
#define RELAX_MOE1 true
#endif
#ifndef RELAX_MOE2
#define RELAX_MOE2 false
#endif
#ifndef PG8_ASM_DMA
#define PG8_ASM_DMA 1
#endif
__device__ __forceinline__ void pg8_dma16(const void* sbase, unsigned voff, unsigned ldsaddr) { unsigned keep;
    asm volatile("s_mov_b32 %0, m0\n\ts_mov_b32 m0, %3\n\ts_nop 0\n\tglobal_load_lds_dwordx4 %1, %2\n\ts_mov_b32 m0, %0" : "=&s"(keep) : "v"(voff), "s"(sbase), "s"(ldsaddr) : "memory"); }
namespace pg8 {
constexpr int BM = 256, BK = 64, HALF = 128, HTB = HALF * BK * 2  , STAGE_BYTES = 8 * HTB, NXCD = 8, WGM = 8;
__host__ __device__ __forceinline__ int lds_byte(int r, int c) { const int st = (r >> 4) * 2 + (c >> 5), rr = r & 15, cc = c & 31, ob = rr * 64 + cc * 2; return st * 1024 + (ob ^ (((ob >> 9) & 1) << 5)); }
__host__ __device__ __forceinline__ void stage_rc(int b, int& R, int& C) { const int st = b / 1024, sb = b % 1024, swz = sb ^ (((sb >> 9) & 1) << 5); R = (st >> 1) * 16 + swz / 64; C = (st & 1) * 32 + (swz % 64) / 2; }
__host__ __device__ __forceinline__ int perm32(int rho) { const int n = rho >> 4, i = rho & 15; return 8 * (i >> 2) + 4 * n + (i & 3); }
struct Unit { int pm, pn, aux; };
#ifndef P1_WGM
#define P1_WGM 16
#endif
struct StaticOrder {
    int nM, nN, nwg, G, c;
    __host__ __device__ void init(int M, int N, int G_, int c_) { nM = M / BM; nN = N / BM; nwg = nM * nN; G = G_; c = c_; }
    __host__ __device__ bool next(int i, Unit& u) const {
        const long L = (long)i * G + c; if (L >= nwg) return false;
        int wgid = (int)L; { const int q = nwg / NXCD, r = nwg % NXCD, xcd = wgid % NXCD, off = wgid / NXCD; wgid = (xcd < r ? xcd * (q + 1) : r * (q + 1) + (xcd - r) * q) + off; }
        const int nig = P1_WGM * nN, gid = wgid / nig, fm = gid * P1_WGM, gsz = (nM - fm) < P1_WGM ? (nM - fm) : P1_WGM;
        u.pm = fm + ((wgid % nig) % gsz); u.pn = (wgid % nig) / gsz; u.aux = 0; return true;
    }
};
__device__ __forceinline__ unsigned cvt_pk_bf16(float lo, float hi) { return gm2::cvt_pk_bf16(lo, hi); }
template <class Epi, class Sched, bool ALIGN_EPI = false, bool SP2 = false, bool RELAX = false>
__device__ __forceinline__ void gemm_phase(PG8_LAS unsigned char* lds, const int K, const Sched& S, const Epi& E) {
    int tid_ = threadIdx.x; asm volatile("" : "+v"(tid_));
    const int tid = tid_, wid = __builtin_amdgcn_readfirstlane(tid >> 6), lane = tid & 63, wr = wid >> 2, wc = wid & 3, fr = lane & 15, fq = lane >> 4;
    const int nt = K / BK;
    unsigned voffA[2], voffB[2];
#pragma unroll
    for (int i = 0; i < 2; ++i) { int R, C; stage_rc(tid * 16 + i * 8192, R, C); const int Rb = Epi::PERM ? ((R & ~31) + perm32(R & 31)) : R;
        voffA[i] = (unsigned)(R * K + C) * 2u; voffB[i] = (unsigned)(Rb * K + C) * 2u; }
    const size_t kstep = (size_t)(BK * 2);
    const size_t hstep = (size_t)HALF * K * 2;
    const unsigned ldsw = (unsigned)wid * 1024u;
    const int aoff = lds_byte(wr * 64 + fr, fq * 8), boff = lds_byte(wc * 32 + fr, fq * 8);
#define PG8_SA(b, h) (((b) * 2 + (h)) * HTB)
#define PG8_SB(b, h) ((4 + (b) * 2 + (h)) * HTB)
#if PG8_ASM_DMA
#define PG8_STAGE(bufoff, gbase, voff) do { _Pragma("unroll") for (int _i = 0; _i < 2; ++_i) \
        pg8_dma16((const void*)(gbase), (voff)[_i], (unsigned)(size_t)(lds + (bufoff) + ldsw + _i * 8192)); } while (0)
#else
#define PG8_STAGE(bufoff, gbase, voff) do { _Pragma("unroll") for (int _i = 0; _i < 2; ++_i) \
        __builtin_amdgcn_global_load_lds((const unsigned*)((const char*)(gbase) + (voff)[_i]), (PG8_LAS unsigned*)(lds + (bufoff) + ldsw + _i * 8192), 16, 0, 0); } while (0)
#endif
#define PG8_LDA(dst, b, h) do { _Pragma("unroll") for (int m = 0; m < 4; ++m) _Pragma("unroll") for (int k = 0; k < 2; ++k) dst[m][k] = *(const PG8_LAS bf16x8*)(lds + PG8_SA(b, h) + aoff + m * 2048 + k * 1024); } while (0)
#define PG8_LDB(dst, b, h) do { _Pragma("unroll") for (int n = 0; n < 2; ++n) _Pragma("unroll") for (int k = 0; k < 2; ++k) dst[n][k] = *(const PG8_LAS bf16x8*)(lds + PG8_SB(b, h) + boff + n * 2048 + k * 1024); } while (0)
#define PG8_MMA(ai, bj, At, Bt) do { __builtin_amdgcn_s_setprio(1); _Pragma("unroll") for (int m = 0; m < 4; ++m) _Pragma("unroll") for (int n = 0; n < 2; ++n) _Pragma("unroll") for (int k = 0; k < 2; ++k) \
        acc[ai][bj][m][n] = __builtin_amdgcn_mfma_f32_16x16x32_bf16(Bt[n][k], At[m][k], acc[ai][bj][m][n], 0, 0, 0); __builtin_amdgcn_s_setprio(0); } while (0)
#define PG8_WAIT_V(n) asm volatile("s_waitcnt vmcnt(" #n ")" ::: "memory")
#define PG8_WAIT_VR asm volatile("s_waitcnt vmcnt(%0)" :: "n"(8 + (Epi::VMOPS > 55 ? 55 : Epi::VMOPS)) : "memory")
#define PG8_WAIT_L(n) asm volatile("s_waitcnt lgkmcnt(" #n ")" ::: "memory")
#define PG8_BAR __builtin_amdgcn_s_barrier()
#define PG8_SCHED __builtin_amdgcn_sched_barrier(0)
    Unit cur, nxt; int ui = 0;
    if (!S.next(0, cur)) return;
    f32x4 acc[2][2][4][2];
#pragma unroll
    for (int a = 0; a < 2; ++a)
#pragma unroll
        for (int b = 0; b < 2; ++b)
#pragma unroll
            for (int m = 0; m < 4; ++m)
#pragma unroll
                for (int n = 0; n < 2; ++n) acc[a][b][m][n] = (f32x4){0.f, 0.f, 0.f, 0.f};
    bf16x8 At[4][2], B0[2][2], B1[2][2];
    const char* cA = S.abase(cur); const char* cB = S.bbase(cur);
    if constexpr (SP2) {
        PG8_STAGE(PG8_SB(0, 0), cB, voffB); PG8_STAGE(PG8_SB(0, 1), cB + hstep, voffB); PG8_STAGE(PG8_SA(0, 0), cA, voffA); PG8_STAGE(PG8_SA(0, 1), cA + hstep, voffA);
        if (wr == 1) PG8_BAR;
        PG8_WAIT_V(2); PG8_BAR;
        PG8_STAGE(PG8_SB(1, 0), cB + kstep, voffB); PG8_STAGE(PG8_SA(1, 0), cA + kstep, voffA); PG8_STAGE(PG8_SB(1, 1), cB + hstep + kstep, voffB);
        if constexpr (RELAX) { PG8_WAIT_V(0); } else { PG8_WAIT_V(6); } PG8_BAR;
    } else {
        PG8_STAGE(PG8_SB(0, 0), cB, voffB); PG8_STAGE(PG8_SA(0, 0), cA, voffA); PG8_STAGE(PG8_SB(0, 1), cB + hstep, voffB); PG8_STAGE(PG8_SA(0, 1), cA + hstep, voffA);
        if (wr == 1) PG8_BAR;
        PG8_WAIT_V(4); PG8_BAR;
        PG8_STAGE(PG8_SB(1, 0), cB + kstep, voffB); PG8_STAGE(PG8_SA(1, 0), cA + kstep, voffA); PG8_STAGE(PG8_SB(1, 1), cB + hstep + kstep, voffB);
        PG8_WAIT_V(6); PG8_BAR;
    }
    for (;;) {
        const bool has_next = S.next(ui + 1, nxt);
        const char* nA = has_next ? S.abase(nxt) : cA; const char* nB = has_next ? S.bbase(nxt) : cB;
#define PG8_ITER(t, last, WV) do { \
            const char* a1 = cA + (size_t)((t) + 1) * kstep; \
            const char* a2 = (last) ? nA : cA + (size_t)((t) + 2) * kstep; const char* b2 = (last) ? nB : cB + (size_t)((t) + 2) * kstep; \
            const char* a3 = a2 + kstep; const char* b3 = b2 + kstep; \
            PG8_LDB(B0, 0, 0); PG8_LDB(B1, 0, 1); PG8_SCHED; PG8_LDA(At, 0, 0); PG8_STAGE(PG8_SA(1, 1), a1 + hstep, voffA); \
            WV; PG8_WAIT_L(0); PG8_BAR; PG8_MMA(0, 0, At, B0); PG8_MMA(0, 1, At, B1); PG8_BAR; PG8_SCHED; \
            PG8_LDA(At, 0, 1); PG8_STAGE(PG8_SB(0, 0), b2, voffB); PG8_STAGE(PG8_SB(0, 1), b2 + hstep, voffB); PG8_STAGE(PG8_SA(0, 0), a2, voffA); \
            WV; PG8_WAIT_L(0); PG8_BAR; PG8_MMA(1, 0, At, B0); PG8_MMA(1, 1, At, B1); PG8_BAR; PG8_SCHED; \
            PG8_LDB(B0, 1, 0); PG8_LDB(B1, 1, 1); PG8_SCHED; PG8_LDA(At, 1, 0); PG8_STAGE(PG8_SA(0, 1), a2 + hstep, voffA); \
            PG8_WAIT_V(8); PG8_WAIT_L(0); PG8_BAR; PG8_MMA(0, 0, At, B0); PG8_MMA(0, 1, At, B1); PG8_BAR; PG8_SCHED; \
            PG8_LDA(At, 1, 1); PG8_STAGE(PG8_SB(1, 0), b3, voffB); PG8_STAGE(PG8_SB(1, 1), b3 + hstep, voffB); PG8_STAGE(PG8_SA(1, 0), a3, voffA); \
            PG8_WAIT_V(8); PG8_WAIT_L(0); PG8_BAR; PG8_MMA(1, 0, At, B0); PG8_MMA(1, 1, At, B1); PG8_BAR; PG8_SCHED; } while (0)
        static_assert(SP2, "only the SP2 loop is kept");
        if constexpr (RELAX) { PG8_ITER(0, false, PG8_WAIT_VR); for (int t = 2; t < nt; t += 2) { const bool last = (t == nt - 2); PG8_ITER(t, last, PG8_WAIT_V(8)); } }
        else { for (int t = 0; t < nt; t += 2) { const bool last = (t == nt - 2); PG8_ITER(t, last, PG8_WAIT_V(8)); } }
#undef PG8_ITER
        if constexpr (ALIGN_EPI) { if (wr == 0) PG8_BAR; }
        if constexpr (!Epi::AFTER_DRAIN) { int fr2 = fr, fq2 = fq; asm volatile("" : "+v"(fr2), "+v"(fq2)); E(acc, cur, wr, wc, fr2, fq2); }
        if (!has_next) break;
#pragma unroll
        for (int a = 0; a < 2; ++a)
#pragma unroll
            for (int b = 0; b < 2; ++b)
#pragma unroll
                for (int m = 0; m < 4; ++m)
#pragma unroll
                    for (int n = 0; n < 2; ++n) acc[a][b][m][n] = (f32x4){0.f, 0.f, 0.f, 0.f};
        cur = nxt; cA = nA; cB = nB; ++ui;
        if constexpr (ALIGN_EPI) { if (wr == 1) PG8_BAR; }
    }
    PG8_WAIT_V(0);
    if constexpr (!ALIGN_EPI) { if (wr == 0) PG8_BAR; }
    PG8_BAR;
    if constexpr (Epi::AFTER_DRAIN) { E.fused(acc, cur, wr, wc, fr, fq, lds, wid, lane); }
#undef PG8_SA
#undef PG8_SB
#undef PG8_STAGE
#undef PG8_LDA
#undef PG8_LDB
#undef PG8_MMA
#undef PG8_WAIT_V
#undef PG8_WAIT_VR
#undef PG8_WAIT_L
#undef PG8_BAR
#undef PG8_SCHED
}

struct SchedProj {
    StaticOrder so; const char* A; const char* B; size_t tstep;
    __device__ __forceinline__ bool next(int i, Unit& u) const { return so.next(i, u); }
    __device__ __forceinline__ const char* abase(const Unit& u) const { return A + (size_t)u.pm * tstep; }
    __device__ __forceinline__ const char* bbase(const Unit& u) const { return B + (size_t)u.pn * tstep; }
};
struct SchedMerged {
    int vcu, G; const char *A0, *A1, *B0, *B1; size_t tstep;
    __device__ __forceinline__ bool next(int i, Unit& u) const { const int tile = vcu + (i >> 1) * G; if (tile >= 512) return false; u.pm = tile >> 2; u.pn = tile & 3; u.aux = i & 1; return true; }
    __device__ __forceinline__ const char* abase(const Unit& u) const { return (u.aux ? A1 : A0) + (size_t)u.pm * tstep; }
    __device__ __forceinline__ const char* bbase(const Unit& u) const { return (u.aux ? B1 : B0) + (size_t)u.pn * tstep; }
};
struct SchedWout {
    int vcu, G; const char *A, *B; size_t tstep;
    __device__ __forceinline__ bool next(int i, Unit& u) const { const int tile = vcu + i * G; if (tile >= 512) return false; u.pm = tile >> 2; u.pn = tile & 3; u.aux = 0; return true; }
    __device__ __forceinline__ const char* abase(const Unit& u) const { return A + (size_t)u.pm * tstep; }
    __device__ __forceinline__ const char* bbase(const Unit& u) const { return B + (size_t)u.pn * tstep; }
};
__device__ __forceinline__ void pair_of2(int pidx, int& a, int& b) { a = pidx < 3 ? 0 : (pidx < 5 ? 1 : 2); b = pidx < 3 ? pidx + 1 : (pidx < 5 ? pidx - 1 : 3); }
struct SchedMoe1 {
    int vcu, G, ntile; const int* tbk; const char *A, *W13; size_t tstep;
    __device__ __forceinline__ bool next(int i, Unit& u) const { const int uid = vcu + i * G; if (uid >= ntile * 8) return false; u.pm = uid >> 3; u.pn = uid & 7; u.aux = __builtin_amdgcn_readfirstlane(tbk[u.pm]); return true; }
    __device__ __forceinline__ const char* abase(const Unit& u) const { return A + (size_t)u.pm * tstep; }
    __device__ __forceinline__ const char* bbase(const Unit& u) const { const int g = u.aux / 6; int a, b; pair_of2(u.aux % 6, a, b); const int e = g * 4 + (u.pn < 4 ? a : b);
        return W13 + ((size_t)e * 1024 + (size_t)(u.pn & 3) * 256) * (1024 * 2); }
};
struct SchedMoe2 {
    int vcu, G, ntile; const int* tbk; const char *A, *W2P; size_t tstep;
    __device__ __forceinline__ bool next(int i, Unit& u) const { const int uid = vcu + i * G; if (uid >= ntile * 4) return false; u.pm = uid >> 2; u.pn = uid & 3; u.aux = __builtin_amdgcn_readfirstlane(tbk[u.pm]); return true; }
    __device__ __forceinline__ const char* abase(const Unit& u) const { return A + (size_t)u.pm * tstep; }
    __device__ __forceinline__ const char* bbase(const Unit& u) const { return W2P + ((size_t)u.aux * 1024 + (size_t)u.pn * 256) * (1024 * 2); }
};

typedef float f32x2 __attribute__((ext_vector_type(2)));
__device__ __forceinline__ float silu_e(float v) { return v * __builtin_amdgcn_rcpf(1.f + __builtin_amdgcn_exp2f(-1.4426950408889634f * v)); }
__device__ __forceinline__ float sigm_e(float v) { return __builtin_amdgcn_rcpf(1.f + __builtin_amdgcn_exp2f(-1.4426950408889634f * v)); }
struct EpiInProj {
    static constexpr bool PERM = true, AFTER_DRAIN = false; static constexpr int VMOPS = 12;
    bf16_t *QO, *Kb, *Vb, *Z, *XBC, *G; float* DT; const float* b_gate; const float* dt_bias;
    __device__ __forceinline__ void operator()(const f32x4 (&acc)[2][2][4][2], const Unit& u, int wr, int wc, int fr, int fq) const {
        const int row0 = u.pm * BM + wr * 64 + fr, pn = u.pn, lc = wc * 32 + 8 * fq;
        if (pn >= 8) {
            const int colt = (pn - 8) * BM + lc;
            f32x4 bv[2][2];
#pragma unroll
            for (int bj = 0; bj < 2; ++bj)
#pragma unroll
                for (int n = 0; n < 2; ++n) bv[bj][n] = *(const f32x4*)(b_gate + colt + bj * HALF + 4 * n);
#pragma unroll
            for (int ai = 0; ai < 2; ++ai)
#pragma unroll
                for (int mp = 0; mp < 2; ++mp)
#pragma unroll
                    for (int bj = 0; bj < 2; ++bj) { unsigned qq[2][2];
#pragma unroll
                        for (int mm = 0; mm < 2; ++mm) { const f32x4 v0 = acc[ai][bj][2 * mp + mm][0] + bv[bj][0], v1 = acc[ai][bj][2 * mp + mm][1] + bv[bj][1];
                            unsigned q0 = 0u, q1 = 0u;
#pragma unroll
                            for (int e = 0; e < 4; ++e) { q0 |= (unsigned)__builtin_rintf(255.f * sigm_e(v0[e])) << (8 * e); q1 |= (unsigned)__builtin_rintf(255.f * sigm_e(v1[e])) << (8 * e); }
                            qq[mm][0] = q0; qq[mm][1] = q1; }
                        auto r0 = __builtin_amdgcn_permlane16_swap(qq[0][0], qq[1][0], false, false); auto r1 = __builtin_amdgcn_permlane16_swap(qq[0][1], qq[1][1], false, false);
                        const u32x4 w = {(unsigned)r0[0], (unsigned)r1[0], (unsigned)r0[1], (unsigned)r1[1]};
                        unsigned char* dst = (unsigned char*)G + (size_t)(row0 + ai * HALF + (2 * mp + (fq & 1)) * 16) * 2048 + (pn - 8) * BM + wc * 32 + 8 * (fq & ~1) + bj * HALF;
                        *(u32x4*)dst = w; }
            return;
        }
        bf16_t* base0; bf16_t* base1; int ld;
        if (pn < 2) { base0 = QO + pn * BM + lc; base1 = base0 + HALF; ld = 512; }
        else if (pn == 2) { base0 = Kb + lc; base1 = Vb + lc; ld = 128; }
        else if (pn < 5) { base0 = Z + (pn - 3) * BM + lc; base1 = base0 + HALF; ld = 512; }
        else { base0 = XBC + (pn - 5) * BM + lc; base1 = base0 + HALF; ld = 768; }
        const bool act = (pn == 3 || pn == 4);
#pragma unroll
        for (int ai = 0; ai < 2; ++ai)
#pragma unroll
            for (int m = 0; m < 4; ++m) { const size_t ro = (size_t)(row0 + ai * HALF + m * 16) * ld;
#pragma unroll
                for (int bj = 0; bj < 2; ++bj) { f32x4 v0 = acc[ai][bj][m][0], v1 = acc[ai][bj][m][1];
                    if (act) {
#pragma unroll
                        for (int e = 0; e < 4; ++e) { v0[e] = silu_e(v0[e]); v1[e] = silu_e(v1[e]); } }
                    u32x4 w; w.x = cvt_pk_bf16(v0[0], v0[1]); w.y = cvt_pk_bf16(v0[2], v0[3]); w.z = cvt_pk_bf16(v1[0], v1[1]); w.w = cvt_pk_bf16(v1[2], v1[3]);
                    *(u32x4*)((bj ? base1 : base0) + ro) = w; } }
    }
};
__device__ __forceinline__ float bflo(unsigned w) { return __builtin_bit_cast(float, w << 16); }
__device__ __forceinline__ float bfhi(unsigned w) { return __builtin_bit_cast(float, w & 0xffff0000u); }
struct EpiMerged {
    static constexpr bool PERM = true, AFTER_DRAIN = false;
    const bf16_t* G; bf16_t* MG;
    __device__ __forceinline__ void operator()(const f32x4 (&acc)[2][2][4][2], const Unit& u, int wr, int wc, int fr, int fq) const {
        const int row0 = u.pm * BM + wr * 64 + fr, col0 = u.pn * BM + wc * 32 + 8 * fq, goff = u.aux ? 0 : 1024;
#pragma unroll
        for (int ai = 0; ai < 2; ++ai)
#pragma unroll
            for (int m = 0; m < 4; ++m) { const size_t row = (size_t)(row0 + ai * HALF + m * 16);
#pragma unroll
                for (int bj = 0; bj < 2; ++bj) { const int col = col0 + bj * HALF;
                    const u32x2 gv = *(const u32x2*)((const unsigned char*)G + row * 2048 + goff + col);
                    f32x4 v0 = acc[ai][bj][m][0], v1 = acc[ai][bj][m][1];
#pragma unroll
                    for (int e = 0; e < 4; ++e) { v0[e] *= (float)((gv.x >> (8 * e)) & 0xffu) * (1.f / 255.f); v1[e] *= (float)((gv.y >> (8 * e)) & 0xffu) * (1.f / 255.f); }
                    bf16_t* dst = MG + row * 1024 + col;
                    if (u.aux) { const u32x4 ov = *(const u32x4*)dst;
                        v0[0] += bflo(ov.x); v0[1] += bfhi(ov.x); v0[2] += bflo(ov.y); v0[3] += bfhi(ov.y); v1[0] += bflo(ov.z); v1[1] += bfhi(ov.z); v1[2] += bflo(ov.w); v1[3] += bfhi(ov.w); }
                    u32x4 w; w.x = cvt_pk_bf16(v0[0], v0[1]); w.y = cvt_pk_bf16(v0[2], v0[3]); w.z = cvt_pk_bf16(v1[0], v1[1]); w.w = cvt_pk_bf16(v1[2], v1[3]);
                    *(u32x4*)dst = w; } }
    }
};
struct EpiWout {
    static constexpr bool PERM = true, AFTER_DRAIN = false; static constexpr int VMOPS = 48;
    const float* x; bf16_t* X1;
    __device__ __forceinline__ void operator()(const f32x4 (&acc)[2][2][4][2], const Unit& u, int wr, int wc, int fr, int fq) const {
        const int row0 = u.pm * BM + wr * 64 + fr, col0 = u.pn * BM + wc * 32 + 8 * fq;
#pragma unroll
        for (int ai = 0; ai < 2; ++ai) {
            f32x4 xv[4][2][2];
#pragma unroll
            for (int m = 0; m < 4; ++m) { const size_t off = (size_t)(row0 + ai * HALF + m * 16) * 1024 + col0;
#pragma unroll
                for (int bj = 0; bj < 2; ++bj) { xv[m][bj][0] = *(const f32x4*)(x + off + bj * HALF); xv[m][bj][1] = *(const f32x4*)(x + off + bj * HALF + 4); } }
            __builtin_amdgcn_sched_barrier(0);
#pragma unroll
            for (int m = 0; m < 4; ++m) { const size_t off = (size_t)(row0 + ai * HALF + m * 16) * 1024 + col0;
#pragma unroll
                for (int bj = 0; bj < 2; ++bj) { const f32x4 v0 = xv[m][bj][0] + acc[ai][bj][m][0], v1 = xv[m][bj][1] + acc[ai][bj][m][1];
                    u32x4 w; w.x = cvt_pk_bf16(v0[0], v0[1]); w.y = cvt_pk_bf16(v0[2], v0[3]); w.z = cvt_pk_bf16(v1[0], v1[1]); w.w = cvt_pk_bf16(v1[2], v1[3]);
                    *(u32x4*)(X1 + off + bj * HALF) = w; } }
            asm volatile("" ::: "memory");
            __builtin_amdgcn_sched_barrier(0);
        }
    }
};
struct EpiMoe1 {
    static constexpr bool PERM = true, AFTER_DRAIN = false, HAS_MID = false; static constexpr int MID_T = 0; static constexpr int VMOPS = 24;
    bf16_t* HID; const float* SWA; const float* SWB; const float* SRS;
    __device__ __forceinline__ void operator()(const f32x4 (&acc)[2][2][4][2], const Unit& u, int wr, int wc, int fr, int fq) const {
        const int row0 = u.pm * BM + wr * 64 + fr, slot = u.pn >> 2, hc = slot * 512 + (u.pn & 3) * 128 + 16 * wc + 4 * fq;
        const float* SW = slot ? SWB : SWA;
        float wrow[2][4], rrow[2][4];
#pragma unroll
        for (int ai = 0; ai < 2; ++ai)
#pragma unroll
            for (int m = 0; m < 4; ++m) { wrow[ai][m] = SW[row0 + ai * HALF + m * 16]; rrow[ai][m] = SRS[row0 + ai * HALF + m * 16]; }
        __builtin_amdgcn_sched_barrier(0);
#pragma unroll
        for (int ai = 0; ai < 2; ++ai)
#pragma unroll
            for (int mp = 0; mp < 2; ++mp)
#pragma unroll
                for (int bj = 0; bj < 2; ++bj) { u32x2 oo[2];
#pragma unroll
                    for (int mm = 0; mm < 2; ++mm) { const int m = 2 * mp + mm; const float rs = rrow[ai][m], w = wrow[ai][m] * rs; const f32x4 v0 = acc[ai][bj][m][0], v1 = acc[ai][bj][m][1];
                        float h0 = w * silu_e(rs * v0[0]) * v0[1], h1 = w * silu_e(rs * v0[2]) * v0[3], h2 = w * silu_e(rs * v1[0]) * v1[1], h3 = w * silu_e(rs * v1[2]) * v1[3];
                        if (w == 0.f) { h0 = 0.f; h1 = 0.f; h2 = 0.f; h3 = 0.f; }
                        oo[mm].x = cvt_pk_bf16(h0, h1); oo[mm].y = cvt_pk_bf16(h2, h3); }
                    auto r0 = __builtin_amdgcn_permlane16_swap(oo[0].x, oo[1].x, false, false); auto r1 = __builtin_amdgcn_permlane16_swap(oo[0].y, oo[1].y, false, false);
                    const u32x4 wv = {(unsigned)r0[0], (unsigned)r1[0], (unsigned)r0[1], (unsigned)r1[1]};
                    const size_t row = (size_t)(row0 + ai * HALF + (2 * mp + (fq & 1)) * 16);
                    *(u32x4*)(HID + row * 1024 + slot * 512 + (u.pn & 3) * 128 + 16 * wc + 4 * (fq & ~1) + 64 * bj) = wv; }
    }
};
struct EpiMoe2 {
    static constexpr bool PERM = false, AFTER_DRAIN = false, HAS_MID = false; static constexpr int MID_T = 0; static constexpr int VMOPS = 32;
    float* out; const int* perm; const bf16_t* X1;
    __device__ __forceinline__ void operator()(const f32x4 (&acc)[2][2][4][2], const Unit& u, int wr, int wc, int fr, int fq) const {
        const int row0 = u.pm * BM + wr * 64 + fr, col0 = u.pn * BM + wc * 32 + 4 * fq;
        int tok[2][4];
#pragma unroll
        for (int ai = 0; ai < 2; ++ai)
#pragma unroll
            for (int m = 0; m < 4; ++m) { const int P = (u.aux >> 8) & 7, q = u.aux >> 12;
                const bool mine = (P <= 1) || (P == 2 ? ai == q : (ai == (q >> 1) && (m >> 1) == (q & 1)));
                tok[ai][m] = mine ? perm[row0 + ai * HALF + m * 16] : -1; }
#pragma unroll
        for (int ai = 0; ai < 2; ++ai) {
            u32x2 xv[4][2][2];
#pragma unroll
            for (int m = 0; m < 4; ++m) { const size_t off = (size_t)(tok[ai][m] < 0 ? 0 : tok[ai][m]) * 1024 + col0;
#pragma unroll
                for (int bj = 0; bj < 2; ++bj)
#pragma unroll
                    for (int n = 0; n < 2; ++n) xv[m][bj][n] = *(const u32x2*)(X1 + off + bj * HALF + n * 16); }
#pragma unroll
            for (int m = 0; m < 4; ++m) { if (tok[ai][m] >= 0) { const size_t off = (size_t)tok[ai][m] * 1024 + col0;
#pragma unroll
                for (int bj = 0; bj < 2; ++bj)
#pragma unroll
                    for (int n = 0; n < 2; ++n) { const u32x2 x = xv[m][bj][n];
                        const f32x4 r = {bflo(x.x) + acc[ai][bj][m][n][0], bfhi(x.x) + acc[ai][bj][m][n][1], bflo(x.y) + acc[ai][bj][m][n][2], bfhi(x.y) + acc[ai][bj][m][n][3]};
                        *(f32x4*)(out + off + bj * HALF + n * 16) = r; } } }
            asm volatile("" ::: "memory");
        }
    }
};
template <class Epi, class Sched, bool ALIGN_EPI = false, bool SP2 = false, bool GATHER = false, bool RELAX = false>
__device__ __forceinline__ void gemm_phase2(PG8_LAS unsigned char* lds, const int pitchA, const int pitchB, const int nt, const Sched& S, const Epi& E) {
    int tid_ = threadIdx.x; asm volatile("" : "+v"(tid_));
    const int tid = tid_, wid = __builtin_amdgcn_readfirstlane(tid >> 6), lane = tid & 63, wr = wid >> 2, wc = wid & 3, fr = lane & 15, fq = lane >> 4;
    unsigned voffA[2], voffB[2];
#pragma unroll
    for (int i = 0; i < 2; ++i) { int R, C; stage_rc(tid * 16 + i * 8192, R, C); const int Rb = Epi::PERM ? ((R & ~31) + perm32(R & 31)) : R;
        voffA[i] = (unsigned)(R * pitchA + C) * 2u; voffB[i] = (unsigned)(Rb * pitchB + C) * 2u; }
    unsigned uAc[2][2] = {{0u, 0u}, {0u, 0u}}, uAn[2][2] = {{0u, 0u}, {0u, 0u}};
    int gR[2], gC[2];
#pragma unroll
    for (int i = 0; i < 2; ++i) stage_rc(tid * 16 + i * 8192, gR[i], gC[i]);
#if PG8_ASM_DMA
#define PG8_DMA1(kptr, off32, boff) pg8_dma16((const void*)(kptr), (off32), (unsigned)(size_t)(lds + (boff) + ldsw))
#else
#define PG8_DMA1(kptr, off32, boff) __builtin_amdgcn_global_load_lds((const unsigned*)((const char*)(kptr) + (off32)), (PG8_LAS unsigned*)(lds + (boff) + ldsw), 16, 0, 0)
#endif
#define PG8_ROWOFFS(dst, un) do { if constexpr (GATHER) { _Pragma("unroll") for (int h_ = 0; h_ < 2; ++h_) _Pragma("unroll") for (int i_ = 0; i_ < 2; ++i_) \
        dst[h_][i_] = (unsigned)S.arow(un, h_ * HALF + gR[i_]) * (unsigned)(pitchA * 2) + (unsigned)(gC[i_] * 2); } } while (0)
#define PG8_STAGE_AH(bufoff, kptr, h, NEXT) do { if constexpr (GATHER) { _Pragma("unroll") for (int _i = 0; _i < 2; ++_i) \
        PG8_DMA1((kptr), ((NEXT) ? uAn[h][_i] : uAc[h][_i]), (bufoff) + _i * 8192); } \
      else { PG8_STAGE(bufoff, (const char*)(kptr) + ((h) ? hstepA : 0), voffA); } } while (0)
    const size_t kstep = (size_t)(BK * 2);
    const size_t hstepA = (size_t)HALF * pitchA * 2, hstepB = (size_t)HALF * pitchB * 2;
    const unsigned ldsw = (unsigned)wid * 1024u;
    const int aoff = lds_byte(wr * 64 + fr, fq * 8), boff = lds_byte(wc * 32 + fr, fq * 8);
#define PG8_SA(b, h) (((b) * 2 + (h)) * HTB)
#define PG8_SB(b, h) ((4 + (b) * 2 + (h)) * HTB)
#if PG8_ASM_DMA
#define PG8_STAGE(bufoff, gbase, voff) do { _Pragma("unroll") for (int _i = 0; _i < 2; ++_i) \
        pg8_dma16((const void*)(gbase), (voff)[_i], (unsigned)(size_t)(lds + (bufoff) + ldsw + _i * 8192)); } while (0)
#else
#define PG8_STAGE(bufoff, gbase, voff) do { _Pragma("unroll") for (int _i = 0; _i < 2; ++_i) \
        __builtin_amdgcn_global_load_lds((const unsigned*)((const char*)(gbase) + (voff)[_i]), (PG8_LAS unsigned*)(lds + (bufoff) + ldsw + _i * 8192), 16, 0, 0); } while (0)
#endif
#define PG8_LDA(dst, b, h) do { _Pragma("unroll") for (int m = 0; m < 4; ++m) _Pragma("unroll") for (int k = 0; k < 2; ++k) dst[m][k] = *(const PG8_LAS bf16x8*)(lds + PG8_SA(b, h) + aoff + m * 2048 + k * 1024); } while (0)
#define PG8_LDB(dst, b, h) do { _Pragma("unroll") for (int n = 0; n < 2; ++n) _Pragma("unroll") for (int k = 0; k < 2; ++k) dst[n][k] = *(const PG8_LAS bf16x8*)(lds + PG8_SB(b, h) + boff + n * 2048 + k * 1024); } while (0)
#define PG8_MMA(ai, bj, At, Bt) do { __builtin_amdgcn_s_setprio(1); _Pragma("unroll") for (int m = 0; m < 4; ++m) _Pragma("unroll") for (int n = 0; n < 2; ++n) _Pragma("unroll") for (int k = 0; k < 2; ++k) \
        acc[ai][bj][m][n] = __builtin_amdgcn_mfma_f32_16x16x32_bf16(Bt[n][k], At[m][k], acc[ai][bj][m][n], 0, 0, 0); __builtin_amdgcn_s_setprio(0); } while (0)
#define PG8_WAIT_V(n) asm volatile("s_waitcnt vmcnt(" #n ")" ::: "memory")
#define PG8_WAIT_VR asm volatile("s_waitcnt vmcnt(%0)" :: "n"(8 + (Epi::VMOPS > 55 ? 55 : Epi::VMOPS)) : "memory")
#define PG8_WAIT_L(n) asm volatile("s_waitcnt lgkmcnt(" #n ")" ::: "memory")
#define PG8_BAR __builtin_amdgcn_s_barrier()
#define PG8_SCHED __builtin_amdgcn_sched_barrier(0)
    Unit cur, nxt; int ui = 0;
    if (!S.next(0, cur)) return;
    f32x4 acc[2][2][4][2];
#pragma unroll
    for (int a = 0; a < 2; ++a)
#pragma unroll
        for (int b = 0; b < 2; ++b)
#pragma unroll
            for (int m = 0; m < 4; ++m)
#pragma unroll
                for (int n = 0; n < 2; ++n) acc[a][b][m][n] = (f32x4){0.f, 0.f, 0.f, 0.f};
    bf16x8 At[4][2], B0[2][2], B1[2][2];
    PG8_ROWOFFS(uAc, cur);
    const char* cA = S.aptr(cur, 0); const char* cB = S.bptr(cur, 0); const char* cA1 = S.aptr(cur, 1); const char* cB1 = S.bptr(cur, 1);
    if constexpr (SP2) {
        PG8_STAGE(PG8_SB(0, 0), cB, voffB); PG8_STAGE(PG8_SB(0, 1), cB + hstepB, voffB); PG8_STAGE_AH(PG8_SA(0, 0), cA, 0, false); PG8_STAGE_AH(PG8_SA(0, 1), cA, 1, false);
        if (wr == 1) PG8_BAR;
        PG8_WAIT_V(2); PG8_BAR;
        PG8_STAGE(PG8_SB(1, 0), cB1, voffB); PG8_STAGE_AH(PG8_SA(1, 0), cA1, 0, false); PG8_STAGE(PG8_SB(1, 1), cB1 + hstepB, voffB);
        if constexpr (RELAX) { PG8_WAIT_V(0); } else { PG8_WAIT_V(6); } PG8_BAR;
    } else {
        PG8_STAGE(PG8_SB(0, 0), cB, voffB); PG8_STAGE_AH(PG8_SA(0, 0), cA, 0, false); PG8_STAGE(PG8_SB(0, 1), cB + hstepB, voffB); PG8_STAGE_AH(PG8_SA(0, 1), cA, 1, false);
        if (wr == 1) PG8_BAR;
        PG8_WAIT_V(4); PG8_BAR;
        PG8_STAGE(PG8_SB(1, 0), cB1, voffB); PG8_STAGE_AH(PG8_SA(1, 0), cA1, 0, false); PG8_STAGE(PG8_SB(1, 1), cB1 + hstepB, voffB);
        PG8_WAIT_V(6); PG8_BAR;
    }
    for (;;) {
        const bool has_next = S.next(ui + 1, nxt);
        const Unit nu = has_next ? nxt : cur;
        int rawn[2][2] = {{0, 0}, {0, 0}};
        if constexpr (GATHER) { _Pragma("unroll") for (int h_ = 0; h_ < 2; ++h_) _Pragma("unroll") for (int i_ = 0; i_ < 2; ++i_) rawn[h_][i_] = S.arow_raw(nu, h_ * HALF + gR[i_]); }
        const char* nA = S.aptr(nu, 0); const char* nB = S.bptr(nu, 0); const char* nA1 = S.aptr(nu, 1); const char* nB1 = S.bptr(nu, 1);
#define PG8_ITER(t, last, WV) do { \
            if constexpr (Epi::HAS_MID) { if ((t) == Epi::MID_T) E.mid(acc, cur, wr, wc, fr, fq); } \
            const char* a1 = S.aptr(cur, (t) + 1); \
            const char* a2 = (last) ? nA : S.aptr(cur, (t) + 2); const char* b2 = (last) ? nB : S.bptr(cur, (t) + 2); \
            const char* a3 = (last) ? nA1 : S.aptr(cur, (t) + 3); const char* b3 = (last) ? nB1 : S.bptr(cur, (t) + 3); \
            PG8_LDB(B0, 0, 0); PG8_LDB(B1, 0, 1); PG8_SCHED; PG8_LDA(At, 0, 0); PG8_STAGE_AH(PG8_SA(1, 1), a1, 1, false); \
            WV; PG8_WAIT_L(0); PG8_BAR; PG8_MMA(0, 0, At, B0); PG8_MMA(0, 1, At, B1); PG8_BAR; PG8_SCHED; \
            PG8_LDA(At, 0, 1); PG8_STAGE(PG8_SB(0, 0), b2, voffB); PG8_STAGE(PG8_SB(0, 1), b2 + hstepB, voffB); PG8_STAGE_AH(PG8_SA(0, 0), a2, 0, last); \
            WV; PG8_WAIT_L(0); PG8_BAR; PG8_MMA(1, 0, At, B0); PG8_MMA(1, 1, At, B1); PG8_BAR; PG8_SCHED; \
            PG8_LDB(B0, 1, 0); PG8_LDB(B1, 1, 1); PG8_SCHED; PG8_LDA(At, 1, 0); PG8_STAGE_AH(PG8_SA(0, 1), a2, 1, last); \
            PG8_WAIT_V(8); PG8_WAIT_L(0); PG8_BAR; PG8_MMA(0, 0, At, B0); PG8_MMA(0, 1, At, B1); PG8_BAR; PG8_SCHED; \
            PG8_LDA(At, 1, 1); PG8_STAGE(PG8_SB(1, 0), b3, voffB); PG8_STAGE(PG8_SB(1, 1), b3 + hstepB, voffB); PG8_STAGE_AH(PG8_SA(1, 0), a3, 0, last); \
            PG8_WAIT_V(8); PG8_WAIT_L(0); PG8_BAR; PG8_MMA(1, 0, At, B0); PG8_MMA(1, 1, At, B1); PG8_BAR; PG8_SCHED; } while (0)
        static_assert(SP2, "only the SP2 loop is kept");
        if constexpr (GATHER) {
            if constexpr (RELAX) { PG8_ITER(0, false, PG8_WAIT_VR); for (int t = 2; t < nt - 2; t += 2) { PG8_ITER(t, false, PG8_WAIT_V(8)); } }
            else { for (int t = 0; t < nt - 2; t += 2) { PG8_ITER(t, false, PG8_WAIT_V(8)); } }
            asm volatile("" : "+v"(rawn[0][0]), "+v"(rawn[0][1]), "+v"(rawn[1][0]), "+v"(rawn[1][1]));
            _Pragma("unroll") for (int h_ = 0; h_ < 2; ++h_) _Pragma("unroll") for (int i_ = 0; i_ < 2; ++i_) { const int r_ = rawn[h_][i_]; uAn[h_][i_] = (unsigned)(r_ < 0 ? 0 : r_) * (unsigned)(pitchA * 2) + (unsigned)(gC[i_] * 2); }
            PG8_ITER(nt - 2, true, PG8_WAIT_V(8));
        } else {
            if constexpr (RELAX) { PG8_ITER(0, false, PG8_WAIT_VR); for (int t = 2; t < nt; t += 2) { const bool last = (t == nt - 2); PG8_ITER(t, last, PG8_WAIT_V(8)); } }
            else { for (int t = 0; t < nt; t += 2) { const bool last = (t == nt - 2); PG8_ITER(t, last, PG8_WAIT_V(8)); } }
        }
#undef PG8_ITER
        if constexpr (ALIGN_EPI) { if (wr == 0) PG8_BAR; }
        if constexpr (!Epi::AFTER_DRAIN) { int fr2 = fr, fq2 = fq; asm volatile("" : "+v"(fr2), "+v"(fq2)); E(acc, cur, wr, wc, fr2, fq2); }
        if (!has_next) break;
#pragma unroll
        for (int a = 0; a < 2; ++a)
#pragma unroll
            for (int b = 0; b < 2; ++b)
#pragma unroll
                for (int m = 0; m < 4; ++m)
#pragma unroll
                    for (int n = 0; n < 2; ++n) acc[a][b][m][n] = (f32x4){0.f, 0.f, 0.f, 0.f};
        cur = nxt; ++ui;
        if constexpr (GATHER) { _Pragma("unroll") for (int h_ = 0; h_ < 2; ++h_) _Pragma("unroll") for (int i_ = 0; i_ < 2; ++i_) uAc[h_][i_] = uAn[h_][i_]; }
        if constexpr (ALIGN_EPI) { if (wr == 1) PG8_BAR; }
    }
    PG8_WAIT_V(0);
    if constexpr (!ALIGN_EPI) { if (wr == 0) PG8_BAR; }
    PG8_BAR;
    if constexpr (Epi::AFTER_DRAIN) { E.fused(acc, cur, wr, wc, fr, fq, lds, wid, lane); }
#undef PG8_SA
#undef PG8_SB
#undef PG8_STAGE
#undef PG8_LDA
#undef PG8_LDB
#undef PG8_MMA
#undef PG8_WAIT_V
#undef PG8_WAIT_VR
#undef PG8_WAIT_L
#undef PG8_BAR
#undef PG8_SCHED
#undef PG8_ROWOFFS
#undef PG8_STAGE_AH
#undef PG8_DMA1
}


struct SchedMerged2 {
    int vcu, G; const char *A_attn, *A_ssd, *B_a, *B_s; size_t tstep;
    __device__ __forceinline__ bool next(int i, Unit& u) const { const int tile = vcu + i * G; if (tile >= 512) return false; u.pm = tile >> 2; u.pn = tile & 3; u.aux = 0; return true; }
    __device__ __forceinline__ const char* aptr(const Unit& u, int t) const { return (t < 8 ? A_attn : A_ssd) + (size_t)u.pm * tstep + (size_t)(t & 7) * (BK * 2); }
    __device__ __forceinline__ const char* bptr(const Unit& u, int t) const { return (t < 8 ? B_a : B_s) + (size_t)u.pn * tstep + (size_t)(t & 7) * (BK * 2); }
};
struct EpiMerged2 {
    static constexpr bool PERM = true, AFTER_DRAIN = false, HAS_MID = true; static constexpr int MID_T = 8; static constexpr int VMOPS = 32;
    const unsigned char* G8; bf16_t* MG;
    __device__ __forceinline__ void mid(f32x4 (&acc)[2][2][4][2], const Unit& u, int wr, int wc, int fr, int fq) const {
        const int row0 = u.pm * BM + wr * 64 + fr, col0 = u.pn * BM + wc * 32 + 8 * fq;
#pragma unroll
        for (int ai = 0; ai < 2; ++ai) {
            u32x2 ga[4][2], gs[4][2];
#pragma unroll
            for (int m = 0; m < 4; ++m) { const unsigned char* gp = G8 + (size_t)(row0 + ai * HALF + m * 16) * 2048 + col0;
#pragma unroll
                for (int bj = 0; bj < 2; ++bj) { ga[m][bj] = *(const u32x2*)(gp + bj * HALF); gs[m][bj] = *(const u32x2*)(gp + 1024 + bj * HALF); } }
            __builtin_amdgcn_sched_barrier(0);
#pragma unroll
            for (int m = 0; m < 4; ++m)
#pragma unroll
                for (int bj = 0; bj < 2; ++bj)
#pragma unroll
                    for (int e = 0; e < 4; ++e) {
                        const unsigned s0 = (gs[m][bj].x >> (8 * e)) & 0xffu, s1 = (gs[m][bj].y >> (8 * e)) & 0xffu;
                        acc[ai][bj][m][0][e] *= (float)((ga[m][bj].x >> (8 * e)) & 0xffu) * __builtin_amdgcn_rcpf((float)(s0 ? s0 : 1u));
                        acc[ai][bj][m][1][e] *= (float)((ga[m][bj].y >> (8 * e)) & 0xffu) * __builtin_amdgcn_rcpf((float)(s1 ? s1 : 1u)); }
            asm volatile("" ::: "memory");
            __builtin_amdgcn_sched_barrier(0);
        }
    }
    __device__ __forceinline__ void operator()(const f32x4 (&acc)[2][2][4][2], const Unit& u, int wr, int wc, int fr, int fq) const {
        const int row0 = u.pm * BM + wr * 64 + fr, col0 = u.pn * BM + wc * 32 + 8 * fq;
        u32x2 gs[2][4][2];
#pragma unroll
        for (int ai = 0; ai < 2; ++ai)
#pragma unroll
            for (int m = 0; m < 4; ++m) { const size_t row = (size_t)(row0 + ai * HALF + m * 16);
#pragma unroll
                for (int bj = 0; bj < 2; ++bj) gs[ai][m][bj] = *(const u32x2*)(G8 + row * 2048 + 1024 + col0 + bj * HALF); }
        __builtin_amdgcn_sched_barrier(0);
#pragma unroll
        for (int ai = 0; ai < 2; ++ai)
#pragma unroll
            for (int m = 0; m < 4; ++m) { const size_t row = (size_t)(row0 + ai * HALF + m * 16);
#pragma unroll
                for (int bj = 0; bj < 2; ++bj) { const int col = col0 + bj * HALF; const u32x2 g = gs[ai][m][bj];
                    f32x4 v0 = acc[ai][bj][m][0], v1 = acc[ai][bj][m][1];
#pragma unroll
                    for (int e = 0; e < 4; ++e) { const unsigned s0 = (g.x >> (8 * e)) & 0xffu, s1 = (g.y >> (8 * e)) & 0xffu;
                        v0[e] *= (float)(s0 ? s0 : 1u) * (1.f / 255.f); v1[e] *= (float)(s1 ? s1 : 1u) * (1.f / 255.f); }
                    u32x4 w; w.x = cvt_pk_bf16(v0[0], v0[1]); w.y = cvt_pk_bf16(v0[2], v0[3]); w.z = cvt_pk_bf16(v1[0], v1[1]); w.w = cvt_pk_bf16(v1[2], v1[3]);
                    *(u32x4*)(MG + row * 1024 + col) = w; } }
    }
};

struct SchedMoe2b {
    int vcu, G, ntile; const int* tbk; const char *A, *W2T; size_t tstepA; int ax0, ax1, ax2, ax3;
    __device__ __forceinline__ bool locate(int i, int& unit, int& code) const { const int uid = vcu + i * G, total = ntile * 4, nfull = (total / G) * G, ntail = total - nfull;
        const int P = MOE2_SPLIT_TAIL ? (ntail * 4 <= G ? 4 : (ntail * 2 <= G ? 2 : 1)) : 1;
        unit = uid; code = 0;
        if (uid >= nfull) { const int r = uid - nfull; if (r >= ntail * P) return false; unit = nfull + r / P; code = (P << 8) | ((r % P) << 12); }
        return true; }
    __device__ __forceinline__ void preload() { int a[4];
#pragma unroll
        for (int i = 0; i < 4; ++i) { int unit, code; const bool ok = locate(i, unit, code); a[i] = tbk[ok ? (unit >> 2) : 0]; }
        ax0 = __builtin_amdgcn_readfirstlane(a[0]); ax1 = __builtin_amdgcn_readfirstlane(a[1]); ax2 = __builtin_amdgcn_readfirstlane(a[2]); ax3 = __builtin_amdgcn_readfirstlane(a[3]); }
    __device__ __forceinline__ bool next(int i, Unit& u) const { int unit, code; if (!locate(i, unit, code)) return false;
        u.pm = unit >> 2; u.pn = unit & 3;
        u.aux = (i == 0 ? ax0 : (i == 1 ? ax1 : (i == 2 ? ax2 : (i == 3 ? ax3 : __builtin_amdgcn_readfirstlane(tbk[u.pm]))))) | code; return true; }
    __device__ __forceinline__ const char* aptr(const Unit& u, int t) const { return A + (size_t)u.pm * tstepA + (size_t)t * (BK * 2); }
    __device__ __forceinline__ const char* bptr(const Unit& u, int t) const { const int bk = u.aux & 255, g = bk / 6; int a, b; pair_of2(bk % 6, a, b); const int e = g * 4 + (t < 8 ? a : b);
        return W2T + ((size_t)e * 1024 + (size_t)u.pn * 256) * (512 * 2) + (size_t)(t & 7) * (BK * 2); }
};

struct SchedMoe1g {
    int vcu, G, ntile; const int* tbk; const int* perm; const char *H2, *W13; int ax0, ax1, ax2, ax3, ax4;
    __device__ __forceinline__ void preload() { int a[5];
#pragma unroll
        for (int i = 0; i < 5; ++i) { const int uid = vcu + i * G; a[i] = tbk[uid < ntile * 8 ? (uid >> 3) : 0]; }
        ax0 = __builtin_amdgcn_readfirstlane(a[0]); ax1 = __builtin_amdgcn_readfirstlane(a[1]); ax2 = __builtin_amdgcn_readfirstlane(a[2]); ax3 = __builtin_amdgcn_readfirstlane(a[3]); ax4 = __builtin_amdgcn_readfirstlane(a[4]); }
    __device__ __forceinline__ bool next(int i, Unit& u) const { const int uid = vcu + i * G; if (uid >= ntile * 8) return false; u.pm = uid >> 3; u.pn = uid & 7;
        u.aux = i == 0 ? ax0 : (i == 1 ? ax1 : (i == 2 ? ax2 : (i == 3 ? ax3 : (i == 4 ? ax4 : __builtin_amdgcn_readfirstlane(tbk[u.pm]))))); return true; }
    __device__ __forceinline__ int arow(const Unit& u, int r) const { const int t = perm[u.pm * 256 + r]; return t < 0 ? 0 : t; }
    __device__ __forceinline__ int arow_raw(const Unit& u, int r) const { int v; const int* a = perm + u.pm * 256 + r; asm volatile("global_load_dword %0, %1, off" : "=v"(v) : "v"(a) : "memory"); return v; }
    __device__ __forceinline__ const char* aptr(const Unit&, int t) const { return H2 + (size_t)t * (BK * 2); }
    __device__ __forceinline__ const char* bptr(const Unit& u, int t) const { const int g = u.aux / 6; int a, b; pair_of2(u.aux % 6, a, b); const int e = g * 4 + (u.pn < 4 ? a : b);
        return W13 + ((size_t)e * 1024 + (size_t)(u.pn & 3) * 256) * (1024 * 2) + (size_t)t * (BK * 2); }
};
}

namespace ssd {
typedef __attribute__((address_space(3))) unsigned char LB;
typedef __attribute__((address_space(3))) const bf16x8 Lbf8;
typedef __attribute__((address_space(3))) const u32x2 Lu2;
typedef __attribute__((address_space(3))) const f32x4 Lf4;
typedef unsigned u32x2v __attribute__((ext_vector_type(2)));
constexpr int XT_P = 272, BS_P = 144;
constexpr int OFF_XT = 0, OFF_BS = 256 * XT_P, OFF_BST = OFF_BS + 128 * BS_P, OFF_CS = OFF_BST + 64 * XT_P, OFF_F = OFF_CS + 128 * BS_P;
constexpr int F_DT0 = OFF_F, F_DT1 = OFF_F + 2048, F_CUM = OFF_F + 4096, F_SUF = OFF_F + 6144, F_WF = OFF_F + 8192, F_WB = OFF_F + 10240, LDS_END = OFF_F + 12288;
static_assert(LDS_END <= 147456 - 256, "ssd chunk LDS");
__device__ __forceinline__ unsigned cvtpk(float lo, float hi) { return gm2::cvt_pk_bf16(lo, hi); }
__device__ __forceinline__ float wave_incl_scan(float v, int lane) {
#pragma unroll
    for (int o = 1; o < 64; o <<= 1) { const float t = __shfl_up(v, o); if (lane >= o) v += t; }
    return v;
}
__device__ __forceinline__ void chunk_phase(const Params& p, LB* lds_) {
    LB* const lds = (LB*)(size_t)0;
    (void)lds_;
    const int tid = tid_opaque(), lane = tid & 63, wid = __builtin_amdgcn_readfirstlane(tid >> 6), r32 = lane & 31, hh = lane >> 5;
    const bf16_t* XBC = (const bf16_t*)(p.ws + WS_XBC); const float* DT = (const float*)(p.ws + WS_DT);
    bf16_t* YD = (bf16_t*)(p.ws + WS_YD); bf16_t* CC = (bf16_t*)(p.ws + WS_CC); float* ACUM = (float*)(p.ws + WS_ACUM); float* ST = (float*)(p.ws + WS_ST);
    for (int item = blockIdx.x; item < BATCH * NCHUNK * SSD_G; item += gridDim.x) {
        const int g = item & 1, c = (item >> 1) % NCHUNK, b = item / (2 * NCHUNK);
        const int t0 = b * SEQ + c * CHUNK;
        __syncthreads();
        if (tid < 384) {
            const int grp = tid % 96, rq = tid / 96, cl = 4 * grp;
            const int ch = cl < 256 ? 256 * g + cl : (cl < 320 ? 512 + 64 * g + (cl - 256) : 640 + 64 * g + (cl - 320));
            float w[7][4], bias[4];
#pragma unroll
            for (int k = 0; k < 7; ++k) { const f32x4 t = *(const f32x4*)(p.conv_w + k * CONV_CH + ch); w[k][0] = t[0]; w[k][1] = t[1]; w[k][2] = t[2]; w[k][3] = t[3]; }
            { const f32x4 t = *(const f32x4*)(p.conv_b + ch); bias[0] = t[0]; bias[1] = t[1]; bias[2] = t[2]; bias[3] = t[3]; }
            const bool head_pad = (c == 0 && rq == 0), tail_pad = (c == NCHUNK - 1 && rq == 3);
            float win[7][4];
#pragma unroll
            for (int k = 0; k < 7; ++k) { win[k][0] = 0.f; win[k][1] = 0.f; win[k][2] = 0.f; win[k][3] = 0.f; }
            u32x2 vin[38];
#pragma unroll
            for (int r = 0; r < 38; ++r) {
                int pos = c * CHUNK + 32 * rq + r - 3; pos = pos < 0 ? 0 : (pos >= SEQ ? SEQ - 1 : pos);
                vin[r] = *(const u32x2*)(XBC + (size_t)(b * SEQ + pos) * CONV_CH + ch);
            }
            __builtin_amdgcn_sched_barrier(0);
#pragma unroll
            for (int r = 0; r < 38; ++r) {
                u32x2 v = vin[r];
                if (r < 3) { if (head_pad) v = (u32x2){0u, 0u}; }
                if (r >= 35) { if (tail_pad) v = (u32x2){0u, 0u}; }
#pragma unroll
                for (int k = 0; k < 6; ++k) { win[k][0] = win[k + 1][0]; win[k][1] = win[k + 1][1]; win[k][2] = win[k + 1][2]; win[k][3] = win[k + 1][3]; }
                win[6][0] = gm2::bflo(v.x); win[6][1] = gm2::bfhi(v.x); win[6][2] = gm2::bflo(v.y); win[6][3] = gm2::bfhi(v.y);
                if (r >= 6) {
                    const int i = 32 * rq + r - 6;
                    float o[4];
#pragma unroll
                    for (int e = 0; e < 4; ++e) { float a = bias[e];
#pragma unroll
                        for (int k = 0; k < 7; ++k) a += w[k][e] * win[k][e];
                        o[e] = gm2::silu_e(a); }
                    const unsigned p01 = cvtpk(o[0], o[1]), p23 = cvtpk(o[2], o[3]);
                    if (cl < 256) {
                        __attribute__((address_space(3))) unsigned short* d = (__attribute__((address_space(3))) unsigned short*)(lds + OFF_XT + cl * XT_P + i * 2);
                        d[0] = (unsigned short)p01; d[XT_P / 2] = (unsigned short)(p01 >> 16); d[XT_P] = (unsigned short)p23; d[3 * XT_P / 2] = (unsigned short)(p23 >> 16);
                    } else if (cl < 320) {
                        const int n = cl - 256;
                        *(__attribute__((address_space(3))) u32x2*)(lds + OFF_BS + i * BS_P + n * 2) = (u32x2){p01, p23};
                        __attribute__((address_space(3))) unsigned short* d = (__attribute__((address_space(3))) unsigned short*)(lds + OFF_BST + n * XT_P + i * 2);
                        d[0] = (unsigned short)p01; d[XT_P / 2] = (unsigned short)(p01 >> 16); d[XT_P] = (unsigned short)p23; d[3 * XT_P / 2] = (unsigned short)(p23 >> 16);
                    } else {
                        const int n = cl - 320;
                        *(__attribute__((address_space(3))) u32x2*)(lds + OFF_CS + i * BS_P + n * 2) = (u32x2){p01, p23};
                        *(u32x2*)(CC + (size_t)(t0 + i) * 128 + 64 * g + n) = (u32x2){p01, p23};
                    }
                }
            }
        } else {
            const int i = tid - 384;
            const f32x4 d0 = *(const f32x4*)(DT + (size_t)(t0 + i) * 16 + 4 * g), d1 = *(const f32x4*)(DT + (size_t)(t0 + i) * 16 + 8 + 4 * g);
#pragma unroll
            for (int hl = 0; hl < 4; ++hl) { *(__attribute__((address_space(3))) float*)(lds + F_DT0 + (hl * 128 + i) * 4) = d0[hl]; *(__attribute__((address_space(3))) float*)(lds + F_DT1 + (hl * 128 + i) * 4) = d1[hl]; }
        }
        __syncthreads();
        {
            const int hl = wid & 3, dir = wid >> 2, h = 4 * g + hl;
            const float a = -__expf(p.a_log[dir * 8 + h]);
            const int q0 = 2 * lane, q1 = 2 * lane + 1, i0 = dir ? 127 - q0 : q0, i1 = dir ? 127 - q1 : q1;
            const int fdt = dir ? F_DT1 : F_DT0;
            const float dt_0 = *(__attribute__((address_space(3))) const float*)(lds + fdt + (hl * 128 + i0) * 4), dt_1 = *(__attribute__((address_space(3))) const float*)(lds + fdt + (hl * 128 + i1) * 4);
            const float v0 = dt_0 * a, v1 = dt_1 * a, pr = v0 + v1;
            const float incl = wave_incl_scan(pr, lane), s0 = incl - pr + v0, s1 = incl;
            const float tot = __shfl(incl, 63);
            const int fs = dir ? F_SUF : F_CUM, fw = dir ? F_WB : F_WF;
            *(__attribute__((address_space(3))) float*)(lds + fs + (hl * 128 + i0) * 4) = s0; *(__attribute__((address_space(3))) float*)(lds + fs + (hl * 128 + i1) * 4) = s1;
            *(__attribute__((address_space(3))) float*)(lds + fw + (hl * 128 + i0) * 4) = __expf(tot - s0) * dt_0; *(__attribute__((address_space(3))) float*)(lds + fw + (hl * 128 + i1) * 4) = __expf(tot - s1) * dt_1;
            ACUM[(size_t)(t0 + i0) * 16 + dir * 8 + h] = s0; ACUM[(size_t)(t0 + i1) * 16 + dir * 8 + h] = s1;
        }
        __syncthreads();
        {
            const int it = wid & 3, hp = wid >> 2, i = it * 32 + r32;
            f32x16 Gt[4];
#pragma unroll
            for (int jt = 0; jt < 4; ++jt) {
                f32x16 acc = {0.f, 0.f, 0.f, 0.f, 0.f, 0.f, 0.f, 0.f, 0.f, 0.f, 0.f, 0.f, 0.f, 0.f, 0.f, 0.f};
#pragma unroll
                for (int ks = 0; ks < 4; ++ks) {
                    const bf16x8 af = *(Lbf8*)(lds + OFF_BS + (jt * 32 + r32) * BS_P + 32 * ks + 16 * hh);
                    const bf16x8 bfr = *(Lbf8*)(lds + OFF_CS + (it * 32 + r32) * BS_P + 32 * ks + 16 * hh);
                    acc = __builtin_amdgcn_mfma_f32_32x32x16_bf16(af, bfr, acc, 0, 0, 0);
                }
                Gt[jt] = acc;
            }
#pragma unroll
            for (int hs = 0; hs < 2; ++hs) {
                const int hl = 2 * hp + hs, h = 4 * g + hl;
                const float ci = *(__attribute__((address_space(3))) const float*)(lds + F_CUM + (hl * 128 + i) * 4), si = *(__attribute__((address_space(3))) const float*)(lds + F_SUF + (hl * 128 + i) * 4);
                f32x16 Y[2];
                Y[0] = (f32x16){0.f, 0.f, 0.f, 0.f, 0.f, 0.f, 0.f, 0.f, 0.f, 0.f, 0.f, 0.f, 0.f, 0.f, 0.f, 0.f}; Y[1] = Y[0];
#pragma unroll
                for (int jt = 0; jt < 4; ++jt) {
                    unsigned mt[8];
                    const int rel = jt < it ? 0 : (jt > it ? 1 : 2);
#pragma unroll
                    for (int q = 0; q < 4; ++q) {
                        const int jb = jt * 32 + 8 * q + 4 * hh;
                        float m[4];
                        if (rel == 0) {
                            const f32x4 cj = *(Lf4*)(lds + F_CUM + (hl * 128 + jb) * 4), d0 = *(Lf4*)(lds + F_DT0 + (hl * 128 + jb) * 4);
#pragma unroll
                            for (int e = 0; e < 4; ++e) m[e] = Gt[jt][4 * q + e] * (__expf(ci - cj[e]) * d0[e]);
                        } else if (rel == 1) {
                            const f32x4 sj = *(Lf4*)(lds + F_SUF + (hl * 128 + jb) * 4), d1 = *(Lf4*)(lds + F_DT1 + (hl * 128 + jb) * 4);
#pragma unroll
                            for (int e = 0; e < 4; ++e) m[e] = Gt[jt][4 * q + e] * (__expf(si - sj[e]) * d1[e]);
                        } else {
                            const f32x4 cj = *(Lf4*)(lds + F_CUM + (hl * 128 + jb) * 4), d0 = *(Lf4*)(lds + F_DT0 + (hl * 128 + jb) * 4);
                            const f32x4 sj = *(Lf4*)(lds + F_SUF + (hl * 128 + jb) * 4), d1 = *(Lf4*)(lds + F_DT1 + (hl * 128 + jb) * 4);
#pragma unroll
                            for (int e = 0; e < 4; ++e) {
                                const int dji = (8 * q + 4 * hh + e) - r32;
                                const float wf = __expf(fminf(ci - cj[e], 0.f)) * d0[e], wb = __expf(fminf(si - sj[e], 0.f)) * d1[e];
                                m[e] = Gt[jt][4 * q + e] * ((dji <= 0 ? wf : 0.f) + (dji >= 0 ? wb : 0.f));
                            }
                        }
                        mt[2 * q] = cvtpk(m[0], m[1]); mt[2 * q + 1] = cvtpk(m[2], m[3]);
                    }
#pragma unroll
                    for (int s = 0; s < 2; ++s) {
                        const bf16x8 mf = __builtin_bit_cast(bf16x8, (u32x4){mt[4 * s], mt[4 * s + 1], mt[4 * s + 2], mt[4 * s + 3]});
#pragma unroll
                        for (int pt = 0; pt < 2; ++pt) {
                            const LB* xa = lds + OFF_XT + (hl * 64 + pt * 32 + r32) * XT_P + (jt * 32 + 16 * s + 4 * hh) * 2;
                            const u32x2 lo = *(Lu2*)(xa), hi2 = *(Lu2*)(xa + 16);
                            const bf16x8 xf = __builtin_bit_cast(bf16x8, (u32x4){lo.x, lo.y, hi2.x, hi2.y});
                            Y[pt] = __builtin_amdgcn_mfma_f32_32x32x16_bf16(xf, mf, Y[pt], 0, 0, 0);
                        }
                    }
                }
                const float dsk = p.d_skip[h];
#pragma unroll
                for (int pt = 0; pt < 2; ++pt)
#pragma unroll
                    for (int qp = 0; qp < 2; ++qp) {
                        u32x2 g[2];
#pragma unroll
                        for (int qq = 0; qq < 2; ++qq) { const int q = 2 * qp + qq, p0 = pt * 32 + 8 * q + 4 * hh;
                            float y[4];
#pragma unroll
                            for (int e = 0; e < 4; ++e) { const float xv = bf2f(*(__attribute__((address_space(3))) const unsigned short*)(lds + OFF_XT + (hl * 64 + p0 + e) * XT_P + i * 2)); y[e] = Y[pt][4 * q + e] + dsk * xv; }
                            g[qq] = (u32x2){cvtpk(y[0], y[1]), cvtpk(y[2], y[3])}; }
                        auto r0 = __builtin_amdgcn_permlane32_swap(g[0].x, g[1].x, false, false); auto r1 = __builtin_amdgcn_permlane32_swap(g[0].y, g[1].y, false, false);
                        *(u32x4*)(YD + (size_t)(t0 + i) * 512 + h * 64 + pt * 32 + 16 * qp + 8 * hh) = (u32x4){(unsigned)r0[0], (unsigned)r1[0], (unsigned)r0[1], (unsigned)r1[1]};
                    }
            }
        }
        {
            const int hl = wid & 3, dir = wid >> 2, h = 4 * g + hl, fw = dir ? F_WB : F_WF;
            f32x16 S[2][2];
#pragma unroll
            for (int a = 0; a < 2; ++a)
#pragma unroll
                for (int bb = 0; bb < 2; ++bb) S[a][bb] = (f32x16){0.f, 0.f, 0.f, 0.f, 0.f, 0.f, 0.f, 0.f, 0.f, 0.f, 0.f, 0.f, 0.f, 0.f, 0.f, 0.f};
#pragma unroll 2
            for (int ks = 0; ks < 8; ++ks) {
                const f32x4 w0 = *(Lf4*)(lds + fw + (hl * 128 + 16 * ks + 8 * hh) * 4), w1 = *(Lf4*)(lds + fw + (hl * 128 + 16 * ks + 8 * hh + 4) * 4);
                bf16x8 bfr[2];
#pragma unroll
                for (int nt = 0; nt < 2; ++nt) bfr[nt] = *(Lbf8*)(lds + OFF_BST + (nt * 32 + r32) * XT_P + 32 * ks + 16 * hh);
#pragma unroll
                for (int pt = 0; pt < 2; ++pt) {
                    const u32x4 xr = *(__attribute__((address_space(3))) const u32x4*)(lds + OFF_XT + (hl * 64 + pt * 32 + r32) * XT_P + 32 * ks + 16 * hh);
                    const u32x4 xw = {cvtpk(gm2::bflo(xr.x) * w0[0], gm2::bfhi(xr.x) * w0[1]), cvtpk(gm2::bflo(xr.y) * w0[2], gm2::bfhi(xr.y) * w0[3]),
                                      cvtpk(gm2::bflo(xr.z) * w1[0], gm2::bfhi(xr.z) * w1[1]), cvtpk(gm2::bflo(xr.w) * w1[2], gm2::bfhi(xr.w) * w1[3])};
                    const bf16x8 af = __builtin_bit_cast(bf16x8, xw);
#pragma unroll
                    for (int nt = 0; nt < 2; ++nt) S[pt][nt] = __builtin_amdgcn_mfma_f32_32x32x16_bf16(bfr[nt], af, S[pt][nt], 0, 0, 0);
                }
            }
            bf16_t* dst = (bf16_t*)ST + ((((size_t)dir * BATCH + b) * NCHUNK + c) * 8 + h) * 4096;
#pragma unroll
            for (int pt = 0; pt < 2; ++pt)
#pragma unroll
                for (int nt = 0; nt < 2; ++nt)
#pragma unroll
                    for (int gp = 0; gp < 2; ++gp) { u32x2 g[2];
#pragma unroll
                        for (int gg = 0; gg < 2; ++gg) { const int b4 = 4 * (2 * gp + gg); g[gg] = (u32x2){cvtpk(S[pt][nt][b4], S[pt][nt][b4 + 1]), cvtpk(S[pt][nt][b4 + 2], S[pt][nt][b4 + 3])}; }
                        auto r0 = __builtin_amdgcn_permlane32_swap(g[0].x, g[1].x, false, false); auto r1 = __builtin_amdgcn_permlane32_swap(g[0].y, g[1].y, false, false);
                        *(u32x4*)(dst + (pt * 32 + r32) * 64 + nt * 32 + 16 * gp + 8 * hh) = (u32x4){(unsigned)r0[0], (unsigned)r1[0], (unsigned)r0[1], (unsigned)r1[1]}; }
        }
    }
}

constexpr int VT_P = 1040;
constexpr int OFF_VT = 0, OFF_SS = 128 * VT_P, OFF_EF = OFF_SS + 8 * 128 * 4, FIN_END = OFF_EF + 2 * 8 * 128 * 4;
static_assert(FIN_END <= 147456 - 256, "ssd final LDS");
__device__ __forceinline__ void final_phase(const Params& p, LB* lds_) {
    LB* const lds = (LB*)(size_t)0; (void)lds_;
    const int tid = tid_opaque(), lane = tid & 63, h = __builtin_amdgcn_readfirstlane(tid >> 6), r32 = lane & 31, hh = lane >> 5, g = h >> 2;
    const bf16_t* YD = (const bf16_t*)(p.ws + WS_YD); const bf16_t* CC = (const bf16_t*)(p.ws + WS_CC); const float* ACUM = (const float*)(p.ws + WS_ACUM); const float* ST = (const float*)(p.ws + WS_ST);
    const bf16_t* Z = (const bf16_t*)(p.ws + WS_Z); bf16_t* SSD = (bf16_t*)(p.ws + WS_SSD);
    typedef __attribute__((address_space(3))) float LF;
    for (int item = blockIdx.x; item < BATCH * NCHUNK; item += gridDim.x) {
        const int c = item % NCHUNK, b = item / NCHUNK, t0 = b * SEQ + c * CHUNK;
        __syncthreads();
#pragma unroll
        for (int q = 0; q < 2; ++q) { const int i = lane + 64 * q;
            *(LF*)(lds + OFF_EF + ((0 * 8 + h) * 128 + i) * 4) = __expf(ACUM[(size_t)(t0 + i) * 16 + h]);
            *(LF*)(lds + OFF_EF + ((1 * 8 + h) * 128 + i) * 4) = __expf(ACUM[(size_t)(t0 + i) * 16 + 8 + h]); }
        bf16x8 cf[2][2][4];
#pragma unroll
        for (int dir = 0; dir < 2; ++dir) { const bf16_t* cs = (const bf16_t*)ST + ((((size_t)dir * BATCH + b) * NCHUNK + c) * 8 + h) * 4096;
#pragma unroll
            for (int pt = 0; pt < 2; ++pt)
#pragma unroll
                for (int ks = 0; ks < 4; ++ks) cf[dir][pt][ks] = *(const bf16x8*)(cs + (pt * 32 + r32) * 64 + 16 * ks + 8 * hh); }
        asm volatile("s_waitcnt lgkmcnt(0)" ::: "memory");
#pragma unroll 1
        for (int it = 0; it < 4; ++it) {
            f32x16 A[2][2];
#pragma unroll
            for (int dir = 0; dir < 2; ++dir)
#pragma unroll
                for (int pt = 0; pt < 2; ++pt) A[dir][pt] = (f32x16){0.f, 0.f, 0.f, 0.f, 0.f, 0.f, 0.f, 0.f, 0.f, 0.f, 0.f, 0.f, 0.f, 0.f, 0.f, 0.f};
            bf16x8 afr[4]; unsigned short ydv[16][2], zv[16][2];
#pragma unroll
            for (int ks = 0; ks < 4; ++ks) afr[ks] = *(const bf16x8*)(CC + (size_t)(t0 + it * 32 + r32) * 128 + g * 64 + 16 * ks + 8 * hh);
#pragma unroll
            for (int rg = 0; rg < 16; ++rg) { const size_t t = (size_t)(t0 + it * 32 + (rg & 3) + 8 * (rg >> 2) + 4 * hh);
#pragma unroll
                for (int pt = 0; pt < 2; ++pt) { const int col = h * 64 + pt * 32 + r32; ydv[rg][pt] = YD[t * 512 + col]; zv[rg][pt] = Z[t * 512 + col]; } }
            __builtin_amdgcn_sched_barrier(0);
#pragma unroll
            for (int ks = 0; ks < 4; ++ks) {
#pragma unroll
                for (int dir = 0; dir < 2; ++dir)
#pragma unroll
                    for (int pt = 0; pt < 2; ++pt) A[dir][pt] = __builtin_amdgcn_mfma_f32_32x32x16_bf16(afr[ks], cf[dir][pt][ks], A[dir][pt], 0, 0, 0); }
#pragma unroll
            for (int rg = 0; rg < 16; ++rg) {
                const int i = it * 32 + (rg & 3) + 8 * (rg >> 2) + 4 * hh;
                const float ef = *(LF*)(lds + OFF_EF + ((0 * 8 + h) * 128 + i) * 4), eb = *(LF*)(lds + OFF_EF + ((1 * 8 + h) * 128 + i) * 4);
                float ss = 0.f;
#pragma unroll
                for (int pt = 0; pt < 2; ++pt) { const int col = h * 64 + pt * 32 + r32;
                    const float y = (bf2f(ydv[rg][pt]) + A[0][pt][rg] * ef + A[1][pt][rg] * eb) * bf2f(zv[rg][pt]);
                    ss += y * y;
                    *(__attribute__((address_space(3))) unsigned short*)(lds + OFF_VT + i * VT_P + col * 2) = (unsigned short)f2bf(y); }
                ss = half32_sum(ss);
                if (r32 == 0) *(LF*)(lds + OFF_SS + (h * 128 + i) * 4) = ss;
            }
        }
        __syncthreads();
        const f32x4 w0 = *(const f32x4*)(p.ssd_norm_w + lane * 8), w1 = *(const f32x4*)(p.ssd_norm_w + lane * 8 + 4);
#pragma unroll 4
        for (int q = 0; q < 16; ++q) {
            const int i = h * 16 + q;
            float tot = 0.f;
#pragma unroll
            for (int k = 0; k < 8; ++k) tot += *(LF*)(lds + OFF_SS + (k * 128 + i) * 4);
            const float rstd = 1.f / sqrtf(tot * (1.f / 512.f) + EPS);
            const u32x4 v = *(__attribute__((address_space(3))) const u32x4*)(lds + OFF_VT + i * VT_P + lane * 16);
            u32x4 o; o.x = cvtpk(gm2::bflo(v.x) * rstd * w0[0], gm2::bfhi(v.x) * rstd * w0[1]); o.y = cvtpk(gm2::bflo(v.y) * rstd * w0[2], gm2::bfhi(v.y) * rstd * w0[3]);
            o.z = cvtpk(gm2::bflo(v.z) * rstd * w1[0], gm2::bfhi(v.z) * rstd * w1[1]); o.w = cvtpk(gm2::bflo(v.w) * rstd * w1[2], gm2::bfhi(v.w) * rstd * w1[3]);
            *(u32x4*)(SSD + (size_t)(t0 + i) * 512 + lane * 8) = o;
        }
    }
}
}
#ifndef NAIVE_SSDC
#define NAIVE_SSDC 0
#endif
#ifndef NAIVE_SSDF
#define NAIVE_SSDF 0
#endif
#ifndef NAIVE_P1
#define NAIVE_P1 0
#endif
#ifndef NAIVE_P4B
#define NAIVE_P4B 0
#endif
#ifndef NAIVE_P4C
#define NAIVE_P4C 0
#endif
#ifndef NAIVE_P6
#define NAIVE_P6 0
#endif
#ifndef NAIVE_P7
#define NAIVE_P7 0
#endif
__device__ __forceinline__ int vcu_of() { const int G = gridDim.x, bx = blockIdx.x; return (G % 8 == 0) ? (bx % 8) * (G / 8) + bx / 8 : bx; }
#if USE_PG8
#define GNS pg8
#define GEMM_CALL(EPI, SCHED, K, RX) pg8::gemm_phase<pg8::EPI, pg8::SCHED, true, true, RX>(lds3, K, S, E)
#else
#define GNS gm2
#define GEMM_CALL(EPI, SCHED, K, RX) gm2::gemm_phase<gm2::EPI, gm2::SCHED>(lds3, K, S, E)
#endif
__device__ __forceinline__ void phase_p1_pg8(const Params& p, PG8_LAS unsigned char* lds3) {
#if USE_PG8
    pg8::SchedProj S; S.so.init(T, 4096, gridDim.x, blockIdx.x); S.A = (const char*)wsp<bf16_t>(p, WS_H); S.B = (const char*)wsp<bf16_t>(p, WS_WIN); S.tstep = (size_t)256 * DM * 2;
#else
    gm2::SchedProj S{vcu_of(), (int)gridDim.x, (const char*)wsp<bf16_t>(p, WS_H), (const char*)wsp<bf16_t>(p, WS_WIN), (size_t)256 * DM * 2};
#endif
#if USE_PG8
    pg8::EpiInProj E{wsp<bf16_t>(p, WS_QO), wsp<bf16_t>(p, WS_K), wsp<bf16_t>(p, WS_V), wsp<bf16_t>(p, WS_Z), wsp<bf16_t>(p, WS_XBC), wsp<bf16_t>(p, WS_G), wsp<float>(p, WS_DT), p.b_gate, p.dt_bias};
#else
    gm2::EpiInProj E{p.ws, p.b_gate};
#endif
    GEMM_CALL(EpiInProj, SchedProj, DM, RELAX_P1);
}
__device__ __forceinline__ void phase_merged_pg8(const Params& p, PG8_LAS unsigned char* lds3) {
#if USE_PG8
    pg8::SchedMerged2 S{vcu_of(), (int)gridDim.x, (const char*)wsp<bf16_t>(p, WS_QO), (const char*)wsp<bf16_t>(p, WS_SSD), (const char*)wsp<bf16_t>(p, WS_WA), (const char*)wsp<bf16_t>(p, WS_WS), (size_t)256 * 512 * 2};
    pg8::EpiMerged2 E{(const unsigned char*)(p.ws + WS_G), wsp<bf16_t>(p, WS_MERGED)};
    pg8::gemm_phase2<pg8::EpiMerged2, pg8::SchedMerged2, true, true, false, RELAX_MERGED>(lds3, 512, 512, 16, S, E);
#else
    GNS::SchedMerged S{vcu_of(), (int)gridDim.x, (const char*)wsp<bf16_t>(p, WS_SSD), (const char*)wsp<bf16_t>(p, WS_QO), (const char*)wsp<bf16_t>(p, WS_WS), (const char*)wsp<bf16_t>(p, WS_WA), (size_t)256 * 512 * 2};
    GNS::EpiMerged E{wsp<bf16_t>(p, WS_G), wsp<bf16_t>(p, WS_MERGED)};
    GEMM_CALL(EpiMerged, SchedMerged, 512, false);
#endif
}
__device__ __forceinline__ void phase_wout_pg8(const Params& p, PG8_LAS unsigned char* lds3) {
    GNS::SchedWout S{vcu_of(), (int)gridDim.x, (const char*)wsp<bf16_t>(p, WS_MERGED), (const char*)wsp<bf16_t>(p, WS_WO), (size_t)256 * DM * 2};
#if USE_PG8
    pg8::EpiWout E{p.x, wsp<bf16_t>(p, WS_X1B)};
#else
    gm2::EpiWout E{p.x, p.out};
#endif
#if W13_IN_WOUT
    const bool head = ((vcu_of() >> 2) & 1) == 0;
#pragma unroll 1
    for (int pass = 0; pass < 2; ++pass) {
        int pz = pass; asm volatile("" : "+s"(pz));
        if ((pz == 0) == head) { const int tid = tid_opaque(), lane = tid & 63, wave = tid >> 6; phase_tr_range(p, (float*)(unsigned char*)lds3 + wave * (64 * 33), lane, TR_EARLY, TR_W2, (int)blockIdx.x * 8 + wave, (int)gridDim.x * 8); __syncthreads(); }
        if (pz == 0) { GEMM_CALL(EpiWout, SchedWout, DM, RELAX_WOUT); }
    }
#else
    GEMM_CALL(EpiWout, SchedWout, DM, RELAX_WOUT);
#endif
}
__device__ __forceinline__ void phase_moe1_pg8(const Params& p, PG8_LAS unsigned char* lds3) {
    const int* tbk = (const int*)(p.ws + WS_ROUTE + RT_TB);
#if USE_PG8 && FUSE_GATHER
    pg8::SchedMoe1g S{vcu_of(), (int)gridDim.x, __builtin_amdgcn_readfirstlane(tbk[TS / 256]), tbk, (const int*)(p.ws + WS_ROUTE + RT_PERM), (const char*)wsp<bf16_t>(p, WS_X1B), (const char*)wsp<bf16_t>(p, WS_W13), 0, 0, 0, 0, 0}; S.preload();
    pg8::EpiMoe1 E{wsp<bf16_t>(p, WS_HID), (const float*)(p.ws + WS_ROUTE + RT_SWA), (const float*)(p.ws + WS_ROUTE + RT_SWB), (const float*)(p.ws + WS_ROUTE + RT_SRS)};
    pg8::gemm_phase2<pg8::EpiMoe1, pg8::SchedMoe1g, true, true, true, RELAX_MOE1>(lds3, DM, DM, 16, S, E);
#else
    GNS::SchedMoe1 S{vcu_of(), (int)gridDim.x, __builtin_amdgcn_readfirstlane(tbk[TS / 256]), tbk, (const char*)wsp<bf16_t>(p, WS_XS), (const char*)wsp<bf16_t>(p, WS_W13), (size_t)256 * DM * 2};
    GNS::EpiMoe1 E{wsp<bf16_t>(p, WS_HID), (const float*)(p.ws + WS_ROUTE + RT_SWA), (const float*)(p.ws + WS_ROUTE + RT_SWB)};
    GEMM_CALL(EpiMoe1, SchedMoe1, DM, false);
#endif
}
__device__ __forceinline__ void phase_moe2_pg8(const Params& p, PG8_LAS unsigned char* lds3) {
    const int* tbk = (const int*)(p.ws + WS_ROUTE + RT_TB);
#if USE_PG8
    pg8::SchedMoe2b S{vcu_of(), (int)gridDim.x, __builtin_amdgcn_readfirstlane(tbk[TS / 256]), tbk, (const char*)wsp<bf16_t>(p, WS_HID), (const char*)wsp<bf16_t>(p, WS_W2P), (size_t)256 * 1024 * 2, 0, 0, 0, 0}; S.preload();
    pg8::EpiMoe2 E{p.out, (const int*)(p.ws + WS_ROUTE + RT_PERM), wsp<bf16_t>(p, WS_X1B)};
    pg8::gemm_phase2<pg8::EpiMoe2, pg8::SchedMoe2b, true, true, false, RELAX_MOE2>(lds3, 1024, 512, 16, S, E);
#else
    GNS::SchedMoe2 S{vcu_of(), (int)gridDim.x, __builtin_amdgcn_readfirstlane(tbk[TS / 256]), tbk, (const char*)wsp<bf16_t>(p, WS_HID), (const char*)wsp<bf16_t>(p, WS_W2P), (size_t)256 * 1024 * 2};
    GNS::EpiMoe2 E{p.out, (const int*)(p.ws + WS_ROUTE + RT_PERM)};
    GEMM_CALL(EpiMoe2, SchedMoe2, 1024, false);
#endif
}

__device__ __forceinline__ void phase_tr_w13(const Params& p, unsigned char* lds) {
    const int tid = tid_opaque(), lane = tid & 63, wave = tid >> 6;
    phase_tr_range(p, (float*)lds + wave * (64 * 33), lane, TR_EARLY, TR_W2, (int)blockIdx.x * 8 + wave, (int)gridDim.x * 8);
    __syncthreads();
}
__device__ __forceinline__ void phase_tr_w2(const Params& p, unsigned char* lds) {
    const int tid = tid_opaque(), lane = tid & 63, wave = tid >> 6;
    const int* tbk = (const int*)(p.ws + WS_ROUTE + RT_TB);
    const int G = (int)gridDim.x, ntile = __builtin_amdgcn_readfirstlane(tbk[TS / 256]), rot = (ntile * 8) % G, vcu = vcu_of();
    if (vcu >= rot) phase_tr_range(p, (float*)lds + wave * (64 * 33), lane, TR_W2, TR_TOTAL, (vcu - rot) * 8 + wave, (G - rot) * 8);
}
constexpr int LDS_BYTES = 147456;
__global__ void __launch_bounds__(512, 2) k_mega(Params p) {
    extern __shared__ __attribute__((aligned(16))) unsigned char lds[];
    PG8_LAS unsigned char* lds3 = (PG8_LAS unsigned char*)lds;
    volatile LAS unsigned* MISC = (volatile LAS unsigned*)(lds3 + MISC_OFF);
    if (threadIdx.x < 64) MISC[threadIdx.x] = 0u;
    __syncthreads();
    XcdBarrier bar = xcd_barrier_post((unsigned*)(p.ws + WS_CTL) + CW_BAR, MISC + 8);
#define GRID_BAR() xcd_barrier(bar)
    phase_p0(p, lds); GRID_BAR();
#if NAIVE_P1
    phase_p1(p);
#else
    phase_p1_pg8(p, lds3); phase_dt(p);
#endif
    GRID_BAR();
    phase_rope(p);
#if NAIVE_SSDC
    phase_ssd_chunk_naive(p, lds);
#else
    ssd::chunk_phase(p, (ssd::LB*)lds);
#endif
    GRID_BAR();
    phase_scan(p);
#if NAIVE_ATTN
    phase_attn_naive(p);
#else
    phase_attn(p, lds);
#endif
    GRID_BAR();
#if NAIVE_SSDF
    phase_ssd_final_naive(p, lds);
#else
    ssd::final_phase(p, (ssd::LB*)lds);
#endif
    GRID_BAR();
#if NAIVE_P4B
    phase_merged_naive(p);
#else
    phase_merged_pg8(p, lds3);
#endif
    GRID_BAR();
#if NAIVE_P4C
    phase_wout_naive(p);
#else
    phase_wout_pg8(p, lds3);
#endif
    GRID_BAR();
    phase_route(p, lds); GRID_BAR();
    phase_gather(p, lds); GRID_BAR();
#if NAIVE_P6
    phase_moe1_naive(p);
#else
    phase_moe1_pg8(p, lds3);
#endif
    phase_tr_w2(p, lds);
    GRID_BAR();
#if NAIVE_P7
    phase_moe2_naive(p);
#else
    phase_moe2_pg8(p, lds3);
#endif
}

extern "C" void kernel_launch(void* const* d_in, const int* in_sizes, int n_in, void* d_out, int out_size, void* d_ws, size_t ws_size, hipStream_t stream) {
    if (n_in != 23 || out_size != T * DM || ws_size < WS_END) { fprintf(stderr, "kernel_launch: unexpected shapes (n_in %d out %d ws %zu need %zu)\n", n_in, out_size, ws_size, (size_t)WS_END); return; }
    Params p{};
    const float** f = (const float**)&p;
    for (int i = 0; i < 23; ++i) f[i] = (const float*)d_in[i];
    p.out = (float*)d_out; p.ws = (unsigned char*)d_ws;
    static int grid_blocks = 0;
    if (!grid_blocks) {
        int dev = 0, cus = 0, per_cu = 0;
        (void)hipGetDevice(&dev); (void)hipDeviceGetAttribute(&cus, hipDeviceAttributeMultiprocessorCount, dev);
        (void)hipFuncSetAttribute((const void*)k_mega, hipFuncAttributeMaxDynamicSharedMemorySize, LDS_BYTES);
        (void)hipOccupancyMaxActiveBlocksPerMultiprocessor(&per_cu, (const void*)k_mega, 512, LDS_BYTES);
        if (per_cu < 1) { fprintf(stderr, "kernel_launch: occupancy query says %d blocks/CU\n", per_cu); per_cu = 1; }
        grid_blocks = cus * 1;
        fprintf(stderr, "kernel_launch: cus %d per_cu %d grid %d\n", cus, per_cu, grid_blocks);
    }
    (void)hipMemsetAsync((char*)d_ws + WS_CTL, 0, 1 * MiB, stream);
    void* args[] = {&p};
    hipError_t e = hipLaunchCooperativeKernel((const void*)k_mega, dim3(grid_blocks), dim3(512), args, LDS_BYTES, stream);
    if (e != hipSuccess) fprintf(stderr, "cooperative launch failed: %s (grid %d)\n", hipGetErrorString(e), grid_blocks);
}
```

```cpp
#include <hip/hip_runtime.h>
#include <hip/hip_cooperative_groups.h>
#include <cstdio>
#include <cstdint>
namespace cg = cooperative_groups;

#ifndef ONE_LAUNCH
#define ONE_LAUNCH 0
#endif

__device__ __forceinline__ int tid_opaque() { int t = threadIdx.x; asm volatile("" : "+v"(t)); return t; }
#ifndef USE_PG8
#define USE_PG8 1
#endif
#ifndef MOE2_SPLIT_TAIL
#define MOE2_SPLIT_TAIL 1
#endif
#ifndef FUSE_GATHER
#define FUSE_GATHER 1
#endif
typedef unsigned short bf16_t;
typedef short bf16x8 __attribute__((ext_vector_type(8)));
typedef float f32x4 __attribute__((ext_vector_type(4)));
typedef float f32x16 __attribute__((ext_vector_type(16)));
typedef unsigned u32x4 __attribute__((ext_vector_type(4)));
typedef unsigned u32x2 __attribute__((ext_vector_type(2)));

constexpr int BATCH = 8, SEQ = 4096, DM = 1024, T = BATCH * SEQ;
constexpr int NQH = 8, NKVH = 2, HD = 64, ATTN_W = 512, KV_W = 128;
constexpr int SSD_W = 512, SSD_H = 8, SSD_G = 2, DSTATE = 64, DCONV = 7, CONV_CH = 768, CHUNK = 128, NCHUNK = SEQ / CHUNK;
constexpr int IN_PROJ = 4112, NPROJ = 4352;
constexpr int NE = 16, NG = 4, EPG = 4, DE = 512;
constexpr int NBUCKET = 24;
constexpr int TS = T + NBUCKET * 256;
constexpr int NRT = T / 128;
constexpr float EPS = 1e-6f;
constexpr float C2 = 0.125f * 1.4426950408889634f;

constexpr size_t MiB = 1u << 20;
constexpr size_t al(size_t x) { return (x + 255) & ~(size_t)255; }
constexpr size_t WS_CTL = 0;
constexpr size_t WS_WIN = 1 * MiB;
constexpr size_t WS_WA = WS_WIN + al((size_t)NPROJ * DM * 2);
constexpr size_t WS_WS = WS_WA + al((size_t)DM * 512 * 2);
constexpr size_t WS_WO = WS_WS + al((size_t)DM * 512 * 2);
constexpr size_t WS_W13 = WS_WO + al((size_t)DM * DM * 2);
constexpr size_t WS_W2P = WS_W13 + al((size_t)NE * 1024 * DM * 2);
constexpr size_t WS_H = WS_W2P + al((size_t)NBUCKET * DM * 1024 * 2);
constexpr size_t WS_YD = WS_H;
constexpr size_t WS_CC = WS_H + (size_t)T * 512 * 2;
constexpr size_t WS_QO = WS_H + al((size_t)T * DM * 2);
constexpr size_t WS_XBC = WS_QO + al((size_t)T * 512 * 2);
constexpr size_t WS_SSD = WS_XBC;
constexpr size_t WS_K = WS_XBC + al((size_t)T * 768 * 2);
constexpr size_t WS_V = WS_K + al((size_t)T * 128 * 2);
constexpr size_t WS_Z = WS_V + al((size_t)T * 128 * 2);
constexpr size_t WS_G = WS_Z + al((size_t)T * 512 * 2);
constexpr size_t WS_HID = WS_G;
constexpr size_t WS_X1B = WS_QO;
constexpr size_t WS_DT = WS_G + al((size_t)T * 2048 * 2);
constexpr size_t WS_ACUM = WS_DT + al((size_t)T * 16 * 4);
constexpr size_t WS_ROUTE = WS_ACUM + al((size_t)T * 16 * 4);
constexpr size_t WS_ST = WS_ROUTE + 2 * MiB;
constexpr size_t WS_MERGED = WS_ST;
constexpr size_t WS_XS = WS_ST;
constexpr size_t WS_END = WS_ST + al((size_t)TS * DM * 2);
static_assert((size_t)2 * BATCH * NCHUNK * 8 * 64 * 64 * 4 <= (size_t)TS * DM * 2, "ST fits in the XS region");
static_assert(WS_END <= (size_t)512 * MiB, "workspace map exceeds 512 MiB");
static_assert(WS_X1B + (size_t)T * DM * 2 <= WS_G, "x1 (bf16) overlay");
constexpr size_t RT_BUCKET = 0;
constexpr size_t RT_RANK = RT_BUCKET + (size_t)T * 4;
constexpr size_t RT_WA = RT_RANK + (size_t)T * 4;
constexpr size_t RT_WB = RT_WA + (size_t)T * 4;
constexpr size_t RT_CNT = RT_WB + (size_t)T * 4;
constexpr size_t RT_PERM = RT_CNT + al((size_t)NRT * NBUCKET * 4);
constexpr size_t RT_TB = RT_PERM + al((size_t)TS * 4);
constexpr size_t RT_SWA = RT_TB + 1024;
constexpr size_t RT_SWB = RT_SWA + al((size_t)TS * 4);
constexpr size_t RT_WRT = RT_SWB + al((size_t)TS * 4);
constexpr size_t RT_RSTD = RT_WRT + al((size_t)32 * DM * 2);
constexpr size_t RT_SRS = RT_RSTD + al((size_t)T * 4);
static_assert(RT_SRS + al((size_t)TS * 4) <= 2 * MiB, "routing records");
static_assert(RT_WRT + 65536 <= 2 * MiB, "routing records");

struct Params {
    const float *x, *norm_mix_w, *w_in, *b_gate, *q_norm_w, *k_norm_w, *w_attn_o, *conv_w, *conv_b, *dt_bias, *a_log, *d_skip, *ssd_norm_w, *w_ssd_o, *w_out,
        *norm_ffn_w, *w_rg, *b_rg, *w_re, *b_re, *w1, *w3, *w2;
    float* out; unsigned char* ws;
};

__device__ __forceinline__ unsigned f2bf(float f) { unsigned u = __builtin_bit_cast(unsigned, f); return (u + 0x7fffu + ((u >> 16) & 1u)) >> 16; }
__device__ __forceinline__ float bf2f(unsigned short b) { return __builtin_bit_cast(float, (unsigned)b << 16); }
__device__ __forceinline__ unsigned pk2(float lo, float hi) { return f2bf(lo) | (f2bf(hi) << 16); }
template <int CTRL> __device__ __forceinline__ float dpp_f(float v) { return __builtin_bit_cast(float, __builtin_amdgcn_update_dpp(0, __builtin_bit_cast(int, v), CTRL, 0xf, 0xf, false)); }
__device__ __forceinline__ float row16_sum(float v) { v += dpp_f<0x121>(v); v += dpp_f<0x122>(v); v += dpp_f<0x124>(v); v += dpp_f<0x128>(v); return v; }
__device__ __forceinline__ float half32_sum(float v) { v = row16_sum(v); const unsigned u = __builtin_bit_cast(unsigned, v);
    auto rr = __builtin_amdgcn_permlane16_swap(u, u, false, false); return __builtin_bit_cast(float, (unsigned)rr[0]) + __builtin_bit_cast(float, (unsigned)rr[1]); }
__device__ __forceinline__ float wave_sum(float v) { v = half32_sum(v); const unsigned u = __builtin_bit_cast(unsigned, v);
    auto rr = __builtin_amdgcn_permlane32_swap(u, u, false, false); return __builtin_bit_cast(float, (unsigned)rr[0]) + __builtin_bit_cast(float, (unsigned)rr[1]); }
__device__ __forceinline__ float silu_f(float v) { return v / (1.f + __expf(-v)); }
__device__ __forceinline__ float sigmoid_f(float v) { return 1.f / (1.f + __expf(-v)); }
__device__ __forceinline__ float softplus_f(float v) { return v > 20.f ? v : log1pf(__expf(v)); }

template <class T_> __device__ __forceinline__ T_* wsp(const Params& p, size_t off) { return (T_*)(p.ws + off); }

namespace gm2 {
#define PG8_LAS __attribute__((address_space(3)))
constexpr int BM = 256, BK = 64, TILE_B = BM * BK * 2, STAGE_B = 2 * TILE_B, LDS_NEED = 2 * STAGE_B;
__device__ __forceinline__ int lds_byte(int r, int c) { const int st = (r >> 4) * 2 + (c >> 5), ob = (r & 15) * 64 + (c & 31) * 2; return st * 1024 + (ob ^ (((ob >> 9) & 1) << 5)); }
__device__ __forceinline__ void stage_rc(int b, int& R, int& C) { const int st = b >> 10, sb = b & 1023, swz = sb ^ (((sb >> 9) & 1) << 5); R = (st >> 1) * 16 + swz / 64; C = (st & 1) * 32 + (swz % 64) / 2; }
__device__ __forceinline__ int perm32(int rho) { const int n = rho >> 4, i = rho & 15; return 8 * (i >> 2) + 4 * n + (i & 3); }
struct Unit { int pm, pn, aux; };
typedef float f32x2_t __attribute__((ext_vector_type(2))); typedef __bf16 bf16x2_t __attribute__((ext_vector_type(2)));
__device__ __forceinline__ unsigned cvt_pk_bf16(float lo, float hi) { f32x2_t v = {lo, hi}; bf16x2_t b = __builtin_convertvector(v, bf16x2_t); return __builtin_bit_cast(unsigned, b); }

template <class Epi, class Sched>
__device__ __forceinline__ void gemm_phase(PG8_LAS unsigned char* lds, const int K, const Sched& S, const Epi& E) {
    int tid_ = threadIdx.x; asm volatile("" : "+v"(tid_));
    const int tid = tid_, wid = __builtin_amdgcn_readfirstlane(tid >> 6), lane = tid & 63, wr = wid >> 2, wc = wid & 3, fr = lane & 15, fq = lane >> 4;
    const int nt = K / BK;
    unsigned voffA[4], voffB[4];
#pragma unroll
    for (int i = 0; i < 4; ++i) { int R, C; stage_rc(tid * 16 + i * 8192, R, C); const int Rb = Epi::PERM ? ((R & ~31) + perm32(R & 31)) : R;
        voffA[i] = (unsigned)(R * K + C) * 2u; voffB[i] = (unsigned)(Rb * K + C) * 2u; }
    const unsigned ldsw = (unsigned)wid * 1024u;
    const int aoff = lds_byte(wr * 128 + fr, fq * 8), boff = lds_byte(wc * 64 + fr, fq * 8);
#ifndef GM2_REGSTAGE
#define GM2_REGSTAGE 0
#endif
#if GM2_REGSTAGE
#define GM2_STAGE(buf, abase, bbase, kt) do { _Pragma("unroll") for (int _i = 0; _i < 4; ++_i) { \
        const u32x4 va_ = *(const u32x4*)((abase) + (size_t)(kt) * (BK * 2) + voffA[_i]); const u32x4 vb_ = *(const u32x4*)((bbase) + (size_t)(kt) * (BK * 2) + voffB[_i]); \
        *(PG8_LAS u32x4*)(lds + (buf) * STAGE_B + ldsw + _i * 8192 + lane * 16) = va_; *(PG8_LAS u32x4*)(lds + (buf) * STAGE_B + TILE_B + ldsw + _i * 8192 + lane * 16) = vb_; } } while (0)
#else
#define GM2_STAGE(buf, abase, bbase, kt) do { _Pragma("unroll") for (int _i = 0; _i < 4; ++_i) { \
        __builtin_amdgcn_global_load_lds((const unsigned*)((abase) + (size_t)(kt) * (BK * 2) + voffA[_i]), (PG8_LAS unsigned*)(lds + (buf) * STAGE_B + ldsw + _i * 8192), 16, 0, 0); \
        __builtin_amdgcn_global_load_lds((const unsigned*)((bbase) + (size_t)(kt) * (BK * 2) + voffB[_i]), (PG8_LAS unsigned*)(lds + (buf) * STAGE_B + TILE_B + ldsw + _i * 8192), 16, 0, 0); } } while (0)
#endif
#define GM2_WAIT_V0() asm volatile("s_waitcnt vmcnt(0)" ::: "memory")
    Unit cur, nxt;
    if (!S.next(0, cur)) return;
    const char* cA = S.abase(cur); const char* cB = S.bbase(cur);
    GM2_STAGE(0, cA, cB, 0); GM2_WAIT_V0(); __syncthreads();
    for (int ui = 0;; ++ui) {
        const bool has_next = S.next(ui + 1, nxt);
        const char* nA = has_next ? S.abase(nxt) : cA; const char* nB = has_next ? S.bbase(nxt) : cB;
        f32x4 acc[8][4];
#pragma unroll
        for (int m = 0; m < 8; ++m)
#pragma unroll
            for (int n = 0; n < 4; ++n) acc[m][n] = (f32x4){0.f, 0.f, 0.f, 0.f};
        for (int t = 0; t < nt; ++t) {
            const int cb = t & 1;
            if (t + 1 < nt) { GM2_STAGE(cb ^ 1, cA, cB, t + 1); }
            else if (has_next) { GM2_STAGE(cb ^ 1, nA, nB, 0); }
#pragma unroll
            for (int ks = 0; ks < 2; ++ks) {
                bf16x8 At[8], Bf[4];
#pragma unroll
                for (int n = 0; n < 4; ++n) Bf[n] = *(const PG8_LAS bf16x8*)(lds + cb * STAGE_B + TILE_B + boff + n * 2048 + ks * 1024);
#pragma unroll
                for (int m = 0; m < 8; ++m) At[m] = *(const PG8_LAS bf16x8*)(lds + cb * STAGE_B + aoff + m * 2048 + ks * 1024);
#pragma unroll
                for (int m = 0; m < 8; ++m)
#pragma unroll
                    for (int n = 0; n < 4; ++n) acc[m][n] = __builtin_amdgcn_mfma_f32_16x16x32_bf16(Bf[n], At[m], acc[m][n], 0, 0, 0);
                __builtin_amdgcn_sched_group_barrier(0x100, 6, 0);
#pragma unroll
                for (int m = 0; m < 6; ++m) { __builtin_amdgcn_sched_group_barrier(0x008, 4, 0); __builtin_amdgcn_sched_group_barrier(0x100, 1, 0); }
                __builtin_amdgcn_sched_group_barrier(0x008, 8, 0);
                __builtin_amdgcn_sched_barrier(0);
            }
            GM2_WAIT_V0(); __syncthreads();
        }
        { int fr2 = fr, fq2 = fq; asm volatile("" : "+v"(fr2), "+v"(fq2)); E(acc, cur, wr, wc, fr2, fq2); }
        if (!has_next) break;
        cur = nxt; cA = nA; cB = nB;
    }
#undef GM2_STAGE
#undef GM2_WAIT_V0
}

struct SchedProj {
    int vcu, G; const char* A; const char* B; size_t tstep;
    __device__ __forceinline__ bool next(int i, Unit& u) const { const int uid = vcu + i * G; if (uid >= 128 * 16) return false; u.pm = uid >> 4; u.pn = uid & 15; u.aux = 0; return true; }
    __device__ __forceinline__ const char* abase(const Unit& u) const { return A + (size_t)u.pm * tstep; }
    __device__ __forceinline__ const char* bbase(const Unit& u) const { return B + (size_t)u.pn * tstep; }
};
struct SchedMerged {
    int vcu, G; const char *A0, *A1, *B0, *B1; size_t tstep;
    __device__ __forceinline__ bool next(int i, Unit& u) const { const int tile = vcu + (i >> 1) * G; if (tile >= 512) return false; u.pm = tile >> 2; u.pn = tile & 3; u.aux = i & 1; return true; }
    __device__ __forceinline__ const char* abase(const Unit& u) const { return (u.aux ? A1 : A0) + (size_t)u.pm * tstep; }
    __device__ __forceinline__ const char* bbase(const Unit& u) const { return (u.aux ? B1 : B0) + (size_t)u.pn * tstep; }
};
struct SchedWout {
    int vcu, G; const char *A, *B; size_t tstep;
    __device__ __forceinline__ bool next(int i, Unit& u) const { const int tile = vcu + i * G; if (tile >= 512) return false; u.pm = tile >> 2; u.pn = tile & 3; u.aux = 0; return true; }
    __device__ __forceinline__ const char* abase(const Unit& u) const { return A + (size_t)u.pm * tstep; }
    __device__ __forceinline__ const char* bbase(const Unit& u) const { return B + (size_t)u.pn * tstep; }
};
__device__ __forceinline__ void pair_of2(int pidx, int& a, int& b) { a = pidx < 3 ? 0 : (pidx < 5 ? 1 : 2); b = pidx < 3 ? pidx + 1 : (pidx < 5 ? pidx - 1 : 3); }
struct SchedMoe1 {
    int vcu, G, ntile; const int* tbk; const char *A, *W13; size_t tstep;
    __device__ __forceinline__ bool next(int i, Unit& u) const { const int uid = vcu + i * G; if (uid >= ntile * 8) return false; u.pm = uid >> 3; u.pn = uid & 7; u.aux = __builtin_amdgcn_readfirstlane(tbk[u.pm]); return true; }
    __device__ __forceinline__ const char* abase(const Unit& u) const { return A + (size_t)u.pm * tstep; }
    __device__ __forceinline__ const char* bbase(const Unit& u) const { const int g = u.aux / 6; int a, b; pair_of2(u.aux % 6, a, b); const int e = g * 4 + (u.pn < 4 ? a : b);
        return W13 + ((size_t)e * 1024 + (size_t)(u.pn & 3) * 256) * (1024 * 2); }
};
struct SchedMoe2 {
    int vcu, G, ntile; const int* tbk; const char *A, *W2P; size_t tstep;
    __device__ __forceinline__ bool next(int i, Unit& u) const { const int uid = vcu + i * G; if (uid >= ntile * 4) return false; u.pm = uid >> 2; u.pn = uid & 3; u.aux = __builtin_amdgcn_readfirstlane(tbk[u.pm]); return true; }
    __device__ __forceinline__ const char* abase(const Unit& u) const { return A + (size_t)u.pm * tstep; }
    __device__ __forceinline__ const char* bbase(const Unit& u) const { return W2P + ((size_t)u.aux * 1024 + (size_t)u.pn * 256) * (1024 * 2); }
};

__device__ __forceinline__ float silu_e(float v) { return v * __builtin_amdgcn_rcpf(1.f + __builtin_amdgcn_exp2f(-1.4426950408889634f * v)); }
__device__ __forceinline__ float sigm_e(float v) { return __builtin_amdgcn_rcpf(1.f + __builtin_amdgcn_exp2f(-1.4426950408889634f * v)); }
__device__ __forceinline__ float bflo(unsigned w) { return __builtin_bit_cast(float, w << 16); }
__device__ __forceinline__ float bfhi(unsigned w) { return __builtin_bit_cast(float, w & 0xffff0000u); }
__device__ __forceinline__ u32x4 pack8(const f32x4& v0, const f32x4& v1) { u32x4 w; w.x = cvt_pk_bf16(v0[0], v0[1]); w.y = cvt_pk_bf16(v0[2], v0[3]); w.z = cvt_pk_bf16(v1[0], v1[1]); w.w = cvt_pk_bf16(v1[2], v1[3]); return w; }
__device__ __forceinline__ float softplus_e(float v) {
    const float e = __builtin_amdgcn_exp2f(1.4426950408889634f * fminf(v, 20.f));
    const float s = e * (1.f - e * (0.5f - e * 0.33333334f));
    const float l = 0.6931471805599453f * __builtin_amdgcn_logf(1.f + e);
    const float r = e < 0.03f ? s : l;
    return v > 20.f ? v : r;
}
struct EpiInProj {
    static constexpr bool PERM = true;
    unsigned char* ws; const float* b_gate;
    template <int LD, bool ACT> static __device__ __forceinline__ void store_plain(const f32x4 (&acc)[8][4], bf16_t* base, int row0) {
#pragma unroll
        for (int m = 0; m < 8; ++m) { bf16_t* rp = base + (size_t)(row0 + m * 16) * LD;
#pragma unroll
            for (int n2 = 0; n2 < 2; ++n2) { f32x4 v0 = acc[m][2 * n2], v1 = acc[m][2 * n2 + 1];
                if (ACT) {
#pragma unroll
                    for (int e = 0; e < 4; ++e) { v0[e] = silu_e(v0[e]); v1[e] = silu_e(v1[e]); } }
                *(u32x4*)(rp + n2 * 32) = pack8(v0, v1); }
            if (m & 1) asm volatile("" ::: "memory"); }
    }
    __device__ __forceinline__ void operator()(const f32x4 (&acc)[8][4], const Unit& u, int wr, int wc, int fr, int fq) const {
        const int row0 = u.pm * BM + wr * 128 + fr, pn = u.pn, lc = wc * 64 + 8 * fq;
        if (pn >= 8) {
            const int colt = (pn - 8) * BM + lc; bf16_t* G = (bf16_t*)(ws + WS_G);
            f32x4 bv[2][2];
#pragma unroll
            for (int n2 = 0; n2 < 2; ++n2) { bv[n2][0] = *(const f32x4*)(b_gate + colt + n2 * 32); bv[n2][1] = *(const f32x4*)(b_gate + colt + n2 * 32 + 4); }
#pragma unroll
            for (int m = 0; m < 8; ++m) { bf16_t* rp = G + (size_t)(row0 + m * 16) * 2048 + colt;
#pragma unroll
                for (int n2 = 0; n2 < 2; ++n2) { f32x4 v0 = acc[m][2 * n2] + bv[n2][0], v1 = acc[m][2 * n2 + 1] + bv[n2][1];
#pragma unroll
                    for (int e = 0; e < 4; ++e) { v0[e] = sigm_e(v0[e]); v1[e] = sigm_e(v1[e]); }
                    *(u32x4*)(rp + n2 * 32) = pack8(v0, v1); }
                if (m & 1) asm volatile("" ::: "memory"); }
        } else if (pn < 2) store_plain<512, false>(acc, (bf16_t*)(ws + WS_QO) + pn * BM + lc, row0);
        else if (pn == 2) { if (wc < 2) store_plain<128, false>(acc, (bf16_t*)(ws + WS_K) + lc, row0); else store_plain<128, false>(acc, (bf16_t*)(ws + WS_V) + (lc - 128), row0); }
        else if (pn < 5) store_plain<512, true>(acc, (bf16_t*)(ws + WS_Z) + (pn - 3) * BM + lc, row0);
        else store_plain<768, false>(acc, (bf16_t*)(ws + WS_XBC) + (pn - 5) * BM + lc, row0);
    }
};
struct EpiMerged {
    static constexpr bool PERM = true;
    const bf16_t* G; bf16_t* MG;
    __device__ __forceinline__ void operator()(const f32x4 (&acc)[8][4], const Unit& u, int wr, int wc, int fr, int fq) const {
        const int row0 = u.pm * BM + wr * 128 + fr, col0 = u.pn * BM + wc * 64 + 8 * fq, goff = u.aux ? 0 : 1024;
#pragma unroll
        for (int m = 0; m < 8; ++m) { const size_t row = (size_t)(row0 + m * 16);
#pragma unroll
            for (int n2 = 0; n2 < 2; ++n2) { const int col = col0 + n2 * 32;
                const u32x4 gv = *(const u32x4*)(G + row * 2048 + goff + col);
                f32x4 v0 = acc[m][2 * n2], v1 = acc[m][2 * n2 + 1];
                v0[0] *= bflo(gv.x); v0[1] *= bfhi(gv.x); v0[2] *= bflo(gv.y); v0[3] *= bfhi(gv.y); v1[0] *= bflo(gv.z); v1[1] *= bfhi(gv.z); v1[2] *= bflo(gv.w); v1[3] *= bfhi(gv.w);
                bf16_t* dst = MG + row * 1024 + col;
                if (u.aux) { const u32x4 ov = *(const u32x4*)dst;
                    v0[0] += bflo(ov.x); v0[1] += bfhi(ov.x); v0[2] += bflo(ov.y); v0[3] += bfhi(ov.y); v1[0] += bflo(ov.z); v1[1] += bfhi(ov.z); v1[2] += bflo(ov.w); v1[3] += bfhi(ov.w); }
                *(u32x4*)dst = pack8(v0, v1); }
            asm volatile("" ::: "memory"); }
    }
};
struct EpiWout {
    static constexpr bool PERM = false;
    const float* x; float* out;
    __device__ __forceinline__ void operator()(const f32x4 (&acc)[8][4], const Unit& u, int wr, int wc, int fr, int fq) const {
        const int row0 = u.pm * BM + wr * 128 + fr, col0 = u.pn * BM + wc * 64 + 4 * fq;
#pragma unroll
        for (int m = 0; m < 8; ++m) { const size_t off = (size_t)(row0 + m * 16) * 1024 + col0;
#pragma unroll
            for (int n = 0; n < 4; ++n) *(f32x4*)(out + off + n * 16) = *(const f32x4*)(x + off + n * 16) + acc[m][n];
            if (m & 1) asm volatile("" ::: "memory"); }
    }
};
struct EpiMoe1 {
    static constexpr bool PERM = true;
    bf16_t* HID; const float* SWA; const float* SWB;
    __device__ __forceinline__ void operator()(const f32x4 (&acc)[8][4], const Unit& u, int wr, int wc, int fr, int fq) const {
        const int row0 = u.pm * BM + wr * 128 + fr, slot = u.pn >> 2, hc = slot * 512 + (u.pn & 3) * 128 + 32 * wc + 4 * fq;
        const float* SW = slot ? SWB : SWA;
#pragma unroll
        for (int m = 0; m < 8; ++m) { const size_t row = (size_t)(row0 + m * 16); const float w = SW[row];
#pragma unroll
            for (int n2 = 0; n2 < 2; ++n2) { const f32x4 v0 = acc[m][2 * n2], v1 = acc[m][2 * n2 + 1];
                float h0 = w * silu_e(v0[0]) * v0[1], h1 = w * silu_e(v0[2]) * v0[3], h2 = w * silu_e(v1[0]) * v1[1], h3 = w * silu_e(v1[2]) * v1[3];
                if (w == 0.f) { h0 = 0.f; h1 = 0.f; h2 = 0.f; h3 = 0.f; }
                u32x2 o; o.x = cvt_pk_bf16(h0, h1); o.y = cvt_pk_bf16(h2, h3);
                *(u32x2*)(HID + row * 1024 + hc + 16 * n2) = o; } }
    }
};
struct EpiMoe2 {
    static constexpr bool PERM = false;
    float* out; const int* perm;
    __device__ __forceinline__ void operator()(const f32x4 (&acc)[8][4], const Unit& u, int wr, int wc, int fr, int fq) const {
        const int row0 = u.pm * BM + wr * 128 + fr, col0 = u.pn * BM + wc * 64 + 4 * fq;
#pragma unroll
        for (int m = 0; m < 8; ++m) { const int tok = perm[row0 + m * 16];
            if (tok >= 0) { float* op = out + (size_t)tok * 1024 + col0;
#pragma unroll
                for (int n = 0; n < 4; ++n) { f32x4* q = (f32x4*)(op + n * 16); *q = *q + acc[m][n]; } } }
    }
};
}


#define GAS __attribute__((address_space(1)))
#define LAS __attribute__((address_space(3)))
typedef GAS unsigned gu32;
#define RLX_AGENT __ATOMIC_RELAXED, __HIP_MEMORY_SCOPE_AGENT
constexpr int CW_BAR = 4096;
constexpr int MISC_OFF = 147456 - 256;
#define XB_TMO      128
#define XB_XCNT(j)  (256  + 64 * (j))
#define XB_XSUB(j)  (1280 + 64 * (j))
#define XB_XGEN(j)  (2304 + 64 * (j))
#define XB_TOP      3328
#define XB_TOPGEN   3392
#define XCD_BAR_WORDS 3456
#define XB_SPIN_CAP (1u << 18)

__device__ __forceinline__ unsigned xb_ld(unsigned* p)              { return __hip_atomic_load(p, __ATOMIC_RELAXED, __HIP_MEMORY_SCOPE_AGENT); }
__device__ __forceinline__ unsigned xb_add(unsigned* p, unsigned v) { return __hip_atomic_fetch_add(p, v, __ATOMIC_RELAXED, __HIP_MEMORY_SCOPE_AGENT); }
__device__ __forceinline__ unsigned xb_xcc_id() { return (unsigned)__builtin_amdgcn_s_getreg((3 << 11) | 20) & 0xFu; }
#define XB_SPIN(cond, bar) do { unsigned _sp = 0; while (cond) { __builtin_amdgcn_s_sleep(1); \
    if ((++_sp & 255u) == 0u) { if (xb_ld(&(bar)[XB_TMO])) break; if (_sp > XB_SPIN_CAP) { atomicAdd(&(bar)[XB_TMO], 1u); break; } } } } while (0)

struct XcdBarrier {
    unsigned* bar; unsigned x;
    volatile LAS unsigned* st;
};

__device__ __forceinline__ XcdBarrier xcd_barrier_post(unsigned* bar, volatile LAS unsigned* st) {
    XcdBarrier b; b.bar = bar; b.x = xb_xcc_id(); b.st = st;
    if (threadIdx.x == 0) (void)xb_add(&bar[XB_XCNT(b.x)], 1u);
    return b;
}
__device__ __forceinline__ void xcd_barrier_complete(unsigned* bar, unsigned x, unsigned& nloc, unsigned& nx) {
    const unsigned G = gridDim.x * gridDim.y * gridDim.z;
    unsigned sum, cnt, mine, sp = 0u;
    for (;;) {
        sum = 0u; cnt = 0u; mine = 0u;
#pragma unroll
        for (unsigned j = 0; j < 16; ++j) { const unsigned c = xb_ld(&bar[XB_XCNT(j)]); sum += c; cnt += (c > 0u) ? 1u : 0u; mine = (j == x) ? c : mine; }
        if (sum == G) break;
        __builtin_amdgcn_s_sleep(1);
        if ((++sp & 255u) == 0u) { if (xb_ld(&bar[XB_TMO])) break; if (sp > XB_SPIN_CAP) { atomicAdd(&bar[XB_TMO], 1u); break; } }
    }
    nloc = mine > 0u ? mine : 1u; nx = cnt > 0u ? cnt : 1u;
}

__device__ __forceinline__ void xcd_barrier(const XcdBarrier& b) {
    asm volatile("s_waitcnt vmcnt(0)" ::: "memory");
    __syncthreads();
    if (threadIdx.x == 0) {
        unsigned* bar = b.bar;
        __builtin_amdgcn_s_waitcnt(0);
        unsigned nloc = b.st[0], nx = b.st[1];
        if (nloc == 0u) { xcd_barrier_complete(bar, b.x, nloc, nx); b.st[0] = nloc; b.st[1] = nx; }
        const unsigned old = xb_add(&bar[XB_XSUB(b.x)], 1u);
        const unsigned gen = old / nloc;
        if (old + 1u == (gen + 1u) * nloc) {
            __builtin_amdgcn_fence(__ATOMIC_RELEASE, "agent");
            asm volatile("s_waitcnt vmcnt(0)" ::: "memory");
            const unsigned og = xb_add(&bar[XB_TOP], 1u);
            const unsigned tg = og / nx;
            if (og + 1u == (tg + 1u) * nx) xb_add(&bar[XB_TOPGEN], 1u);
            else XB_SPIN(xb_ld(&bar[XB_TOPGEN]) == tg, bar);
            __builtin_amdgcn_fence(__ATOMIC_ACQUIRE, "agent");
            xb_add(&bar[XB_XGEN(b.x)], 1u);
            asm volatile("s_waitcnt vmcnt(0)" ::: "memory");
        } else {
            XB_SPIN(xb_ld(&bar[XB_XGEN(b.x)]) == gen, bar);
            __builtin_amdgcn_fence(__ATOMIC_ACQUIRE, "agent");
            asm volatile("s_waitcnt vmcnt(0)" ::: "memory");
        }
    }
    __syncthreads();
}

struct TrJob { const float* W; int ldw, K, sc0, ncols; bf16_t* dst; int ldd, dr0, dstride, dk0; bf16_t* dst2; int dk2; bf16_t* dst3; int dk3; const float* ks = nullptr; };
__device__ __forceinline__ int tr_items(const TrJob& j) { return (j.K / 64) * ((j.ncols + 31) / 32); }
constexpr int tr_items_c(int K, int ncols) { return (K / 64) * ((ncols + 31) / 32); }
__device__ __forceinline__ void tr_item(const TrJob& j, int item, float* scr  , int lane) {
    const int nblk = (j.ncols + 31) / 32, kb = item / nblk, nb = item % nblk, k0 = 64 * kb, n0 = 32 * nb;
    const int nvalid = min(32, j.ncols - n0);
    {
        f32x4 v[8]; const int n4 = 4 * (lane & 7), kr = lane >> 3; const float* src = j.W + (size_t)(k0 + kr) * j.ldw + j.sc0 + n0 + (n4 < nvalid ? n4 : 0);
#pragma unroll
        for (int i = 0; i < 8; ++i) v[i] = *(const f32x4*)(src + (size_t)(8 * i) * j.ldw);
#pragma unroll
        for (int i = 0; i < 8; ++i) { float* d = scr + (8 * i + kr) * 33 + n4; d[0] = v[i][0]; d[1] = v[i][1]; d[2] = v[i][2]; d[3] = v[i][3]; }
    }
    __builtin_amdgcn_s_waitcnt(0xc07f); asm volatile("" ::: "memory");
    const int c = lane & 7;
    f32x4 ka = {1.f, 1.f, 1.f, 1.f}, kc = ka;
    if (j.ks) { ka = *(const f32x4*)(j.ks + k0 + 8 * c); kc = *(const f32x4*)(j.ks + k0 + 8 * c + 4); }
#pragma unroll
    for (int jj = 0; jj < 4; ++jj) { const int n = (lane >> 3) + 8 * jj; const float* s = scr + (8 * c) * 33 + n;
        u32x4 o; o.x = pk2(s[0 * 33] * ka[0], s[1 * 33] * ka[1]); o.y = pk2(s[2 * 33] * ka[2], s[3 * 33] * ka[3]); o.z = pk2(s[4 * 33] * kc[0], s[5 * 33] * kc[1]); o.w = pk2(s[6 * 33] * kc[2], s[7 * 33] * kc[3]);
        if (n < nvalid) { const size_t ro = (size_t)(j.dr0 + (n0 + n) * j.dstride) * j.ldd + k0 + 8 * c; *(u32x4*)(j.dst + ro + j.dk0) = o;
            if (j.dst2) *(u32x4*)(j.dst2 + ro + j.dk2) = o; if (j.dst3) *(u32x4*)(j.dst3 + ro + j.dk3) = o; } }
    __builtin_amdgcn_s_waitcnt(0xc07f); asm volatile("" ::: "memory");
}
__device__ __forceinline__ void pair_of(int pidx, int& a, int& b) {
    a = pidx < 3 ? 0 : (pidx < 5 ? 1 : 2); b = pidx < 3 ? pidx + 1 : (pidx < 5 ? pidx - 1 : 3);
}
constexpr int TR_WIN = 2064, TR_EARLY = 3088, TR_W2 = TR_EARLY + 32 * 256, TR_TOTAL = TR_W2 + 16 * 256;
__device__ __forceinline__ void tr_mkjob(const Params& p, int g, TrJob& j, int& it) {
    bf16_t* WinT = wsp<bf16_t>(p, WS_WIN);
    if (g < 1024) { it = g; j = TrJob{p.w_in, IN_PROJ, DM, 0, 2048, WinT, DM, 0, 1, 0, nullptr, 0, nullptr, 0}; }
    else if (g < 2048) { it = g - 1024; j = TrJob{p.w_in, IN_PROJ, DM, 2064, 2048, WinT, DM, 2048, 1, 0, nullptr, 0, nullptr, 0}; }
    else if (g < 2064) { it = g - 2048; j = TrJob{p.w_in, IN_PROJ, DM, 2048, 16, WinT, DM, 4096, 1, 0, nullptr, 0, nullptr, 0}; }
    else if (g < 2320) { it = g - 2064; j = TrJob{p.w_attn_o, DM, 512, 0, DM, wsp<bf16_t>(p, WS_WA), 512, 0, 1, 0, nullptr, 0, nullptr, 0}; }
    else if (g < 2576) { it = g - 2320; j = TrJob{p.w_ssd_o, DM, 512, 0, DM, wsp<bf16_t>(p, WS_WS), 512, 0, 1, 0, nullptr, 0, nullptr, 0}; }
    else if (g < TR_EARLY) { it = g - 2576; j = TrJob{p.w_out, DM, DM, 0, DM, wsp<bf16_t>(p, WS_WO), DM, 0, 1, 0, nullptr, 0, nullptr, 0}; }
    else { const int q = (g - TR_EARLY) >> 8, e = q & 15; it = (g - TR_EARLY) & 255;
        if (q < 16) j = TrJob{p.w1 + (size_t)e * DM * DE, DE, DM, 0, DE, wsp<bf16_t>(p, WS_W13) + (size_t)e * 1024 * DM, DM, 0, 2, 0, nullptr, 0, nullptr, 0, p.norm_ffn_w};
        else if (q < 32) j = TrJob{p.w3 + (size_t)e * DM * DE, DE, DM, 0, DE, wsp<bf16_t>(p, WS_W13) + (size_t)e * 1024 * DM, DM, 1, 2, 0, nullptr, 0, nullptr, 0, p.norm_ffn_w};
        else j = TrJob{p.w2 + (size_t)e * DE * DM, DM, DE, 0, DM, wsp<bf16_t>(p, WS_W2P) + (size_t)e * 1024 * 512, 512, 0, 1, 0, nullptr, 0, nullptr, 0}; }
}
static_assert(tr_items_c(DM, 2048) == 1024 && tr_items_c(DM, 16) == 16 && tr_items_c(512, DM) == 256 && tr_items_c(DM, DM) == 512 && tr_items_c(DM, DE) == 256 && tr_items_c(DE, DM) == 256, "item counts of the flat transpose table");
__device__ __forceinline__ void phase_tr_range(const Params& p, float* scr, int lane, int g0, int g1, int w, int nw) {
    for (int g = g0 + w; g < g1; g += nw) { TrJob j; int it; tr_mkjob(p, g, j, it); tr_item(j, it, scr, lane); }
}
__device__ __forceinline__ void phase_p0(const Params& p, unsigned char* lds) {
    const int tid = tid_opaque(), lane = tid & 63, wave = tid >> 6;
    float* scr = (float*)lds + wave * (64 * 33);
    const int gw = blockIdx.x * 8 + wave, NGW = gridDim.x * 8;
    bf16_t* WinT = wsp<bf16_t>(p, WS_WIN);
    phase_tr_range(p, scr, lane, 0, TR_WIN, gw, NGW);
    { bf16_t* WRT = (bf16_t*)(p.ws + WS_ROUTE + RT_WRT);
      for (int i = blockIdx.x * 512 + tid; i < 32 * DM; i += gridDim.x * 512) { const int n = i >> 10, k = i & 1023;
          const float v = n < 4 ? p.w_rg[k * 4 + n] : (n < 20 ? p.w_re[k * 16 + (n - 4)] : 0.f); WRT[i] = (bf16_t)f2bf(v * p.norm_ffn_w[k]); } }
    { u32x4 z = {0u, 0u, 0u, 0u}; u32x4* d = (u32x4*)(WinT + (size_t)4112 * DM); const int n16 = (NPROJ - 4112) * DM * 2 / 16;
      for (int i = blockIdx.x * 512 + tid; i < n16; i += gridDim.x * 512) d[i] = z; }
    bf16_t* H = wsp<bf16_t>(p, WS_H);
    {
        const f32x4* wr = (const f32x4*)p.norm_mix_w;
        f32x4 w4[4];
#pragma unroll
        for (int jj = 0; jj < 4; ++jj) w4[jj] = wr[2 * lane + (jj & 1) + 128 * (jj >> 1)];
        for (int m = gw; m + 3 * NGW < T; m += 4 * NGW) {
            f32x4 v[4][4];
#pragma unroll
            for (int r = 0; r < 4; ++r) { const f32x4* xr = (const f32x4*)(p.x + (size_t)(m + r * NGW) * DM);
#pragma unroll
                for (int jj = 0; jj < 4; ++jj) v[r][jj] = xr[2 * lane + (jj & 1) + 128 * (jj >> 1)]; }
            __builtin_amdgcn_sched_barrier(0);
#pragma unroll
            for (int r = 0; r < 4; ++r) { float s = 0.f;
#pragma unroll
                for (int jj = 0; jj < 4; ++jj) s += (v[r][jj].x * v[r][jj].x + v[r][jj].y * v[r][jj].y) + (v[r][jj].z * v[r][jj].z + v[r][jj].w * v[r][jj].w);
                const float rstd = 1.f / sqrtf(wave_sum(s) * (1.f / DM) + EPS);
                u32x4* o16 = (u32x4*)(H + (size_t)(m + r * NGW) * DM);
#pragma unroll
                for (int hf = 0; hf < 2; ++hf) { const f32x4 a = v[r][2 * hf], b = v[r][2 * hf + 1], wa = w4[2 * hf], wb = w4[2 * hf + 1];
                    o16[lane + 64 * hf] = (u32x4){pk2(a.x * rstd * wa.x, a.y * rstd * wa.y), pk2(a.z * rstd * wa.z, a.w * rstd * wa.w), pk2(b.x * rstd * wb.x, b.y * rstd * wb.y), pk2(b.z * rstd * wb.z, b.w * rstd * wb.w)}; } }
        }
    }
}

template <class AF, class BF, class Epi>
__device__ __forceinline__ void gemm_naive(int M, int N, int K, const AF& af, const BF& bf, const Epi& epi) {
    const int lane = threadIdx.x & 63, gw = blockIdx.x * 8 + (threadIdx.x >> 6), NGW = gridDim.x * 8;
    const int tn = N / 32, nt = (M / 32) * tn, r = lane & 31, h = lane >> 5;
    for (int t = gw; t < nt; t += NGW) {
        const int pm = t / tn, pn = t % tn;
        const bf16_t* a = af(pm * 32 + r) + 8 * h; const bf16_t* b = bf(pm * 32, pn * 32 + r) + 8 * h;
        f32x16 acc = {0.f, 0.f, 0.f, 0.f, 0.f, 0.f, 0.f, 0.f, 0.f, 0.f, 0.f, 0.f, 0.f, 0.f, 0.f, 0.f};
        for (int k = 0; k < K; k += 16) { const bf16x8 av = *(const bf16x8*)(a + k), bv = *(const bf16x8*)(b + k); acc = __builtin_amdgcn_mfma_f32_32x32x16_bf16(av, bv, acc, 0, 0, 0); }
#pragma unroll
        for (int i = 0; i < 16; ++i) epi(pm * 32 + (i & 3) + 8 * (i >> 2) + 4 * h, pn * 32 + r, acc[i]);
    }
}

__device__ __forceinline__ void phase_p1(const Params& p) {
    const bf16_t* H = wsp<bf16_t>(p, WS_H); const bf16_t* W = wsp<bf16_t>(p, WS_WIN);
    bf16_t *QO = wsp<bf16_t>(p, WS_QO), *Kb = wsp<bf16_t>(p, WS_K), *Vb = wsp<bf16_t>(p, WS_V), *Z = wsp<bf16_t>(p, WS_Z), *XBC = wsp<bf16_t>(p, WS_XBC), *G = wsp<bf16_t>(p, WS_G);
    float* DT = wsp<float>(p, WS_DT); const float* b_gate = p.b_gate; const float* dt_bias = p.dt_bias;
    auto af = [=](int row) { return H + (size_t)row * DM; };
    auto bf = [=](int, int col) { return W + (size_t)col * DM; };
    auto epi = [=](int row, int c, float v) {
        if (c < 512) QO[(size_t)row * 512 + c] = (bf16_t)f2bf(v);
        else if (c < 640) Kb[(size_t)row * 128 + (c - 512)] = (bf16_t)f2bf(v);
        else if (c < 768) Vb[(size_t)row * 128 + (c - 640)] = (bf16_t)f2bf(v);
        else if (c < 1280) Z[(size_t)row * 512 + (c - 768)] = (bf16_t)f2bf(silu_f(v));
        else if (c < 2048) XBC[(size_t)row * 768 + (c - 1280)] = (bf16_t)f2bf(v);
        else if (c < 4096) G[(size_t)row * 2048 + (c - 2048)] = (bf16_t)f2bf(sigmoid_f(v + b_gate[c - 2048]));
        else if (c < 4112) DT[(size_t)row * 16 + (c - 4096)] = softplus_f(v + dt_bias[c - 4096]);
    };
    gemm_naive(T, NPROJ, DM, af, bf, epi);
}

__device__ __forceinline__ void phase_dt(const Params& p) {
    const bf16_t* H = wsp<bf16_t>(p, WS_H); const bf16_t* W = wsp<bf16_t>(p, WS_WIN) + (size_t)4096 * DM;
    float* DT = wsp<float>(p, WS_DT); const float* dt_bias = p.dt_bias;
    const int lane = tid_opaque() & 63, gw = blockIdx.x * 8 + (tid_opaque() >> 6), NGW = gridDim.x * 8, r = lane & 31, h = lane >> 5;
    const float bias = dt_bias[r & 15];
    for (int t = gw; t < T / 32; t += NGW) {
        const bf16_t* a = H + (size_t)(t * 32 + r) * DM + 8 * h; const bf16_t* b = W + (size_t)r * DM + 8 * h;
        f32x16 acc = {0.f, 0.f, 0.f, 0.f, 0.f, 0.f, 0.f, 0.f, 0.f, 0.f, 0.f, 0.f, 0.f, 0.f, 0.f, 0.f};
#pragma unroll 1
        for (int k0 = 0; k0 < DM; k0 += 256) {
            bf16x8 av[16], bv[16];
#pragma unroll
            for (int u = 0; u < 16; ++u) { av[u] = *(const bf16x8*)(a + k0 + 16 * u); bv[u] = *(const bf16x8*)(b + k0 + 16 * u); }
            __builtin_amdgcn_sched_barrier(0);
#pragma unroll
            for (int u = 0; u < 16; ++u) acc = __builtin_amdgcn_mfma_f32_32x32x16_bf16(av[u], bv[u], acc, 0, 0, 0);
            __builtin_amdgcn_sched_barrier(0);
        }
        if (r < 16) {
#pragma unroll
            for (int i = 0; i < 16; ++i) { const int row = t * 32 + (i & 3) + 8 * (i >> 2) + 4 * h; DT[(size_t)row * 16 + r] = softplus_f(acc[i] + bias); }
        }
    }
}
__device__ __forceinline__ void phase_p1_check(const Params& p) {
    const bf16_t* H = wsp<bf16_t>(p, WS_H); const bf16_t* W = wsp<bf16_t>(p, WS_WIN);
    bf16_t *QO = wsp<bf16_t>(p, WS_QO), *Kb = wsp<bf16_t>(p, WS_K), *Vb = wsp<bf16_t>(p, WS_V), *Z = wsp<bf16_t>(p, WS_Z), *XBC = wsp<bf16_t>(p, WS_XBC), *G = wsp<bf16_t>(p, WS_G);
    float* DT = wsp<float>(p, WS_DT); const float* b_gate = p.b_gate; const float* dt_bias = p.dt_bias;
    unsigned* ctl = (unsigned*)(p.ws + WS_CTL);
    auto af = [=](int row) { return H + (size_t)row * DM; };
    auto bf = [=](int, int col) { return W + (size_t)col * DM; };
    auto cmp2 = [=](float got, float want, int type, int row, int c) { if (!(fabsf(got - want) <= 0.03f + 0.03f * fabsf(want))) { if (c < 4096) ctl[8192 + (row >> 8) * 16 + (c >> 8)] = 1u; } };
    #define cmp(g_, w_, t_) cmp2(g_, w_, t_, row, c)
    auto epi = [=](int row, int c, float v) {
        if (c < 512) cmp(bf2f(QO[(size_t)row * 512 + c]), v, 0);
        else if (c < 640) cmp(bf2f(Kb[(size_t)row * 128 + (c - 512)]), v, 1);
        else if (c < 768) cmp(bf2f(Vb[(size_t)row * 128 + (c - 640)]), v, 2);
        else if (c < 1280) cmp(bf2f(Z[(size_t)row * 512 + (c - 768)]), silu_f(v), 3);
        else if (c < 2048) cmp(bf2f(XBC[(size_t)row * 768 + (c - 1280)]), v, 4);
        else if (c < 4096) cmp(bf2f(G[(size_t)row * 2048 + (c - 2048)]), sigmoid_f(v + b_gate[c - 2048]), 5);
        else if (c < 4112) cmp(DT[(size_t)row * 16 + (c - 4096)], softplus_f(v + dt_bias[c - 4096]), 6);
    };
    gemm_naive(T, NPROJ, DM, af, bf, epi);
}
#ifndef PROBE_SEL
#define PROBE_SEL 4
#endif
#ifndef PROBE_MODE
#define PROBE_MODE 1
#endif
__device__ __forceinline__ void phase_probe_out(const Params& p) {
    const unsigned* ctl = (const unsigned*)(p.ws + WS_CTL);
    __shared__ unsigned cnt[4];
    if (threadIdx.x == 0) { cnt[0] = 1000000u; cnt[1] = 0u; cnt[2] = 0u; cnt[3] = 0u; }
    __syncthreads();
    for (int i = threadIdx.x; i < 2048; i += 512) if (ctl[8192 + i]) { const unsigned v = (unsigned)(i & 255); atomicMin(&cnt[0], v); atomicMax(&cnt[1], v); atomicAdd(&cnt[2], 1u); atomicOr(&cnt[3], 1u << (i >> 8)); }
    __syncthreads();
#if PROBE_MODE == 0
    const float f = 1.f + (float)(cnt[0] + 1);
    const float V = 100.f * (float)(cnt[1] + 1);
#else
    const float f = 1.f + (float)(cnt[2]);
    const float V = 100.f * (float)(cnt[3] + 1);
#endif
    for (size_t i = (size_t)blockIdx.x * 512 + threadIdx.x; i < (size_t)T * DM; i += (size_t)gridDim.x * 512) p.out[i] = (i == 0) ? V : p.x[i] * f;
}
#undef cmp
__device__ __forceinline__ void phase_rope(const Params& p) {
    bf16_t* Kb = wsp<bf16_t>(p, WS_K);
    const int nth = gridDim.x * 512;
    for (int idx = blockIdx.x * 512 + tid_opaque(); idx < T * 2; idx += nth) {
        const int t = idx >> 1, hh = idx & 1;
        bf16_t* ptr = Kb + (size_t)t * 128 + hh * 64;
        const float* nw = p.k_norm_w;
        float x[64];
#pragma unroll
        for (int c = 0; c < 8; ++c) { const u32x4 v = *(const u32x4*)(ptr + 8 * c);
            x[8 * c + 0] = bf2f(v.x & 0xffff); x[8 * c + 1] = bf2f(v.x >> 16); x[8 * c + 2] = bf2f(v.y & 0xffff); x[8 * c + 3] = bf2f(v.y >> 16);
            x[8 * c + 4] = bf2f(v.z & 0xffff); x[8 * c + 5] = bf2f(v.z >> 16); x[8 * c + 6] = bf2f(v.w & 0xffff); x[8 * c + 7] = bf2f(v.w >> 16); }
        float ss = 0.f;
#pragma unroll
        for (int d = 0; d < 64; ++d) ss += x[d] * x[d];
        const float rstd = 1.f / sqrtf(ss * (1.f / 64.f) + EPS);
#pragma unroll
        for (int d = 0; d < 64; ++d) x[d] = x[d] * rstd * nw[d];
        const int pos = t % SEQ; const float frow = (float)(pos / 64), fcol = (float)(pos % 64);
        float o[64];
#pragma unroll
        for (int i = 0; i < 16; ++i) {
            const float inv = exp2f(-(float)i * (13.287712379549449f / 16.f));
            const float ar = frow * inv, ac = fcol * inv;
            const float cr = __cosf(ar), sr = __sinf(ar), cc = __cosf(ac), s2 = __sinf(ac);
            o[i] = x[i] * cr - x[i + 16] * sr; o[i + 16] = x[i + 16] * cr + x[i] * sr;
            o[32 + i] = x[32 + i] * cc - x[48 + i] * s2; o[48 + i] = x[48 + i] * cc + x[32 + i] * s2;
        }
#pragma unroll
        for (int c = 0; c < 8; ++c) { u32x4 v; v.x = pk2(o[8 * c], o[8 * c + 1]); v.y = pk2(o[8 * c + 2], o[8 * c + 3]); v.z = pk2(o[8 * c + 4], o[8 * c + 5]); v.w = pk2(o[8 * c + 6], o[8 * c + 7]);
            *(u32x4*)(ptr + 8 * c) = v; }
    }
}

__device__ __forceinline__ void phase_ssd_chunk_naive(const Params& p, unsigned char* lds) {
    const int tid = tid_opaque();
    bf16_t* xs = (bf16_t*)lds;
    bf16_t* Bs = xs + 128 * 256;
    bf16_t* Cs = Bs + 128 * 64;
    float* dts = (float*)(Cs + 128 * 64);
    float* cum = dts + 2 * 4 * 128;
    float* suf = cum + 4 * 128;
    const bf16_t* XBC = wsp<bf16_t>(p, WS_XBC); const float* DT = wsp<float>(p, WS_DT);
    bf16_t* YD = wsp<bf16_t>(p, WS_YD); bf16_t* CC = wsp<bf16_t>(p, WS_CC); float* ACUM = wsp<float>(p, WS_ACUM); float* ST = wsp<float>(p, WS_ST);
    for (int item = blockIdx.x; item < BATCH * NCHUNK * SSD_G; item += gridDim.x) {
        const int g = item & 1, c = (item >> 1) % NCHUNK, b = item / (2 * NCHUNK);
        const int t0 = b * SEQ + c * CHUNK;
        __syncthreads();
        for (int idx = tid; idx < 128 * 384; idx += 512) {
            const int i = idx / 384, cl = idx % 384;
            const int ch = cl < 256 ? 256 * g + cl : (cl < 320 ? 512 + 64 * g + (cl - 256) : 640 + 64 * g + (cl - 320));
            float acc = p.conv_b[ch];
#pragma unroll
            for (int k = 0; k < DCONV; ++k) { const int pos = c * CHUNK + i + k - 3;
                if (pos >= 0 && pos < SEQ) acc += p.conv_w[k * CONV_CH + ch] * bf2f(XBC[(size_t)(b * SEQ + pos) * CONV_CH + ch]); }
            const bf16_t v = (bf16_t)f2bf(silu_f(acc));
            if (cl < 256) xs[i * 256 + cl] = v; else if (cl < 320) Bs[i * 64 + (cl - 256)] = v; else { Cs[i * 64 + (cl - 320)] = v; CC[(size_t)(t0 + i) * 128 + 64 * g + (cl - 320)] = v; }
        }
        for (int idx = tid; idx < 2 * 4 * 128; idx += 512) { const int dir = idx >> 9, hl = (idx >> 7) & 3, i = idx & 127; dts[idx] = DT[(size_t)(t0 + i) * 16 + dir * 8 + 4 * g + hl]; }
        __syncthreads();
        if (tid < 4) { const int hl = tid; const float a = -__expf(p.a_log[4 * g + hl]); float s = 0.f;
            for (int i = 0; i < 128; ++i) { s += dts[hl * 128 + i] * a; cum[hl * 128 + i] = s; ACUM[(size_t)(t0 + i) * 16 + 4 * g + hl] = s; } }
        else if (tid >= 64 && tid < 68) { const int hl = tid - 64; const float a = -__expf(p.a_log[8 + 4 * g + hl]); float s = 0.f;
            for (int i = 127; i >= 0; --i) { s += dts[512 + hl * 128 + i] * a; suf[hl * 128 + i] = s; ACUM[(size_t)(t0 + i) * 16 + 8 + 4 * g + hl] = s; } }
        __syncthreads();
        {
            const int hl = tid >> 7, i = tid & 127, h = 4 * g + hl;
            float Cr[64], y[64];
#pragma unroll
            for (int n = 0; n < 64; ++n) { Cr[n] = bf2f(Cs[i * 64 + n]); y[n] = 0.f; }
            const float ci = cum[hl * 128 + i], si = suf[hl * 128 + i];
            for (int j = 0; j < 128; ++j) {
                float cb = 0.f;
#pragma unroll
                for (int n = 0; n < 64; ++n) cb += Cr[n] * bf2f(Bs[j * 64 + n]);
                float w = 0.f;
                if (j <= i) w += __expf(ci - cum[hl * 128 + j]) * dts[hl * 128 + j];
                if (j >= i) w += __expf(si - suf[hl * 128 + j]) * dts[512 + hl * 128 + j];
                const float s = cb * w;
#pragma unroll
                for (int q = 0; q < 64; ++q) y[q] += s * bf2f(xs[j * 256 + hl * 64 + q]);
            }
            const float dsk = p.d_skip[h];
#pragma unroll
            for (int q = 0; q < 64; q += 2) { const float y0 = y[q] + dsk * bf2f(xs[i * 256 + hl * 64 + q]), y1 = y[q + 1] + dsk * bf2f(xs[i * 256 + hl * 64 + q + 1]);
                *(unsigned*)(YD + (size_t)(t0 + i) * 512 + h * 64 + q) = pk2(y0, y1); }
        }
        {
            const int combo = tid >> 6, hl = combo & 3, dir = combo >> 2, n = tid & 63, h = 4 * g + hl;
            float acc[64];
#pragma unroll
            for (int q = 0; q < 64; ++q) acc[q] = 0.f;
            const float ref = dir == 0 ? cum[hl * 128 + 127] : suf[hl * 128 + 0];
            for (int j = 0; j < 128; ++j) {
                const float wj = __expf(ref - (dir == 0 ? cum[hl * 128 + j] : suf[hl * 128 + j])) * dts[dir * 512 + hl * 128 + j];
                const float bw = bf2f(Bs[j * 64 + n]) * wj;
#pragma unroll
                for (int q = 0; q < 64; ++q) acc[q] += bf2f(xs[j * 256 + hl * 64 + q]) * bw;
            }
            float* dst = ST + ((((size_t)dir * BATCH + b) * NCHUNK + c) * 8 + h) * 4096;
#pragma unroll
            for (int q = 0; q < 64; ++q) dst[q * 64 + n] = acc[q];
        }
    }
}

__device__ __forceinline__ void phase_scan(const Params& p) {
    bf16_t* ST = wsp<bf16_t>(p, WS_ST); const float* ACUM = wsp<float>(p, WS_ACUM);
    const int tid = tid_opaque();
    if (tid < 256) {
        for (int idx = blockIdx.x * 256 + tid; idx < 2 * BATCH * 8 * 512; idx += gridDim.x * 256) {
            const int e = (idx & 511) * 8, h = (idx >> 9) & 7, b = (idx >> 12) & 7, dir = idx >> 15;
            u32x4* base = (u32x4*)(ST + (((size_t)dir * BATCH + b) * NCHUNK * 8 + h) * 4096 + e);
            u32x4 s[NCHUNK]; float dec[NCHUNK];
#pragma unroll
            for (int k = 0; k < NCHUNK; ++k) { const int ck = dir ? NCHUNK - 1 - k : k; s[k] = base[(size_t)ck * 8 * 512]; }
#pragma unroll
            for (int k = 0; k < NCHUNK; ++k) { const int ck = dir ? NCHUNK - 1 - k : k; dec[k] = dir == 0 ? ACUM[(size_t)(b * SEQ + ck * CHUNK + 127) * 16 + h] : ACUM[(size_t)(b * SEQ + ck * CHUNK) * 16 + 8 + h]; }
            float c[8] = {0.f, 0.f, 0.f, 0.f, 0.f, 0.f, 0.f, 0.f};
#pragma unroll
            for (int k = 0; k < NCHUNK; ++k) { const int ck = dir ? NCHUNK - 1 - k : k;
                base[(size_t)ck * 8 * 512] = (u32x4){pk2(c[0], c[1]), pk2(c[2], c[3]), pk2(c[4], c[5]), pk2(c[6], c[7])};
                const float d = __expf(dec[k]); const u32x4 v = s[k];
                c[0] = c[0] * d + bf2f(v.x & 0xffff); c[1] = c[1] * d + bf2f(v.x >> 16); c[2] = c[2] * d + bf2f(v.y & 0xffff); c[3] = c[3] * d + bf2f(v.y >> 16);
                c[4] = c[4] * d + bf2f(v.z & 0xffff); c[5] = c[5] * d + bf2f(v.z >> 16); c[6] = c[6] * d + bf2f(v.w & 0xffff); c[7] = c[7] * d + bf2f(v.w >> 16); }
        }
    }
}

__device__ __forceinline__ void phase_attn_naive(const Params& p) {
    bf16_t* QO = wsp<bf16_t>(p, WS_QO); const bf16_t* Kb = wsp<bf16_t>(p, WS_K); const bf16_t* Vb = wsp<bf16_t>(p, WS_V);
    const int nth = gridDim.x * 512;
    for (int idx = blockIdx.x * 512 + tid_opaque(); idx < BATCH * NQH * SEQ; idx += nth) {
        const int qi = idx % SEQ, h = (idx / SEQ) % NQH, b = idx / (SEQ * NQH), kvh = h / 4;
        bf16_t* qp = QO + (size_t)(b * SEQ + qi) * 512 + h * 64;
        float q[64], o[64];
#pragma unroll
        for (int d = 0; d < 64; ++d) { q[d] = bf2f(qp[d]); o[d] = 0.f; }
        float m = -1e30f, l = 0.f;
        const bf16_t* kp = Kb + (size_t)b * SEQ * 128 + kvh * 64; const bf16_t* vp = Vb + (size_t)b * SEQ * 128 + kvh * 64;
        for (int j = 0; j < SEQ; ++j) {
            float s = 0.f;
#pragma unroll
            for (int c = 0; c < 8; ++c) { const u32x4 v = *(const u32x4*)(kp + (size_t)j * 128 + 8 * c);
                s += q[8 * c] * bf2f(v.x & 0xffff) + q[8 * c + 1] * bf2f(v.x >> 16) + q[8 * c + 2] * bf2f(v.y & 0xffff) + q[8 * c + 3] * bf2f(v.y >> 16)
                   + q[8 * c + 4] * bf2f(v.z & 0xffff) + q[8 * c + 5] * bf2f(v.z >> 16) + q[8 * c + 6] * bf2f(v.w & 0xffff) + q[8 * c + 7] * bf2f(v.w >> 16); }
            if (s > m) { const float f = exp2f(m - s); l *= f;
#pragma unroll
                for (int d = 0; d < 64; ++d) o[d] *= f;
                m = s; }
            const float pr = exp2f(s - m); l += pr;
#pragma unroll
            for (int c = 0; c < 8; ++c) { const u32x4 v = *(const u32x4*)(vp + (size_t)j * 128 + 8 * c);
                o[8 * c] += pr * bf2f(v.x & 0xffff); o[8 * c + 1] += pr * bf2f(v.x >> 16); o[8 * c + 2] += pr * bf2f(v.y & 0xffff); o[8 * c + 3] += pr * bf2f(v.y >> 16);
                o[8 * c + 4] += pr * bf2f(v.z & 0xffff); o[8 * c + 5] += pr * bf2f(v.z >> 16); o[8 * c + 6] += pr * bf2f(v.w & 0xffff); o[8 * c + 7] += pr * bf2f(v.w >> 16); }
        }
        const float il = 1.f / l;
#pragma unroll
        for (int d = 0; d < 64; d += 2) *(unsigned*)(qp + d) = pk2(o[d] * il, o[d + 1] * il);
    }
}

__device__ __forceinline__ void phase_ssd_final_naive(const Params& p, unsigned char* lds) {
    const int tid = tid_opaque();
    float* cs = (float*)lds;
    float* ssum = cs + 8 * 4096;
    const bf16_t* YD = wsp<bf16_t>(p, WS_YD); const bf16_t* CC = wsp<bf16_t>(p, WS_CC); const float* ACUM = wsp<float>(p, WS_ACUM); const float* ST = wsp<float>(p, WS_ST);
    const bf16_t* Z = wsp<bf16_t>(p, WS_Z); bf16_t* SSD = wsp<bf16_t>(p, WS_SSD);
    for (int item = blockIdx.x; item < BATCH * NCHUNK; item += gridDim.x) {
        const int c = item % NCHUNK, b = item / NCHUNK, t0 = b * SEQ + c * CHUNK;
        const int i = tid & 127, hq = tid >> 7, t = t0 + i;
        float ss = 0.f;
        for (int s = 0; s < 2; ++s) {
            __syncthreads();
            for (int idx = tid; idx < 8 * 4096; idx += 512) { const int mtx = idx >> 12, e = idx & 4095, hh = 2 * (mtx >> 1) + s, dir = mtx & 1;
                cs[idx] = ST[((((size_t)dir * BATCH + b) * NCHUNK + c) * 8 + hh) * 4096 + e]; }
            __syncthreads();
            const int h = 2 * hq + s, g = h >> 2;
            float Cr[64];
#pragma unroll
            for (int n = 0; n < 64; ++n) Cr[n] = bf2f(CC[(size_t)t * 128 + 64 * g + n]);
            const float ef = __expf(ACUM[(size_t)t * 16 + h]), eb = __expf(ACUM[(size_t)t * 16 + 8 + h]);
            const float* cf = cs + (hq * 2 + 0) * 4096; const float* cbk = cs + (hq * 2 + 1) * 4096;
#pragma unroll 2
            for (int q = 0; q < 64; ++q) {
                float af = 0.f, ab = 0.f;
#pragma unroll
                for (int n = 0; n < 64; ++n) { af += Cr[n] * cf[q * 64 + n]; ab += Cr[n] * cbk[q * 64 + n]; }
                const float y = bf2f(YD[(size_t)t * 512 + h * 64 + q]) + af * ef + ab * eb;
                const float v = y * bf2f(Z[(size_t)t * 512 + h * 64 + q]);
                SSD[(size_t)t * 512 + h * 64 + q] = (bf16_t)f2bf(v); ss += v * v;
            }
        }
        ssum[hq * 128 + i] = ss;
        __syncthreads();
        const float tot = ssum[i] + ssum[128 + i] + ssum[256 + i] + ssum[384 + i];
        const float rstd = 1.f / sqrtf(tot * (1.f / 512.f) + EPS);
        for (int q = 0; q < 128; q += 2) { const int col = 2 * hq * 64 + q;
            const unsigned u = *(const unsigned*)(SSD + (size_t)t * 512 + col);
            *(unsigned*)(SSD + (size_t)t * 512 + col) = pk2(bf2f(u & 0xffff) * rstd * p.ssd_norm_w[col], bf2f(u >> 16) * rstd * p.ssd_norm_w[col + 1]); }
    }
}

__device__ __forceinline__ void phase_merged_naive(const Params& p) {
    const bf16_t* AT = wsp<bf16_t>(p, WS_QO); const bf16_t* SS = wsp<bf16_t>(p, WS_SSD); const bf16_t* Wa = wsp<bf16_t>(p, WS_WA); const bf16_t* Wsd = wsp<bf16_t>(p, WS_WS);
    const bf16_t* G = wsp<bf16_t>(p, WS_G); bf16_t* MG = wsp<bf16_t>(p, WS_MERGED);
    const int lane = tid_opaque() & 63, gw = blockIdx.x * 8 + (tid_opaque() >> 6), NGW = gridDim.x * 8, r = lane & 31, h = lane >> 5;
    const int tn = DM / 32, nt = (T / 32) * tn;
    for (int t = gw; t < nt; t += NGW) {
        const int pm = t / tn, pn = t % tn;
        const bf16_t* a1 = AT + (size_t)(pm * 32 + r) * 512 + 8 * h; const bf16_t* a2 = SS + (size_t)(pm * 32 + r) * 512 + 8 * h;
        const bf16_t* b1 = Wa + (size_t)(pn * 32 + r) * 512 + 8 * h; const bf16_t* b2 = Wsd + (size_t)(pn * 32 + r) * 512 + 8 * h;
        f32x16 c1 = {0.f, 0.f, 0.f, 0.f, 0.f, 0.f, 0.f, 0.f, 0.f, 0.f, 0.f, 0.f, 0.f, 0.f, 0.f, 0.f}, c2 = c1;
        for (int k = 0; k < 512; k += 16) {
            c1 = __builtin_amdgcn_mfma_f32_32x32x16_bf16(*(const bf16x8*)(a1 + k), *(const bf16x8*)(b1 + k), c1, 0, 0, 0);
            c2 = __builtin_amdgcn_mfma_f32_32x32x16_bf16(*(const bf16x8*)(a2 + k), *(const bf16x8*)(b2 + k), c2, 0, 0, 0); }
#pragma unroll
        for (int i = 0; i < 16; ++i) { const int row = pm * 32 + (i & 3) + 8 * (i >> 2) + 4 * h, col = pn * 32 + r;
            const float ga = bf2f(G[(size_t)row * 2048 + col]), gs = bf2f(G[(size_t)row * 2048 + 1024 + col]);
            MG[(size_t)row * DM + col] = (bf16_t)f2bf(ga * c1[i] + gs * c2[i]); }
    }
}
__device__ __forceinline__ void phase_wout_naive(const Params& p) {
    const bf16_t* MG = wsp<bf16_t>(p, WS_MERGED); const bf16_t* Wo = wsp<bf16_t>(p, WS_WO); const float* x = p.x; float* out = p.out;
    auto af = [=](int row) { return MG + (size_t)row * DM; };
    auto bf = [=](int, int col) { return Wo + (size_t)col * DM; };
    auto epi = [=](int row, int col, float v) { out[(size_t)row * DM + col] = x[(size_t)row * DM + col] + v; };
    gemm_naive(T, DM, DM, af, bf, epi);
}

__device__ __forceinline__ void phase_route(const Params& p, unsigned char* lds) {
    const int tid = tid_opaque(), lane = tid & 63, wave = tid >> 6;
    float* lg = (float*)lds;
    int* bk_l = (int*)(lds + 128 * 32 * 4);
    const bf16_t* WRT = (const bf16_t*)(p.ws + WS_ROUTE + RT_WRT);
    int* tb = (int*)(p.ws + WS_ROUTE + RT_BUCKET); int* trk = (int*)(p.ws + WS_ROUTE + RT_RANK); float* twa = (float*)(p.ws + WS_ROUTE + RT_WA); float* twb = (float*)(p.ws + WS_ROUTE + RT_WB);
    int* cnt = (int*)(p.ws + WS_ROUTE + RT_CNT); float* RSTD = (float*)(p.ws + WS_ROUTE + RT_RSTD);
    float* rs_l = (float*)(lds + 128 * 32 * 4 + 512);
    const bf16_t* X1 = wsp<bf16_t>(p, WS_X1B);
    for (int tile = blockIdx.x; tile < NRT; tile += gridDim.x) {
        __syncthreads();
        { const int r0 = wave * 16;
            u32x4 v[16][2];
#pragma unroll
            for (int r = 0; r < 16; ++r) { const u32x4* xr = (const u32x4*)(X1 + (size_t)(tile * 128 + r0 + r) * DM) + lane; v[r][0] = xr[0]; v[r][1] = xr[64]; }
            __builtin_amdgcn_sched_barrier(0);
#pragma unroll
            for (int r = 0; r < 16; ++r) { float s = 0.f;
#pragma unroll
                for (int hf = 0; hf < 2; ++hf) { const float f0 = gm2::bflo(v[r][hf].x), f1 = gm2::bfhi(v[r][hf].x), f2 = gm2::bflo(v[r][hf].y), f3 = gm2::bfhi(v[r][hf].y),
                                                             f4 = gm2::bflo(v[r][hf].z), f5 = gm2::bfhi(v[r][hf].z), f6 = gm2::bflo(v[r][hf].w), f7 = gm2::bfhi(v[r][hf].w);
                    s += (f0 * f0 + f1 * f1) + (f2 * f2 + f3 * f3) + (f4 * f4 + f5 * f5) + (f6 * f6 + f7 * f7); }
                const float rstd = 1.f / sqrtf(wave_sum(s) * (1.f / DM) + EPS);
                if (lane == 0) { RSTD[tile * 128 + r0 + r] = rstd; rs_l[r0 + r] = rstd; } }
        }
        __syncthreads();
        {
            const int rt = wave & 3, kh = wave >> 2, r = lane & 31, hh = lane >> 5;
            const bf16_t* a = X1 + (size_t)(tile * 128 + rt * 32 + r) * DM + kh * 512 + 8 * hh; const bf16_t* b = WRT + (size_t)r * DM + kh * 512 + 8 * hh;
            f32x16 acc = {0.f, 0.f, 0.f, 0.f, 0.f, 0.f, 0.f, 0.f, 0.f, 0.f, 0.f, 0.f, 0.f, 0.f, 0.f, 0.f};
#pragma unroll 1
            for (int k0 = 0; k0 < 512; k0 += 256) {
                bf16x8 av[16], bv[16];
#pragma unroll
                for (int u = 0; u < 16; ++u) { av[u] = *(const bf16x8*)(a + k0 + 16 * u); bv[u] = *(const bf16x8*)(b + k0 + 16 * u); }
                __builtin_amdgcn_sched_barrier(0);
#pragma unroll
                for (int u = 0; u < 16; ++u) acc = __builtin_amdgcn_mfma_f32_32x32x16_bf16(av[u], bv[u], acc, 0, 0, 0);
                __builtin_amdgcn_sched_barrier(0);
            }
            if (kh == 1) {
#pragma unroll
                for (int i = 0; i < 16; ++i) lg[(rt * 32 + (i & 3) + 8 * (i >> 2) + 4 * hh) * 32 + r] = acc[i];
            }
            __syncthreads();
            if (kh == 0) {
#pragma unroll
                for (int i = 0; i < 16; ++i) lg[(rt * 32 + (i & 3) + 8 * (i >> 2) + 4 * hh) * 32 + r] += acc[i];
            }
        }
        __syncthreads();
        if (tid < 128) {
            const int m = tile * 128 + tid; const float* L = lg + tid * 32; const float rs = rs_l[tid];
            float gl[4]; float gm = -1e30f;
#pragma unroll
            for (int g = 0; g < 4; ++g) { gl[g] = L[g] * rs + p.b_rg[g]; gm = fmaxf(gm, gl[g]); }
            float gs = 0.f; int gi = 0; float gbest = -1e30f;
#pragma unroll
            for (int g = 0; g < 4; ++g) { const float e = __expf(gl[g] - gm); gs += e; if (gl[g] > gbest) { gbest = gl[g]; gi = g; } }
            const float gval = __expf(gbest - gm) / gs;
            float fl[4]; float fm = -1e30f;
#pragma unroll
            for (int e = 0; e < 4; ++e) { fl[e] = L[4 + 4 * gi + e] * rs + p.b_re[4 * gi + e]; fm = fmaxf(fm, fl[e]); }
            int i0 = 0; float b0 = -1e30f;
#pragma unroll
            for (int e = 0; e < 4; ++e) if (fl[e] > b0) { b0 = fl[e]; i0 = e; }
            int i1 = 0; float b1 = -1e30f;
#pragma unroll
            for (int e = 0; e < 4; ++e) if (e != i0 && fl[e] > b1) { b1 = fl[e]; i1 = e; }
            const float e0 = __expf(b0 - fm), e1 = __expf(b1 - fm); const float w0 = e0 / (e0 + e1) * gval, w1 = e1 / (e0 + e1) * gval;
            const int a = min(i0, i1), bb = max(i0, i1); const float wa = (i0 < i1) ? w0 : w1, wb = (i0 < i1) ? w1 : w0;
            const int pidx = a == 0 ? bb - 1 : (a == 1 ? bb + 1 : 5);
            const int bucket = gi * 6 + pidx;
            tb[m] = bucket; twa[m] = wa; twb[m] = wb; bk_l[tid] = bucket;
        }
        __syncthreads();
        if (tid < 128) { const int mine = bk_l[tid]; int rk = 0; for (int j = 0; j < tid; ++j) rk += (bk_l[j] == mine) ? 1 : 0; trk[tile * 128 + tid] = rk; }
        else if (tid < 128 + NBUCKET) { const int k = tid - 128; int n = 0; for (int j = 0; j < 128; ++j) n += (bk_l[j] == k) ? 1 : 0; cnt[tile * NBUCKET + k] = n; }
    }
}

__device__ __forceinline__ void phase_gather(const Params& p, unsigned char* lds) {
    const int tid = tid_opaque(), lane = tid & 63, wave = tid >> 6;
    int* cl = (int*)lds;
    int* start = cl + NRT * NBUCKET;
    int* tot = start + 32;
    int* mybase = tot + 32;
    const int* cnt = (const int*)(p.ws + WS_ROUTE + RT_CNT); const int* tb = (const int*)(p.ws + WS_ROUTE + RT_BUCKET); const int* trk = (const int*)(p.ws + WS_ROUTE + RT_RANK);
    int* perm = (int*)(p.ws + WS_ROUTE + RT_PERM); int* tbk = (int*)(p.ws + WS_ROUTE + RT_TB);
    float* swa = (float*)(p.ws + WS_ROUTE + RT_SWA); float* swb = (float*)(p.ws + WS_ROUTE + RT_SWB);
    const float* twa = (const float*)(p.ws + WS_ROUTE + RT_WA); const float* twb = (const float*)(p.ws + WS_ROUTE + RT_WB);
    const float* RSTD = (const float*)(p.ws + WS_ROUTE + RT_RSTD); float* srs = (float*)(p.ws + WS_ROUTE + RT_SRS);
    const bf16_t* H2 = wsp<bf16_t>(p, WS_H); bf16_t* XS = wsp<bf16_t>(p, WS_XS);
    for (int i = tid; i < NRT * NBUCKET; i += 512) cl[i] = cnt[i];
    __syncthreads();
    for (int k = wave; k < NBUCKET; k += 8) { int s = 0;
#pragma unroll
        for (int q = 0; q < NRT / 64; ++q) s += cl[(lane + 64 * q) * NBUCKET + k];
#pragma unroll
        for (int o = 1; o < 64; o <<= 1) s += __shfl_xor(s, o);
        if (lane == 0) tot[k] = s; }
    __syncthreads();
    if (tid == 0) { int s = 0; for (int k = 0; k < NBUCKET; ++k) { start[k] = s; s += (tot[k] + 255) & ~255; } start[NBUCKET] = s; }
    __syncthreads();
    if (blockIdx.x == 0) {
        for (int k = 0; k < NBUCKET; ++k) { const int lo = start[k] + tot[k], hi = start[k + 1]; for (int r = lo + tid; r < hi; r += 512) { perm[r] = -1; swa[r] = 0.f; swb[r] = 0.f; srs[r] = 0.f; } }
        const int ntile = start[NBUCKET] / 256;
        for (int t = tid; t < TS / 256; t += 512) { int bk = -1; if (t < ntile) { for (int k = 0; k < NBUCKET; ++k) if (t * 256 >= start[k] && t * 256 < start[k + 1]) bk = k; } tbk[t] = bk; }
        if (tid == 0) tbk[TS / 256] = ntile;
    }
    for (int tile = blockIdx.x; tile < NRT; tile += gridDim.x) {
        __syncthreads();
        for (int k = wave; k < NBUCKET; k += 8) { int s = 0;
#pragma unroll
            for (int q = 0; q < NRT / 64; ++q) { const int t = lane + 64 * q; s += (t < tile) ? cl[t * NBUCKET + k] : 0; }
#pragma unroll
            for (int o = 1; o < 64; o <<= 1) s += __shfl_xor(s, o);
            if (lane == 0) mybase[k] = start[k] + s; }
        __syncthreads();
#if USE_PG8 && FUSE_GATHER
        if (lane < 16) {
            const int m = tile * 128 + wave * 16 + lane;
            const int bkt = tb[m], rk = trk[m]; const float wa = twa[m], wb = twb[m], rs = RSTD[m];
            const int d = mybase[bkt] + rk;
            perm[d] = m; swa[d] = wa; swb[d] = wb; srs[d] = rs;
        }
#else
        {
            int dest[16];
#pragma unroll
            for (int q = 0; q < 16; ++q) { const int m = tile * 128 + wave * 16 + q; dest[q] = mybase[tb[m]] + trk[m]; }
#pragma unroll
            for (int q = 0; q < 16; ++q) { const int m = tile * 128 + wave * 16 + q; if (lane == 0) { perm[dest[q]] = m; swa[dest[q]] = twa[m]; swb[dest[q]] = twb[m]; } }
#if !(USE_PG8 && FUSE_GATHER)
#pragma unroll
            for (int q0 = 0; q0 < 16; q0 += 8) {
                u32x4 v0[8], v1[8];
#pragma unroll
                for (int q = 0; q < 8; ++q) { const u32x4* src = (const u32x4*)(H2 + (size_t)(tile * 128 + wave * 16 + q0 + q) * DM); v0[q] = src[lane]; v1[q] = src[64 + lane]; }
#pragma unroll
                for (int q = 0; q < 8; ++q) { u32x4* dst = (u32x4*)(XS + (size_t)dest[q0 + q] * DM); dst[lane] = v0[q]; dst[64 + lane] = v1[q]; }
            }
#endif
        }
#endif
    }
}

__device__ __forceinline__ void phase_moe1_naive(const Params& p) {
    const bf16_t* XS = wsp<bf16_t>(p, WS_XS); const bf16_t* W13 = wsp<bf16_t>(p, WS_W13); bf16_t* HID = wsp<bf16_t>(p, WS_HID);
    const int* perm = (const int*)(p.ws + WS_ROUTE + RT_PERM); const int* tbk = (const int*)(p.ws + WS_ROUTE + RT_TB);
    const float* twa = (const float*)(p.ws + WS_ROUTE + RT_WA); const float* twb = (const float*)(p.ws + WS_ROUTE + RT_WB);
    const int lane = tid_opaque() & 63, gw = blockIdx.x * 8 + (tid_opaque() >> 6), NGW = gridDim.x * 8, r = lane & 31, h = lane >> 5;
    const int nrows = tbk[TS / 256] * 256, tn = 1024 / 32, nt = (nrows / 32) * tn;
    for (int t = gw; t < nt; t += NGW) {
        const int pm = t / tn, pn = t % tn, bucket = tbk[pm / 8], g = bucket / 6; int a, b; pair_of(bucket % 6, a, b);
        const int slot = pn >> 4, e = g * 4 + (slot ? b : a), j0 = (pn & 15) * 32;
        const bf16_t* ap = XS + (size_t)(pm * 32 + r) * DM + 8 * h;
        const bf16_t* b1 = W13 + ((size_t)e * 1024 + 2 * (j0 + r)) * DM + 8 * h; const bf16_t* b3 = b1 + DM;
        f32x16 c1 = {0.f, 0.f, 0.f, 0.f, 0.f, 0.f, 0.f, 0.f, 0.f, 0.f, 0.f, 0.f, 0.f, 0.f, 0.f, 0.f}, c3 = c1;
        for (int k = 0; k < DM; k += 16) { const bf16x8 av = *(const bf16x8*)(ap + k);
            c1 = __builtin_amdgcn_mfma_f32_32x32x16_bf16(av, *(const bf16x8*)(b1 + k), c1, 0, 0, 0);
            c3 = __builtin_amdgcn_mfma_f32_32x32x16_bf16(av, *(const bf16x8*)(b3 + k), c3, 0, 0, 0); }
#pragma unroll
        for (int i = 0; i < 16; ++i) { const int row = pm * 32 + (i & 3) + 8 * (i >> 2) + 4 * h; const int tok = perm[row];
            const float w = tok < 0 ? 0.f : (slot ? twb[tok] : twa[tok]);
            HID[(size_t)row * 1024 + slot * 512 + j0 + r] = (bf16_t)f2bf(w * silu_f(c1[i]) * c3[i]); }
    }
}
__device__ __forceinline__ void phase_moe2_naive(const Params& p) {
    const bf16_t* HID = wsp<bf16_t>(p, WS_HID); const bf16_t* W2P = wsp<bf16_t>(p, WS_W2P); float* out = p.out;
    const int* perm = (const int*)(p.ws + WS_ROUTE + RT_PERM); const int* tbk = (const int*)(p.ws + WS_ROUTE + RT_TB);
    const int nrows = tbk[TS / 256] * 256;
    auto af = [=](int row) { return HID + (size_t)row * 1024; };
    auto bf = [=](int row0, int col) { return W2P + ((size_t)tbk[row0 / 256] * 1024 + col) * 1024; };
    auto epi = [=](int row, int col, float v) { const int tok = perm[row]; if (tok >= 0) out[(size_t)tok * DM + col] += v; };
    gemm_naive(nrows, DM, 1024, af, bf, epi);
}


#include <hip/hip_bf16.h>
namespace attn_body {
using bf16=__hip_bfloat16;
using bf16x8=__attribute__((ext_vector_type(8)))short;
using s16x4=__attribute__((ext_vector_type(4)))short;
using f32x16=__attribute__((ext_vector_type(16)))float;
using u32x4=__attribute__((ext_vector_type(4)))unsigned;
constexpr int BATCH=8,NHEAD=8,SEQ=4096,D=64,QP=512,KP=128;
constexpr int NW=8,QBLK=32,QB=QBLK*NW,KVBLK=64,NQB=SEQ/QB;
constexpr int ATTN_UNIT_ROWS=QB;
__device__ __forceinline__ int crow(int r,int hi){return (r&3)+8*(r>>2)+4*hi;}
#define SBAR() __builtin_amdgcn_sched_barrier(0)
__device__ __forceinline__ void cmask(f32x16&p0,f32x16&p1,int jb,int qrel,int hi){
  const float NEG=-INFINITY; int kb=64*jb+4*hi;
  #pragma unroll
  for(int r=0;r<16;++r){int kv=kb+(r&3)+8*(r>>2); if(kv>qrel)p0[r]=NEG; if(kv+32>qrel)p1[r]=NEG;}
}

constexpr int NSLOT=3, SLOTB=8192;
constexpr int LDS_K=0, LDS_V=NSLOT*SLOTB, LDS_WS=2*NSLOT*SLOTB, LDS_OST=LDS_WS+NW*64*4, LDS_BYTES=LDS_OST+NW*4096;
constexpr float C2=0.125f*1.4426950408889634f;
__device__ __forceinline__ void glds16(const void*gsrc,unsigned lds_dst){unsigned keep;
  asm volatile("s_mov_b32 %0, m0\n\ts_mov_b32 m0, %2\n\ts_nop 0\n\tglobal_load_lds_dwordx4 %1, off\n\ts_mov_b32 m0, %0":"=&s"(keep):"v"(gsrc),"s"(lds_dst):"memory");}
__device__ __forceinline__ float max3f(float a,float b,float c){float r;asm("v_max3_f32 %0, %1, %2, %3":"=v"(r):"v"(a),"v"(b),"v"(c));return r;}
__device__ __forceinline__ float max2f(float a,float b){float r;asm("v_max_f32_e32 %0, %1, %2":"=v"(r):"v"(a),"v"(b));return r;}
__device__ __forceinline__ float fadd_s(float a,float b){float r;asm("v_add_f32_e32 %0, %1, %2":"=v"(r):"v"(a),"v"(b));return r;}
__device__ __forceinline__ float fsub_s(float a,float b){float r;asm("v_sub_f32_e32 %0, %1, %2":"=v"(r):"v"(a),"v"(b));return r;}
typedef float f32x2_t __attribute__((ext_vector_type(2))); typedef __bf16 bf16x2_t __attribute__((ext_vector_type(2)));
__device__ __forceinline__ unsigned cvtpk_s(float lo,float hi){f32x2_t v={lo,hi};bf16x2_t b=__builtin_convertvector(v,bf16x2_t);return __builtin_bit_cast(unsigned,b);}
#define WAIT_BAR(N) asm volatile("s_waitcnt vmcnt(" #N ") lgkmcnt(0)\n\ts_barrier":::"memory")

__device__ __forceinline__ void qkt(f32x16&p0,f32x16&p1,const char*Kslot,const bf16x8*qr,const f32x16&negm,int r32,int hi){
  const char*kb=Kslot+hi*1024+r32*16;
  #pragma unroll
  for(int d0=0;d0<4;++d0){
    const bf16x8 b0=*reinterpret_cast<const bf16x8*>(kb+d0*2048);
    const bf16x8 b1=*reinterpret_cast<const bf16x8*>(kb+d0*2048+512);
    if(d0==0){p0=__builtin_amdgcn_mfma_f32_32x32x16_bf16(b0,qr[0],negm,0,0,0);p1=__builtin_amdgcn_mfma_f32_32x32x16_bf16(b1,qr[0],negm,0,0,0);}
    else{p0=__builtin_amdgcn_mfma_f32_32x32x16_bf16(b0,qr[d0],p0,0,0,0);p1=__builtin_amdgcn_mfma_f32_32x32x16_bf16(b1,qr[d0],p1,0,0,0);}}
}
typedef __attribute__((address_space(3))) const char* lds_cptr;
typedef short v4i16_t __attribute__((ext_vector_type(4)));
__device__ __forceinline__ void kload8(bf16x8*kf,lds_cptr kp){
  kf[0]=*(const __attribute__((address_space(3))) bf16x8*)(kp);      kf[1]=*(const __attribute__((address_space(3))) bf16x8*)(kp+512);
  kf[2]=*(const __attribute__((address_space(3))) bf16x8*)(kp+2048); kf[3]=*(const __attribute__((address_space(3))) bf16x8*)(kp+2560);
  kf[4]=*(const __attribute__((address_space(3))) bf16x8*)(kp+4096); kf[5]=*(const __attribute__((address_space(3))) bf16x8*)(kp+4608);
  kf[6]=*(const __attribute__((address_space(3))) bf16x8*)(kp+6144); kf[7]=*(const __attribute__((address_space(3))) bf16x8*)(kp+6656);
}
__device__ __forceinline__ void kload2(bf16x8*kf,lds_cptr kp,int j){ kf[2*j]=*(const __attribute__((address_space(3))) bf16x8*)(kp+j*2048); kf[2*j+1]=*(const __attribute__((address_space(3))) bf16x8*)(kp+j*2048+512); }
__device__ __forceinline__ s16x4 vtr(lds_cptr p){ return __builtin_bit_cast(s16x4,__builtin_amdgcn_ds_read_tr16_b64_v4i16((__attribute__((address_space(3))) v4i16_t*)p)); }
__device__ __forceinline__ float rowmax(const f32x16&p0,const f32x16&p1){
  float a=max3f(p0[0],p0[1],p1[0]),b=max3f(p0[2],p0[3],p1[1]);a=max3f(a,p1[2],p1[3]);
  #pragma unroll
  for(int r=4;r<16;r+=4){a=max3f(a,p0[r],p0[r+1]);b=max3f(b,p0[r+2],p0[r+3]);a=max3f(a,p1[r],p1[r+1]);b=max3f(b,p1[r+2],p1[r+3]);}
  const float m=max2f(a,b);
  auto rr=__builtin_amdgcn_permlane32_swap(__float_as_uint(m),__float_as_uint(m),false,false);
  return max2f(__uint_as_float(rr[0]),__uint_as_float(rr[1]));
}
__device__ __forceinline__ void pv(f32x16*o,int vb,bf16x8 pa0,bf16x8 pa1,bf16x8 pa2,bf16x8 pa3){
  #pragma unroll
  for(int d0=0;d0<2;++d0){s16x4 lo[4],hi[4];
    #pragma unroll
    for(int ks=0;ks<4;++ks){
      asm volatile("ds_read_b64_tr_b16 %0,%1 offset:%c2":"=&v"(lo[ks]):"v"(vb),"i"(d0*4096+ks*1024):"memory");
      asm volatile("ds_read_b64_tr_b16 %0,%1 offset:%c2":"=&v"(hi[ks]):"v"(vb),"i"(d0*4096+ks*1024+512):"memory");}
    asm volatile("s_waitcnt lgkmcnt(0)":::"memory");SBAR();
    #define PK(k) (bf16x8){lo[k][0],lo[k][1],lo[k][2],lo[k][3],hi[k][0],hi[k][1],hi[k][2],hi[k][3]}
    o[d0]=__builtin_amdgcn_mfma_f32_32x32x16_bf16(pa0,PK(0),o[d0],0,0,0);
    o[d0]=__builtin_amdgcn_mfma_f32_32x32x16_bf16(pa1,PK(1),o[d0],0,0,0);
    o[d0]=__builtin_amdgcn_mfma_f32_32x32x16_bf16(pa2,PK(2),o[d0],0,0,0);
    o[d0]=__builtin_amdgcn_mfma_f32_32x32x16_bf16(pa3,PK(3),o[d0],0,0,0);
    #undef PK
  }
}

#ifndef ATTN_STORE16
#define ATTN_STORE16(p,v) (*(u32x4*)(p)=(v))
#endif
template<int THRL> __device__ __forceinline__ void attn_unit(int b,int h,int qb,const bf16*Q,const bf16*__restrict__ K,const bf16*__restrict__ V,bf16*O,char*shm,const float*qnw){
  const int tid=threadIdx.x,lane=tid&63,r32=lane&31,hi=lane>>5; const int wid=__builtin_amdgcn_readfirstlane(tid>>6);
  const long rowbase=(long)b*SEQ; const int q0=qb*QB;
  const bf16*Qw=Q+(rowbase+q0+wid*QBLK)*QP+h*D;
  const bf16*Kh=K+rowbase*KP+(h>>2)*D,*Vh=V+rowbase*KP+(h>>2)*D;
  const unsigned lds0=(unsigned)(uintptr_t)shm;
  float*wsf=(float*)(shm+LDS_WS)+wid*64;
  const bf16*ksrc=Kh+(long)lane*KP+wid*8;
  const bf16*vsrc=Vh+(long)(16*(wid&3)+(lane>>2))*KP+(wid>>2)*32+(lane&3)*8;
  const unsigned kdst=lds0+LDS_K+wid*1024, vdst=lds0+LDS_V+wid*1024;
  #define DMA_K(t,slot) glds16(ksrc+(long)(t)*KVBLK*KP,(unsigned)__builtin_amdgcn_readfirstlane(kdst+(slot)))
  #define DMA_V(t,slot) glds16(vsrc+(long)(t)*KVBLK*KP,(unsigned)__builtin_amdgcn_readfirstlane(vdst+(slot)))
  const int vb0=(int)(lds0+LDS_V)+((lane>>4)&1)*32+(lane&3)*8+(4*hi+((lane&15)>>2))*64;
  const char*Kbase=shm+LDS_K; bf16x8 kf[8];
  const lds_cptr shm3=(lds_cptr)shm; const lds_cptr kp0=shm3+LDS_K+hi*1024+r32*16; const lds_cptr vp0=shm3+LDS_V+((lane>>4)&1)*32+(lane&3)*8+(4*hi+((lane&15)>>2))*64;
  const int NT=SEQ/KVBLK;
  DMA_K(0,0);DMA_V(0,0);DMA_K(1,SLOTB);
  bf16x8 qr[4];
  #pragma unroll
  for(int d0=0;d0<4;++d0)qr[d0]=*reinterpret_cast<const bf16x8*>(&Qw[(long)r32*QP+d0*16+hi*8]);
  {
    float qf[4][8];
    #pragma unroll
    for(int d0=0;d0<4;++d0){
      #pragma unroll
      for(int j=0;j<8;++j)qf[d0][j]=__uint_as_float(((unsigned)(unsigned short)qr[d0][j])<<16);}
    float ss=0.f;
    #pragma unroll
    for(int d0=0;d0<4;++d0){
      #pragma unroll
      for(int j=0;j<8;++j)ss+=qf[d0][j]*qf[d0][j];}
    {auto rr=__builtin_amdgcn_permlane32_swap(__float_as_uint(ss),__float_as_uint(ss),false,false);ss=__uint_as_float(rr[0])+__uint_as_float(rr[1]);}
    const float rstd=1.0f/sqrtf(ss*(1.0f/64.0f)+1e-6f);
    #pragma unroll
    for(int d0=0;d0<4;++d0){
      #pragma unroll
      for(int j=0;j<8;++j)qf[d0][j]*=rstd*qnw[d0*16+hi*8+j];}
    const int pos=q0+wid*QBLK+r32; const float frow=(float)(pos>>6),fcol=(float)(pos&63);
    #pragma unroll
    for(int j=0;j<8;++j){
      const float inv=exp2f(-(float)(hi*8+j)*(13.287712379549449f/16.f));
      const float ar=frow*inv,ac=fcol*inv; const float cr=__cosf(ar),sr=__sinf(ar),cc=__cosf(ac),sc=__sinf(ac);
      const float a0=qf[0][j],a1=qf[1][j],a2=qf[2][j],a3=qf[3][j];
      qf[0][j]=(a0*cr-a1*sr)*C2; qf[1][j]=(a1*cr+a0*sr)*C2; qf[2][j]=(a2*cc-a3*sc)*C2; qf[3][j]=(a3*cc+a2*sc)*C2;}
    #pragma unroll
    for(int d0=0;d0<4;++d0){ u32x4 w={cvtpk_s(qf[d0][0],qf[d0][1]),cvtpk_s(qf[d0][2],qf[d0][3]),cvtpk_s(qf[d0][4],qf[d0][5]),cvtpk_s(qf[d0][6],qf[d0][7])}; qr[d0]=__builtin_bit_cast(bf16x8,w);}
  }
  float mhat=0.f,l_reg=0.f;f32x16 o[2];o[0]=f32x16{};o[1]=f32x16{};f32x16 negm=f32x16{};asm volatile("":"+v"(negm));
  const int qrel=wid*QBLK+r32;
  #define CMASK(P0,P1,t) do{}while(0)
  bool resc=false;
  #define START(P0,P1) do{ const float rm=rowmax(P0,P1); resc=false; \
    { const float dl=rm; mhat=fadd_s(mhat,dl); \
      _Pragma("unroll") for(int r=0;r<16;++r){P0[r]=fsub_s(P0[r],dl);P1[r]=fsub_s(P1[r],dl);} \
      _Pragma("unroll") for(int r=0;r<16;++r)negm[r]=-mhat; asm volatile("":"+v"(negm)); } \
    _Pragma("unroll") for(int r=0;r<16;++r)P0[r]=__builtin_amdgcn_exp2f(P0[r]); }while(0)
  #define RESC() do{ if(resc){ asm volatile("s_waitcnt lgkmcnt(0)":::"memory"); \
      _Pragma("unroll") for(int d_=0;d_<2;++d_) _Pragma("unroll") for(int r=0;r<16;++r)o[d_][r]*=wsf[crow(r,hi)]; } }while(0)
  f32x16 pA0,pA1,pB0,pB1;
  int sl_prev=0,sl_cur=0,sl_next=SLOTB;
  #define ROT() do{sl_prev=sl_cur;sl_cur=sl_next;sl_next=(sl_next==(NSLOT-1)*SLOTB)?0:sl_next+SLOTB;}while(0)
  DMA_K(2,2*SLOTB);
  WAIT_BAR(3);
  qkt(pA0,pA1,Kbase,qr,negm,r32,hi);asm volatile("s_nop 15\n\ts_nop 7":"+v"(pA0),"+v"(pA1));CMASK(pA0,pA1,0);
  START(pA0,pA1);
  _Pragma("unroll") for(int r=0;r<16;++r)pA1[r]=__builtin_amdgcn_exp2f(pA1[r]);
  WAIT_BAR(0);
  DMA_K(3,0);DMA_V(1,SLOTB);
  ROT();
  kload8(kf,kp0+sl_cur);
  WAIT_BAR(2);
  s16x4 vlo[8],vhi[8]; u32x4 pw0,pw1,pw2,pw3;
  #define PKW(P,B) cvtpk_s(P[B],P[B+1])
  #define PAF(k) __builtin_bit_cast(bf16x8,pw##k)
  #define VFR(i) (bf16x8){vlo[i][0],vlo[i][1],vlo[i][2],vlo[i][3],vhi[i][0],vhi[i][1],vhi[i][2],vhi[i][3]}
  #define PIN(x) asm volatile("":"+v"(x))
  #define MX3(a,b,c) __builtin_fmaxf(__builtin_fmaxf((a),(b)),(c))
  #define GAPA(MF,A0,A1,A2,A3,W0,W1,PW) do{ MF; sacc+=A0; sacc+=A1; sacc+=A2; sacc+=A3; PIN(sacc); W0; W1; PIN(PW); SBAR(); }while(0)
  #define EX(v) __builtin_amdgcn_exp2f(v)
  #define GAPB(MF,X,B) do{ MF; X[B]=EX(X[B]); X[B+1]=EX(X[B+1]); X[B+2]=EX(X[B+2]); X[B+3]=EX(X[B+3]); PIN(X); SBAR(); }while(0)
  #define VRD(i) do{ vlo[i]=vtr(vp_+(((i)>>2)*4096+((i)&3)*1024)); vhi[i]=vtr(vp_+(((i)>>2)*4096+((i)&3)*1024+512)); }while(0)
  #define KRD(G,j) do{ if(G){ kload2(kf,kp0+sl_next,j); SBAR(); } }while(0)
  #define STEP(C0,C1,P0,P1,t,GK,GV,GL) do{ SBAR(); \
    const lds_cptr vp_=vp0+sl_prev; \
    VRD(0); SBAR(); float sacc=(P0[0]+P0[1]); \
    GAPA(C0=__builtin_amdgcn_mfma_f32_32x32x16_bf16(kf[0],qr[0],negm,0,0,0), P0[2],P0[3],P0[4],P0[5],     pw0[0]=PKW(P0,0), pw0[1]=PKW(P0,2), pw0); \
    VRD(4); SBAR(); GAPA(C1=__builtin_amdgcn_mfma_f32_32x32x16_bf16(kf[1],qr[0],negm,0,0,0), P0[6],P0[7],P0[8],P0[9],     pw0[2]=PKW(P0,4), pw0[3]=PKW(P0,6), pw0); \
    VRD(1); SBAR(); GAPA(C0=__builtin_amdgcn_mfma_f32_32x32x16_bf16(kf[2],qr[1],C0,0,0,0),   P0[10],P0[11],P0[12],P0[13], pw1[0]=PKW(P0,8), pw1[1]=PKW(P0,10), pw1); \
    VRD(5); SBAR(); GAPA(C1=__builtin_amdgcn_mfma_f32_32x32x16_bf16(kf[3],qr[1],C1,0,0,0),   P0[14],P0[15],P1[0],P1[1],   pw1[2]=PKW(P0,12),pw1[3]=PKW(P0,14), pw1); \
    VRD(2); SBAR(); GAPA(C0=__builtin_amdgcn_mfma_f32_32x32x16_bf16(kf[4],qr[2],C0,0,0,0),   P1[2],P1[3],P1[4],P1[5],     pw2[0]=PKW(P1,0), pw2[1]=PKW(P1,2), pw2); \
    VRD(6); SBAR(); GAPA(C1=__builtin_amdgcn_mfma_f32_32x32x16_bf16(kf[5],qr[2],C1,0,0,0),   P1[6],P1[7],P1[8],P1[9],     pw2[2]=PKW(P1,4), pw2[3]=PKW(P1,6), pw2); \
    VRD(3); SBAR(); GAPA(C0=__builtin_amdgcn_mfma_f32_32x32x16_bf16(kf[6],qr[3],C0,0,0,0),   P1[10],P1[11],P1[12],P1[13], pw3[0]=PKW(P1,8), pw3[1]=PKW(P1,10), pw3); \
    VRD(7); SBAR(); GAPA(C1=__builtin_amdgcn_mfma_f32_32x32x16_bf16(kf[7],qr[3],C1,0,0,0),   P1[14],P1[15],0.f,0.f,       pw3[2]=PKW(P1,12),pw3[3]=PKW(P1,14), pw3); \
    l_reg+=sacc; \
    if(GK){DMA_K((t)+3,sl_cur);} if(GV){DMA_V((t)+1,sl_next);} \
    CMASK(C0,C1,t); \
    { float a=MX3(C0[0],C0[1],C1[0]),b=MX3(C0[2],C0[3],C1[1]); a=MX3(a,C1[2],C1[3]); \
      _Pragma("unroll") for(int r=4;r<16;r+=4){a=MX3(a,C0[r],C0[r+1]);b=MX3(b,C0[r+2],C0[r+3]);a=MX3(a,C1[r],C1[r+1]);b=MX3(b,C1[r+2],C1[r+3]);} \
      float rm=__builtin_fmaxf(a,b); { auto rr=__builtin_amdgcn_permlane32_swap(__float_as_uint(rm),__float_as_uint(rm),false,false); rm=__builtin_fmaxf(__uint_as_float(rr[0]),__uint_as_float(rr[1])); } \
      resc=false; \
      if(__builtin_expect(__any(rm>(float)THRL),0)){ const float dl=__builtin_fmaxf(rm,0.f); mhat+=dl; \
        _Pragma("unroll") for(int r=0;r<16;++r){C0[r]-=dl;C1[r]-=dl;} \
        _Pragma("unroll") for(int r=0;r<16;++r)negm[r]=-mhat; asm volatile("":"+v"(negm)); \
        const float f=__builtin_amdgcn_exp2f(-dl); l_reg*=f; if(hi==0)wsf[r32]=f; resc=true; } } \
    SBAR(); \
    GAPB(o[0]=__builtin_amdgcn_mfma_f32_32x32x16_bf16(PAF(0),VFR(0),o[0],0,0,0), C0,0); \
    GAPB(o[1]=__builtin_amdgcn_mfma_f32_32x32x16_bf16(PAF(0),VFR(4),o[1],0,0,0), C0,4); \
    KRD(GL,0); GAPB(o[0]=__builtin_amdgcn_mfma_f32_32x32x16_bf16(PAF(1),VFR(1),o[0],0,0,0), C0,8); \
    KRD(GL,1); GAPB(o[1]=__builtin_amdgcn_mfma_f32_32x32x16_bf16(PAF(1),VFR(5),o[1],0,0,0), C0,12); \
    KRD(GL,2); GAPB(o[0]=__builtin_amdgcn_mfma_f32_32x32x16_bf16(PAF(2),VFR(2),o[0],0,0,0), C1,0); \
    KRD(GL,3); GAPB(o[1]=__builtin_amdgcn_mfma_f32_32x32x16_bf16(PAF(2),VFR(6),o[1],0,0,0), C1,4); \
    GAPB(o[0]=__builtin_amdgcn_mfma_f32_32x32x16_bf16(PAF(3),VFR(3),o[0],0,0,0), C1,8); \
    GAPB(o[1]=__builtin_amdgcn_mfma_f32_32x32x16_bf16(PAF(3),VFR(7),o[1],0,0,0), C1,12); \
    }while(0)
  int t=1;
  #undef CMASK
  #define CMASK(P0,P1,t) do{}while(0)
  for(;t+5<NT;t+=2){
    STEP(pB0,pB1,pA0,pA1,t,true,true,true);     WAIT_BAR(2); RESC(); ROT();
    STEP(pA0,pA1,pB0,pB1,t+1,true,true,true);   WAIT_BAR(2); RESC(); ROT();
  }
  #undef CMASK
  #define CMASK(P0,P1,t) do{}while(0)
  #define ENDW(tt) do{ if((tt)+3<NT){WAIT_BAR(2);} else if((tt)+2<NT){WAIT_BAR(1);} else {WAIT_BAR(0);} }while(0)
  for(;t+1<NT;t+=2){
    STEP(pB0,pB1,pA0,pA1,t,(t+3<NT),(t+1<NT),(t+1<NT));       ENDW(t);   RESC(); ROT();
    STEP(pA0,pA1,pB0,pB1,t+1,(t+4<NT),(t+2<NT),(t+2<NT));     ENDW(t+1); RESC(); ROT();
  }
  STEP(pB0,pB1,pA0,pA1,NT-1,false,false,false); RESC();
  { float sacc=pB0[0]+pB0[1]; _Pragma("unroll") for(int r=2;r<16;++r)sacc+=pB0[r]; _Pragma("unroll") for(int r=0;r<16;++r)sacc+=pB1[r]; l_reg+=sacc;
    pw0=(u32x4){PKW(pB0,0),PKW(pB0,2),PKW(pB0,4),PKW(pB0,6)};pw1=(u32x4){PKW(pB0,8),PKW(pB0,10),PKW(pB0,12),PKW(pB0,14)};pw2=(u32x4){PKW(pB1,0),PKW(pB1,2),PKW(pB1,4),PKW(pB1,6)};pw3=(u32x4){PKW(pB1,8),PKW(pB1,10),PKW(pB1,12),PKW(pB1,14)};
    SBAR(); pv(o,vb0+sl_cur,PAF(0),PAF(1),PAF(2),PAF(3)); }
  #undef PKW
  #undef PAF
  #undef VFR
  #undef PIN
  #undef MX3
  #undef GAPA
  #undef GAPB
  #undef EX
  #undef VRD
  #undef KRD
  #undef STEP
  #undef ENDW
  {auto rr=__builtin_amdgcn_permlane32_swap(__float_as_uint(l_reg),__float_as_uint(l_reg),false,false);l_reg=__uint_as_float(rr[0])+__uint_as_float(rr[1]);}
  if(hi==0)wsf[32+r32]=l_reg;asm volatile("s_waitcnt lgkmcnt(0)":::"memory");
  float rli[16];
  #pragma unroll
  for(int r=0;r<16;++r)rli[r]=__builtin_amdgcn_rcpf(wsf[32+crow(r,hi)]);
  bf16*Ow=O+(rowbase+q0+wid*QBLK)*QP+h*D;
  { bf16*stg=(bf16*)(shm+LDS_OST)+wid*2048;
    #pragma unroll
    for(int r=0;r<16;++r){const int orow=crow(r,hi);
      #pragma unroll
      for(int d0=0;d0<2;++d0)stg[orow*64+d0*32+r32]=__float2bfloat16(o[d0][r]*rli[r]);}
    asm volatile("s_waitcnt lgkmcnt(0)":::"memory");
    #pragma unroll
    for(int i=0;i<4;++i){const int row=i*8+(lane>>3),ch=lane&7; const u32x4 v=*(const u32x4*)(stg+row*64+ch*8); ATTN_STORE16(Ow+(long)row*QP+ch*8,v);} }
  asm volatile("s_waitcnt lgkmcnt(0)\n\ts_barrier":::"memory");
  #undef DMA_K
  #undef DMA_V
  #undef CMASK
  #undef START
  #undef RESC
  #undef ROT
}
constexpr int ATTN_LDS_BYTES=LDS_BYTES;
#undef SBAR
#undef WAIT_BAR
}

#ifndef NAIVE_ATTN
#define NAIVE_ATTN 0
#endif
__device__ __forceinline__ void attn_convert(const Params& p, unsigned char* lds) {
    const int tid = tid_opaque(), lane = tid & 63, wave = tid >> 6;
    phase_tr_range(p, (float*)lds + wave * (64 * 33), lane, TR_WIN, TR_W2, (int)blockIdx.x * 8 + wave, (int)gridDim.x * 8);
    __syncthreads();
}
__device__ __forceinline__ void phase_attn(const Params& p, unsigned char* lds) {
    const int G = gridDim.x, bx = blockIdx.x, vcu = (G % 8 == 0) ? (bx % 8) * (G / 8) + bx / 8 : bx;
    attn_body::bf16* QO = (attn_body::bf16*)(p.ws + WS_QO); const attn_body::bf16* Kb = (const attn_body::bf16*)(p.ws + WS_K); const attn_body::bf16* Vb = (const attn_body::bf16*)(p.ws + WS_V);
    constexpr int NU = BATCH * NQH * (SEQ / 256);
    const int nmine = (NU - vcu + G - 1) / G, slot = (vcu & 3) < nmine ? (vcu & 3) : 0;
    int i = 0;
    for (int u = vcu; u < NU; u += G, ++i) {
        if (i == slot) { attn_convert(p, lds); }
        const int bk = u >> 6, x = u & 63, b = bk >> 1, h = (bk & 1) * 4 + (x >> 4), qb = x & 15;
        attn_body::attn_unit<8>(b, h, qb, QO, Kb, Vb, QO, (char*)lds, p.q_norm_w);
    }
}

#ifndef RELAX_P1
#define RELAX_P1 true
#endif
#ifndef RELAX_WOUT
#define RELAX_WOUT true
#endif
#ifndef RELAX_MERGED
#define RELAX_MERGED true
#endif
#ifndef RELAX_MOE1
#define RELAX_MOE1 true
#endif
#ifndef RELAX_MOE2
#define RELAX_MOE2 false
#endif
#ifndef PG8_ASM_DMA
#define PG8_ASM_DMA 1
#endif
__device__ __forceinline__ void pg8_dma16(const void* sbase, unsigned voff, unsigned ldsaddr) { unsigned keep;
    asm volatile("s_mov_b32 %0, m0\n\ts_mov_b32 m0, %3\n\ts_nop 0\n\tglobal_load_lds_dwordx4 %1, %2\n\ts_mov_b32 m0, %0" : "=&s"(keep) : "v"(voff), "s"(sbase), "s"(ldsaddr) : "memory"); }
namespace pg8 {
constexpr int BM = 256, BK = 64, HALF = 128, HTB = HALF * BK * 2  , STAGE_BYTES = 8 * HTB, NXCD = 8, WGM = 8;
__host__ __device__ __forceinline__ int lds_byte(int r, int c) { const int st = (r >> 4) * 2 + (c >> 5), rr = r & 15, cc = c & 31, ob = rr * 64 + cc * 2; return st * 1024 + (ob ^ (((ob >> 9) & 1) << 5)); }
__host__ __device__ __forceinline__ void stage_rc(int b, int& R, int& C) { const int st = b / 1024, sb = b % 1024, swz = sb ^ (((sb >> 9) & 1) << 5); R = (st >> 1) * 16 + swz / 64; C = (st & 1) * 32 + (swz % 64) / 2; }
__host__ __device__ __forceinline__ int perm32(int rho) { const int n = rho >> 4, i = rho & 15; return 8 * (i >> 2) + 4 * n + (i & 3); }
struct Unit { int pm, pn, aux; };
#ifndef P1_WGM
#define P1_WGM 4
#endif
struct StaticOrder {
    int nM, nN, nwg, G, c;
    __host__ __device__ void init(int M, int N, int G_, int c_) { nM = M / BM; nN = N / BM; nwg = nM * nN; G = G_; c = c_; }
    __host__ __device__ bool next(int i, Unit& u) const {
        const long L = (long)i * G + c; if (L >= nwg) return false;
        int wgid = (int)L; { const int q = nwg / NXCD, r = nwg % NXCD, xcd = wgid % NXCD, off = wgid / NXCD; wgid = (xcd < r ? xcd * (q + 1) : r * (q + 1) + (xcd - r) * q) + off; }
        const int nig = P1_WGM * nN, gid = wgid / nig, fm = gid * P1_WGM, gsz = (nM - fm) < P1_WGM ? (nM - fm) : P1_WGM;
        u.pm = fm + ((wgid % nig) % gsz); u.pn = (wgid % nig) / gsz; u.aux = 0; return true;
    }
};
__device__ __forceinline__ unsigned cvt_pk_bf16(float lo, float hi) { return gm2::cvt_pk_bf16(lo, hi); }
template <class Epi, class Sched, bool ALIGN_EPI = false, bool SP2 = false, bool RELAX = false>
__device__ __forceinline__ void gemm_phase(PG8_LAS unsigned char* lds, const int K, const Sched& S, const Epi& E) {
    int tid_ = threadIdx.x; asm volatile("" : "+v"(tid_));
    const int tid = tid_, wid = __builtin_amdgcn_readfirstlane(tid >> 6), lane = tid & 63, wr = wid >> 2, wc = wid & 3, fr = lane & 15, fq = lane >> 4;
    const int nt = K / BK;
    unsigned voffA[2], voffB[2];
#pragma unroll
    for (int i = 0; i < 2; ++i) { int R, C; stage_rc(tid * 16 + i * 8192, R, C); const int Rb = Epi::PERM ? ((R & ~31) + perm32(R & 31)) : R;
        voffA[i] = (unsigned)(R * K + C) * 2u; voffB[i] = (unsigned)(Rb * K + C) * 2u; }
    const size_t kstep = (size_t)(BK * 2);
    const size_t hstep = (size_t)HALF * K * 2;
    const unsigned ldsw = (unsigned)wid * 1024u;
    const int aoff = lds_byte(wr * 64 + fr, fq * 8), boff = lds_byte(wc * 32 + fr, fq * 8);
#define PG8_SA(b, h) (((b) * 2 + (h)) * HTB)
#define PG8_SB(b, h) ((4 + (b) * 2 + (h)) * HTB)
#if PG8_ASM_DMA
#define PG8_STAGE(bufoff, gbase, voff) do { _Pragma("unroll") for (int _i = 0; _i < 2; ++_i) \
        pg8_dma16((const void*)(gbase), (voff)[_i], (unsigned)(size_t)(lds + (bufoff) + ldsw + _i * 8192)); } while (0)
#else
#define PG8_STAGE(bufoff, gbase, voff) do { _Pragma("unroll") for (int _i = 0; _i < 2; ++_i) \
        __builtin_amdgcn_global_load_lds((const unsigned*)((const char*)(gbase) + (voff)[_i]), (PG8_LAS unsigned*)(lds + (bufoff) + ldsw + _i * 8192), 16, 0, 0); } while (0)
#endif
#define PG8_LDA(dst, b, h) do { _Pragma("unroll") for (int m = 0; m < 4; ++m) _Pragma("unroll") for (int k = 0; k < 2; ++k) dst[m][k] = *(const PG8_LAS bf16x8*)(lds + PG8_SA(b, h) + aoff + m * 2048 + k * 1024); } while (0)
#define PG8_LDB(dst, b, h) do { _Pragma("unroll") for (int n = 0; n < 2; ++n) _Pragma("unroll") for (int k = 0; k < 2; ++k) dst[n][k] = *(const PG8_LAS bf16x8*)(lds + PG8_SB(b, h) + boff + n * 2048 + k * 1024); } while (0)
#define PG8_MMA(ai, bj, At, Bt) do { __builtin_amdgcn_s_setprio(1); _Pragma("unroll") for (int m = 0; m < 4; ++m) _Pragma("unroll") for (int n = 0; n < 2; ++n) _Pragma("unroll") for (int k = 0; k < 2; ++k) \
        acc[ai][bj][m][n] = __builtin_amdgcn_mfma_f32_16x16x32_bf16(Bt[n][k], At[m][k], acc[ai][bj][m][n], 0, 0, 0); __builtin_amdgcn_s_setprio(0); } while (0)
#define PG8_WAIT_V(n) asm volatile("s_waitcnt vmcnt(" #n ")" ::: "memory")
#define PG8_WAIT_VR asm volatile("s_waitcnt vmcnt(%0)" :: "n"(8 + (Epi::VMOPS > 55 ? 55 : Epi::VMOPS)) : "memory")
#define PG8_WAIT_L(n) asm volatile("s_waitcnt lgkmcnt(" #n ")" ::: "memory")
#define PG8_BAR __builtin_amdgcn_s_barrier()
#define PG8_SCHED __builtin_amdgcn_sched_barrier(0)
    Unit cur, nxt; int ui = 0;
    if (!S.next(0, cur)) return;
    f32x4 acc[2][2][4][2];
#pragma unroll
    for (int a = 0; a < 2; ++a)
#pragma unroll
        for (int b = 0; b < 2; ++b)
#pragma unroll
            for (int m = 0; m < 4; ++m)
#pragma unroll
                for (int n = 0; n < 2; ++n) acc[a][b][m][n] = (f32x4){0.f, 0.f, 0.f, 0.f};
    bf16x8 At[4][2], B0[2][2], B1[2][2];
    const char* cA = S.abase(cur); const char* cB = S.bbase(cur);
    if constexpr (SP2) {
        PG8_STAGE(PG8_SB(0, 0), cB, voffB); PG8_STAGE(PG8_SB(0, 1), cB + hstep, voffB); PG8_STAGE(PG8_SA(0, 0), cA, voffA); PG8_STAGE(PG8_SA(0, 1), cA + hstep, voffA);
        if (wr == 1) PG8_BAR;
        PG8_WAIT_V(2); PG8_BAR;
        PG8_STAGE(PG8_SB(1, 0), cB + kstep, voffB); PG8_STAGE(PG8_SA(1, 0), cA + kstep, voffA); PG8_STAGE(PG8_SB(1, 1), cB + hstep + kstep, voffB);
        if constexpr (RELAX) { PG8_WAIT_V(0); } else { PG8_WAIT_V(6); } PG8_BAR;
    } else {
        PG8_STAGE(PG8_SB(0, 0), cB, voffB); PG8_STAGE(PG8_SA(0, 0), cA, voffA); PG8_STAGE(PG8_SB(0, 1), cB + hstep, voffB); PG8_STAGE(PG8_SA(0, 1), cA + hstep, voffA);
        if (wr == 1) PG8_BAR;
        PG8_WAIT_V(4); PG8_BAR;
        PG8_STAGE(PG8_SB(1, 0), cB + kstep, voffB); PG8_STAGE(PG8_SA(1, 0), cA + kstep, voffA); PG8_STAGE(PG8_SB(1, 1), cB + hstep + kstep, voffB);
        PG8_WAIT_V(6); PG8_BAR;
    }
    for (;;) {
        const bool has_next = S.next(ui + 1, nxt);
        const char* nA = has_next ? S.abase(nxt) : cA; const char* nB = has_next ? S.bbase(nxt) : cB;
#define PG8_ITER(t, last, WV) do { \
            const char* a1 = cA + (size_t)((t) + 1) * kstep; \
            const char* a2 = (last) ? nA : cA + (size_t)((t) + 2) * kstep; const char* b2 = (last) ? nB : cB + (size_t)((t) + 2) * kstep; \
            const char* a3 = a2 + kstep; const char* b3 = b2 + kstep; \
            PG8_LDB(B0, 0, 0); PG8_LDB(B1, 0, 1); PG8_SCHED; PG8_LDA(At, 0, 0); PG8_STAGE(PG8_SA(1, 1), a1 + hstep, voffA); \
            WV; PG8_WAIT_L(0); PG8_BAR; PG8_MMA(0, 0, At, B0); PG8_MMA(0, 1, At, B1); PG8_BAR; PG8_SCHED; \
            PG8_LDA(At, 0, 1); PG8_STAGE(PG8_SB(0, 0), b2, voffB); PG8_STAGE(PG8_SB(0, 1), b2 + hstep, voffB); PG8_STAGE(PG8_SA(0, 0), a2, voffA); \
            WV; PG8_WAIT_L(0); PG8_BAR; PG8_MMA(1, 0, At, B0); PG8_MMA(1, 1, At, B1); PG8_BAR; PG8_SCHED; \
            PG8_LDB(B0, 1, 0); PG8_LDB(B1, 1, 1); PG8_SCHED; PG8_LDA(At, 1, 0); PG8_STAGE(PG8_SA(0, 1), a2 + hstep, voffA); \
            PG8_WAIT_V(8); PG8_WAIT_L(0); PG8_BAR; PG8_MMA(0, 0, At, B0); PG8_MMA(0, 1, At, B1); PG8_BAR; PG8_SCHED; \
            PG8_LDA(At, 1, 1); PG8_STAGE(PG8_SB(1, 0), b3, voffB); PG8_STAGE(PG8_SB(1, 1), b3 + hstep, voffB); PG8_STAGE(PG8_SA(1, 0), a3, voffA); \
            PG8_WAIT_V(8); PG8_WAIT_L(0); PG8_BAR; PG8_MMA(1, 0, At, B0); PG8_MMA(1, 1, At, B1); PG8_BAR; PG8_SCHED; } while (0)
        static_assert(SP2, "only the SP2 loop is kept");
        if constexpr (RELAX) { PG8_ITER(0, false, PG8_WAIT_VR); for (int t = 2; t < nt; t += 2) { const bool last = (t == nt - 2); PG8_ITER(t, last, PG8_WAIT_V(8)); } }
        else { for (int t = 0; t < nt; t += 2) { const bool last = (t == nt - 2); PG8_ITER(t, last, PG8_WAIT_V(8)); } }
#undef PG8_ITER
        if constexpr (ALIGN_EPI) { if (wr == 0) PG8_BAR; }
        if constexpr (!Epi::AFTER_DRAIN) { int fr2 = fr, fq2 = fq; asm volatile("" : "+v"(fr2), "+v"(fq2)); E(acc, cur, wr, wc, fr2, fq2); }
        if (!has_next) break;
#pragma unroll
        for (int a = 0; a < 2; ++a)
#pragma unroll
            for (int b = 0; b < 2; ++b)
#pragma unroll
                for (int m = 0; m < 4; ++m)
#pragma unroll
                    for (int n = 0; n < 2; ++n) acc[a][b][m][n] = (f32x4){0.f, 0.f, 0.f, 0.f};
        cur = nxt; cA = nA; cB = nB; ++ui;
        if constexpr (ALIGN_EPI) { if (wr == 1) PG8_BAR; }
    }
    PG8_WAIT_V(0);
    if constexpr (!ALIGN_EPI) { if (wr == 0) PG8_BAR; }
    PG8_BAR;
    if constexpr (Epi::AFTER_DRAIN) { E.fused(acc, cur, wr, wc, fr, fq, lds, wid, lane); }
#undef PG8_SA
#undef PG8_SB
#undef PG8_STAGE
#undef PG8_LDA
#undef PG8_LDB
#undef PG8_MMA
#undef PG8_WAIT_V
#undef PG8_WAIT_VR
#undef PG8_WAIT_L
#undef PG8_BAR
#undef PG8_SCHED
}

struct SchedProj {
    StaticOrder so; const char* A; const char* B; size_t tstep;
    __device__ __forceinline__ bool next(int i, Unit& u) const { return so.next(i, u); }
    __device__ __forceinline__ const char* abase(const Unit& u) const { return A + (size_t)u.pm * tstep; }
    __device__ __forceinline__ const char* bbase(const Unit& u) const { return B + (size_t)u.pn * tstep; }
};
struct SchedMerged {
    int vcu, G; const char *A0, *A1, *B0, *B1; size_t tstep;
    __device__ __forceinline__ bool next(int i, Unit& u) const { const int tile = vcu + (i >> 1) * G; if (tile >= 512) return false; u.pm = tile >> 2; u.pn = tile & 3; u.aux = i & 1; return true; }
    __device__ __forceinline__ const char* abase(const Unit& u) const { return (u.aux ? A1 : A0) + (size_t)u.pm * tstep; }
    __device__ __forceinline__ const char* bbase(const Unit& u) const { return (u.aux ? B1 : B0) + (size_t)u.pn * tstep; }
};
struct SchedWout {
    int vcu, G; const char *A, *B; size_t tstep;
    __device__ __forceinline__ bool next(int i, Unit& u) const { const int tile = vcu + i * G; if (tile >= 512) return false; u.pm = tile >> 2; u.pn = tile & 3; u.aux = 0; return true; }
    __device__ __forceinline__ const char* abase(const Unit& u) const { return A + (size_t)u.pm * tstep; }
    __device__ __forceinline__ const char* bbase(const Unit& u) const { return B + (size_t)u.pn * tstep; }
};
__device__ __forceinline__ void pair_of2(int pidx, int& a, int& b) { a = pidx < 3 ? 0 : (pidx < 5 ? 1 : 2); b = pidx < 3 ? pidx + 1 : (pidx < 5 ? pidx - 1 : 3); }
struct SchedMoe1 {
    int vcu, G, ntile; const int* tbk; const char *A, *W13; size_t tstep;
    __device__ __forceinline__ bool next(int i, Unit& u) const { const int uid = vcu + i * G; if (uid >= ntile * 8) return false; u.pm = uid >> 3; u.pn = uid & 7; u.aux = __builtin_amdgcn_readfirstlane(tbk[u.pm]); return true; }
    __device__ __forceinline__ const char* abase(const Unit& u) const { return A + (size_t)u.pm * tstep; }
    __device__ __forceinline__ const char* bbase(const Unit& u) const { const int g = u.aux / 6; int a, b; pair_of2(u.aux % 6, a, b); const int e = g * 4 + (u.pn < 4 ? a : b);
        return W13 + ((size_t)e * 1024 + (size_t)(u.pn & 3) * 256) * (1024 * 2); }
};
struct SchedMoe2 {
    int vcu, G, ntile; const int* tbk; const char *A, *W2P; size_t tstep;
    __device__ __forceinline__ bool next(int i, Unit& u) const { const int uid = vcu + i * G; if (uid >= ntile * 4) return false; u.pm = uid >> 2; u.pn = uid & 3; u.aux = __builtin_amdgcn_readfirstlane(tbk[u.pm]); return true; }
    __device__ __forceinline__ const char* abase(const Unit& u) const { return A + (size_t)u.pm * tstep; }
    __device__ __forceinline__ const char* bbase(const Unit& u) const { return W2P + ((size_t)u.aux * 1024 + (size_t)u.pn * 256) * (1024 * 2); }
};

typedef float f32x2 __attribute__((ext_vector_type(2)));
__device__ __forceinline__ float silu_e(float v) { return v * __builtin_amdgcn_rcpf(1.f + __builtin_amdgcn_exp2f(-1.4426950408889634f * v)); }
__device__ __forceinline__ float sigm_e(float v) { return __builtin_amdgcn_rcpf(1.f + __builtin_amdgcn_exp2f(-1.4426950408889634f * v)); }
struct EpiInProj {
    static constexpr bool PERM = true, AFTER_DRAIN = false; static constexpr int VMOPS = 12;
    bf16_t *QO, *Kb, *Vb, *Z, *XBC, *G; float* DT; const float* b_gate; const float* dt_bias;
    __device__ __forceinline__ void operator()(const f32x4 (&acc)[2][2][4][2], const Unit& u, int wr, int wc, int fr, int fq) const {
        const int row0 = u.pm * BM + wr * 64 + fr, pn = u.pn, lc = wc * 32 + 8 * fq;
        if (pn >= 8) {
            const int colt = (pn - 8) * BM + lc;
            f32x4 bv[2][2];
#pragma unroll
            for (int bj = 0; bj < 2; ++bj)
#pragma unroll
                for (int n = 0; n < 2; ++n) bv[bj][n] = *(const f32x4*)(b_gate + colt + bj * HALF + 4 * n);
#pragma unroll
            for (int ai = 0; ai < 2; ++ai)
#pragma unroll
                for (int mp = 0; mp < 2; ++mp)
#pragma unroll
                    for (int bj = 0; bj < 2; ++bj) { unsigned qq[2][2];
#pragma unroll
                        for (int mm = 0; mm < 2; ++mm) { const f32x4 v0 = acc[ai][bj][2 * mp + mm][0] + bv[bj][0], v1 = acc[ai][bj][2 * mp + mm][1] + bv[bj][1];
                            unsigned q0 = 0u, q1 = 0u;
#pragma unroll
                            for (int e = 0; e < 4; ++e) { q0 |= (unsigned)__builtin_rintf(255.f * sigm_e(v0[e])) << (8 * e); q1 |= (unsigned)__builtin_rintf(255.f * sigm_e(v1[e])) << (8 * e); }
                            qq[mm][0] = q0; qq[mm][1] = q1; }
                        auto r0 = __builtin_amdgcn_permlane16_swap(qq[0][0], qq[1][0], false, false); auto r1 = __builtin_amdgcn_permlane16_swap(qq[0][1], qq[1][1], false, false);
                        const u32x4 w = {(unsigned)r0[0], (unsigned)r1[0], (unsigned)r0[1], (unsigned)r1[1]};
                        unsigned char* dst = (unsigned char*)G + (size_t)(row0 + ai * HALF + (2 * mp + (fq & 1)) * 16) * 2048 + (pn - 8) * BM + wc * 32 + 8 * (fq & ~1) + bj * HALF;
                        *(u32x4*)dst = w; }
            return;
        }
        bf16_t* base0; bf16_t* base1; int ld;
        if (pn < 2) { base0 = QO + pn * BM + lc; base1 = base0 + HALF; ld = 512; }
        else if (pn == 2) { base0 = Kb + lc; base1 = Vb + lc; ld = 128; }
        else if (pn < 5) { base0 = Z + (pn - 3) * BM + lc; base1 = base0 + HALF; ld = 512; }
        else { base0 = XBC + (pn - 5) * BM + lc; base1 = base0 + HALF; ld = 768; }
        const bool act = (pn == 3 || pn == 4);
#pragma unroll
        for (int ai = 0; ai < 2; ++ai)
#pragma unroll
            for (int m = 0; m < 4; ++m) { const size_t ro = (size_t)(row0 + ai * HALF + m * 16) * ld;
#pragma unroll
                for (int bj = 0; bj < 2; ++bj) { f32x4 v0 = acc[ai][bj][m][0], v1 = acc[ai][bj][m][1];
                    if (act) {
#pragma unroll
                        for (int e = 0; e < 4; ++e) { v0[e] = silu_e(v0[e]); v1[e] = silu_e(v1[e]); } }
                    u32x4 w; w.x = cvt_pk_bf16(v0[0], v0[1]); w.y = cvt_pk_bf16(v0[2], v0[3]); w.z = cvt_pk_bf16(v1[0], v1[1]); w.w = cvt_pk_bf16(v1[2], v1[3]);
                    *(u32x4*)((bj ? base1 : base0) + ro) = w; } }
    }
};
__device__ __forceinline__ float bflo(unsigned w) { return __builtin_bit_cast(float, w << 16); }
__device__ __forceinline__ float bfhi(unsigned w) { return __builtin_bit_cast(float, w & 0xffff0000u); }
struct EpiMerged {
    static constexpr bool PERM = true, AFTER_DRAIN = false;
    const bf16_t* G; bf16_t* MG;
    __device__ __forceinline__ void operator()(const f32x4 (&acc)[2][2][4][2], const Unit& u, int wr, int wc, int fr, int fq) const {
        const int row0 = u.pm * BM + wr * 64 + fr, col0 = u.pn * BM + wc * 32 + 8 * fq, goff = u.aux ? 0 : 1024;
#pragma unroll
        for (int ai = 0; ai < 2; ++ai)
#pragma unroll
            for (int m = 0; m < 4; ++m) { const size_t row = (size_t)(row0 + ai * HALF + m * 16);
#pragma unroll
                for (int bj = 0; bj < 2; ++bj) { const int col = col0 + bj * HALF;
                    const u32x2 gv = *(const u32x2*)((const unsigned char*)G + row * 2048 + goff + col);
                    f32x4 v0 = acc[ai][bj][m][0], v1 = acc[ai][bj][m][1];
#pragma unroll
                    for (int e = 0; e < 4; ++e) { v0[e] *= (float)((gv.x >> (8 * e)) & 0xffu) * (1.f / 255.f); v1[e] *= (float)((gv.y >> (8 * e)) & 0xffu) * (1.f / 255.f); }
                    bf16_t* dst = MG + row * 1024 + col;
                    if (u.aux) { const u32x4 ov = *(const u32x4*)dst;
                        v0[0] += bflo(ov.x); v0[1] += bfhi(ov.x); v0[2] += bflo(ov.y); v0[3] += bfhi(ov.y); v1[0] += bflo(ov.z); v1[1] += bfhi(ov.z); v1[2] += bflo(ov.w); v1[3] += bfhi(ov.w); }
                    u32x4 w; w.x = cvt_pk_bf16(v0[0], v0[1]); w.y = cvt_pk_bf16(v0[2], v0[3]); w.z = cvt_pk_bf16(v1[0], v1[1]); w.w = cvt_pk_bf16(v1[2], v1[3]);
                    *(u32x4*)dst = w; } }
    }
};
struct EpiWout {
    static constexpr bool PERM = true, AFTER_DRAIN = false; static constexpr int VMOPS = 48;
    const float* x; bf16_t* X1;
    __device__ __forceinline__ void operator()(const f32x4 (&acc)[2][2][4][2], const Unit& u, int wr, int wc, int fr, int fq) const {
        const int row0 = u.pm * BM + wr * 64 + fr, col0 = u.pn * BM + wc * 32 + 8 * fq;
#pragma unroll
        for (int ai = 0; ai < 2; ++ai) {
            f32x4 xv[4][2][2];
#pragma unroll
            for (int m = 0; m < 4; ++m) { const size_t off = (size_t)(row0 + ai * HALF + m * 16) * 1024 + col0;
#pragma unroll
                for (int bj = 0; bj < 2; ++bj) { xv[m][bj][0] = *(const f32x4*)(x + off + bj * HALF); xv[m][bj][1] = *(const f32x4*)(x + off + bj * HALF + 4); } }
            __builtin_amdgcn_sched_barrier(0);
#pragma unroll
            for (int m = 0; m < 4; ++m) { const size_t off = (size_t)(row0 + ai * HALF + m * 16) * 1024 + col0;
#pragma unroll
                for (int bj = 0; bj < 2; ++bj) { const f32x4 v0 = xv[m][bj][0] + acc[ai][bj][m][0], v1 = xv[m][bj][1] + acc[ai][bj][m][1];
                    u32x4 w; w.x = cvt_pk_bf16(v0[0], v0[1]); w.y = cvt_pk_bf16(v0[2], v0[3]); w.z = cvt_pk_bf16(v1[0], v1[1]); w.w = cvt_pk_bf16(v1[2], v1[3]);
                    *(u32x4*)(X1 + off + bj * HALF) = w; } }
            asm volatile("" ::: "memory");
            __builtin_amdgcn_sched_barrier(0);
        }
    }
};
struct EpiMoe1 {
    static constexpr bool PERM = true, AFTER_DRAIN = false, HAS_MID = false; static constexpr int MID_T = 0; static constexpr int VMOPS = 24;
    bf16_t* HID; const float* SWA; const float* SWB; const float* SRS;
    __device__ __forceinline__ void operator()(const f32x4 (&acc)[2][2][4][2], const Unit& u, int wr, int wc, int fr, int fq) const {
        const int row0 = u.pm * BM + wr * 64 + fr, slot = u.pn >> 2, hc = slot * 512 + (u.pn & 3) * 128 + 16 * wc + 4 * fq;
        const float* SW = slot ? SWB : SWA;
        float wrow[2][4], rrow[2][4];
#pragma unroll
        for (int ai = 0; ai < 2; ++ai)
#pragma unroll
            for (int m = 0; m < 4; ++m) { wrow[ai][m] = SW[row0 + ai * HALF + m * 16]; rrow[ai][m] = SRS[row0 + ai * HALF + m * 16]; }
        __builtin_amdgcn_sched_barrier(0);
#pragma unroll
        for (int ai = 0; ai < 2; ++ai)
#pragma unroll
            for (int mp = 0; mp < 2; ++mp)
#pragma unroll
                for (int bj = 0; bj < 2; ++bj) { u32x2 oo[2];
#pragma unroll
                    for (int mm = 0; mm < 2; ++mm) { const int m = 2 * mp + mm; const float rs = rrow[ai][m], w = wrow[ai][m] * rs; const f32x4 v0 = acc[ai][bj][m][0], v1 = acc[ai][bj][m][1];
                        float h0 = w * silu_e(rs * v0[0]) * v0[1], h1 = w * silu_e(rs * v0[2]) * v0[3], h2 = w * silu_e(rs * v1[0]) * v1[1], h3 = w * silu_e(rs * v1[2]) * v1[3];
                        if (w == 0.f) { h0 = 0.f; h1 = 0.f; h2 = 0.f; h3 = 0.f; }
                        oo[mm].x = cvt_pk_bf16(h0, h1); oo[mm].y = cvt_pk_bf16(h2, h3); }
                    auto r0 = __builtin_amdgcn_permlane16_swap(oo[0].x, oo[1].x, false, false); auto r1 = __builtin_amdgcn_permlane16_swap(oo[0].y, oo[1].y, false, false);
                    const u32x4 wv = {(unsigned)r0[0], (unsigned)r1[0], (unsigned)r0[1], (unsigned)r1[1]};
                    const size_t row = (size_t)(row0 + ai * HALF + (2 * mp + (fq & 1)) * 16);
                    *(u32x4*)(HID + row * 1024 + slot * 512 + (u.pn & 3) * 128 + 16 * wc + 4 * (fq & ~1) + 64 * bj) = wv; }
    }
};
struct EpiMoe2 {
    static constexpr bool PERM = false, AFTER_DRAIN = false, HAS_MID = false; static constexpr int MID_T = 0; static constexpr int VMOPS = 32;
    float* out; const int* perm; const bf16_t* X1;
    __device__ __forceinline__ void operator()(const f32x4 (&acc)[2][2][4][2], const Unit& u, int wr, int wc, int fr, int fq) const {
        const int row0 = u.pm * BM + wr * 64 + fr, col0 = u.pn * BM + wc * 32 + 4 * fq;
        int tok[2][4];
#pragma unroll
        for (int ai = 0; ai < 2; ++ai)
#pragma unroll
            for (int m = 0; m < 4; ++m) { const int P = (u.aux >> 8) & 7, q = u.aux >> 12;
                const bool mine = (P <= 1) || (P == 2 ? ai == q : (ai == (q >> 1) && (m >> 1) == (q & 1)));
                tok[ai][m] = mine ? perm[row0 + ai * HALF + m * 16] : -1; }
#pragma unroll
        for (int ai = 0; ai < 2; ++ai) {
            u32x2 xv[4][2][2];
#pragma unroll
            for (int m = 0; m < 4; ++m) { const size_t off = (size_t)(tok[ai][m] < 0 ? 0 : tok[ai][m]) * 1024 + col0;
#pragma unroll
                for (int bj = 0; bj < 2; ++bj)
#pragma unroll
                    for (int n = 0; n < 2; ++n) xv[m][bj][n] = *(const u32x2*)(X1 + off + bj * HALF + n * 16); }
#pragma unroll
            for (int m = 0; m < 4; ++m) { if (tok[ai][m] >= 0) { const size_t off = (size_t)tok[ai][m] * 1024 + col0;
#pragma unroll
                for (int bj = 0; bj < 2; ++bj)
#pragma unroll
                    for (int n = 0; n < 2; ++n) { const u32x2 x = xv[m][bj][n];
                        const f32x4 r = {bflo(x.x) + acc[ai][bj][m][n][0], bfhi(x.x) + acc[ai][bj][m][n][1], bflo(x.y) + acc[ai][bj][m][n][2], bfhi(x.y) + acc[ai][bj][m][n][3]};
                        *(f32x4*)(out + off + bj * HALF + n * 16) = r; } } }
            asm volatile("" ::: "memory");
        }
    }
};
template <class Epi, class Sched, bool ALIGN_EPI = false, bool SP2 = false, bool GATHER = false, bool RELAX = false>
__device__ __forceinline__ void gemm_phase2(PG8_LAS unsigned char* lds, const int pitchA, const int pitchB, const int nt, const Sched& S, const Epi& E) {
    int tid_ = threadIdx.x; asm volatile("" : "+v"(tid_));
    const int tid = tid_, wid = __builtin_amdgcn_readfirstlane(tid >> 6), lane = tid & 63, wr = wid >> 2, wc = wid & 3, fr = lane & 15, fq = lane >> 4;
    unsigned voffA[2], voffB[2];
#pragma unroll
    for (int i = 0; i < 2; ++i) { int R, C; stage_rc(tid * 16 + i * 8192, R, C); const int Rb = Epi::PERM ? ((R & ~31) + perm32(R & 31)) : R;
        voffA[i] = (unsigned)(R * pitchA + C) * 2u; voffB[i] = (unsigned)(Rb * pitchB + C) * 2u; }
    unsigned uAc[2][2] = {{0u, 0u}, {0u, 0u}}, uAn[2][2] = {{0u, 0u}, {0u, 0u}};
    int gR[2], gC[2];
#pragma unroll
    for (int i = 0; i < 2; ++i) stage_rc(tid * 16 + i * 8192, gR[i], gC[i]);
#if PG8_ASM_DMA
#define PG8_DMA1(kptr, off32, boff) pg8_dma16((const void*)(kptr), (off32), (unsigned)(size_t)(lds + (boff) + ldsw))
#else
#define PG8_DMA1(kptr, off32, boff) __builtin_amdgcn_global_load_lds((const unsigned*)((const char*)(kptr) + (off32)), (PG8_LAS unsigned*)(lds + (boff) + ldsw), 16, 0, 0)
#endif
#define PG8_ROWOFFS(dst, un) do { if constexpr (GATHER) { _Pragma("unroll") for (int h_ = 0; h_ < 2; ++h_) _Pragma("unroll") for (int i_ = 0; i_ < 2; ++i_) \
        dst[h_][i_] = (unsigned)S.arow(un, h_ * HALF + gR[i_]) * (unsigned)(pitchA * 2) + (unsigned)(gC[i_] * 2); } } while (0)
#define PG8_STAGE_AH(bufoff, kptr, h, NEXT) do { if constexpr (GATHER) { _Pragma("unroll") for (int _i = 0; _i < 2; ++_i) \
        PG8_DMA1((kptr), ((NEXT) ? uAn[h][_i] : uAc[h][_i]), (bufoff) + _i * 8192); } \
      else { PG8_STAGE(bufoff, (const char*)(kptr) + ((h) ? hstepA : 0), voffA); } } while (0)
    const size_t kstep = (size_t)(BK * 2);
    const size_t hstepA = (size_t)HALF * pitchA * 2, hstepB = (size_t)HALF * pitchB * 2;
    const unsigned ldsw = (unsigned)wid * 1024u;
    const int aoff = lds_byte(wr * 64 + fr, fq * 8), boff = lds_byte(wc * 32 + fr, fq * 8);
#define PG8_SA(b, h) (((b) * 2 + (h)) * HTB)
#define PG8_SB(b, h) ((4 + (b) * 2 + (h)) * HTB)
#if PG8_ASM_DMA
#define PG8_STAGE(bufoff, gbase, voff) do { _Pragma("unroll") for (int _i = 0; _i < 2; ++_i) \
        pg8_dma16((const void*)(gbase), (voff)[_i], (unsigned)(size_t)(lds + (bufoff) + ldsw + _i * 8192)); } while (0)
#else
#define PG8_STAGE(bufoff, gbase, voff) do { _Pragma("unroll") for (int _i = 0; _i < 2; ++_i) \
        __builtin_amdgcn_global_load_lds((const unsigned*)((const char*)(gbase) + (voff)[_i]), (PG8_LAS unsigned*)(lds + (bufoff) + ldsw + _i * 8192), 16, 0, 0); } while (0)
#endif
#define PG8_LDA(dst, b, h) do { _Pragma("unroll") for (int m = 0; m < 4; ++m) _Pragma("unroll") for (int k = 0; k < 2; ++k) dst[m][k] = *(const PG8_LAS bf16x8*)(lds + PG8_SA(b, h) + aoff + m * 2048 + k * 1024); } while (0)
#define PG8_LDB(dst, b, h) do { _Pragma("unroll") for (int n = 0; n < 2; ++n) _Pragma("unroll") for (int k = 0; k < 2; ++k) dst[n][k] = *(const PG8_LAS bf16x8*)(lds + PG8_SB(b, h) + boff + n * 2048 + k * 1024); } while (0)
#define PG8_MMA(ai, bj, At, Bt) do { __builtin_amdgcn_s_setprio(1); _Pragma("unroll") for (int m = 0; m < 4; ++m) _Pragma("unroll") for (int n = 0; n < 2; ++n) _Pragma("unroll") for (int k = 0; k < 2; ++k) \
        acc[ai][bj][m][n] = __builtin_amdgcn_mfma_f32_16x16x32_bf16(Bt[n][k], At[m][k], acc[ai][bj][m][n], 0, 0, 0); __builtin_amdgcn_s_setprio(0); } while (0)
#define PG8_WAIT_V(n) asm volatile("s_waitcnt vmcnt(" #n ")" ::: "memory")
#define PG8_WAIT_VR asm volatile("s_waitcnt vmcnt(%0)" :: "n"(8 + (Epi::VMOPS > 55 ? 55 : Epi::VMOPS)) : "memory")
#define PG8_WAIT_L(n) asm volatile("s_waitcnt lgkmcnt(" #n ")" ::: "memory")
#define PG8_BAR __builtin_amdgcn_s_barrier()
#define PG8_SCHED __builtin_amdgcn_sched_barrier(0)
    Unit cur, nxt; int ui = 0;
    if (!S.next(0, cur)) return;
    f32x4 acc[2][2][4][2];
#pragma unroll
    for (int a = 0; a < 2; ++a)
#pragma unroll
        for (int b = 0; b < 2; ++b)
#pragma unroll
            for (int m = 0; m < 4; ++m)
#pragma unroll
                for (int n = 0; n < 2; ++n) acc[a][b][m][n] = (f32x4){0.f, 0.f, 0.f, 0.f};
    bf16x8 At[4][2], B0[2][2], B1[2][2];
    PG8_ROWOFFS(uAc, cur);
    const char* cA = S.aptr(cur, 0); const char* cB = S.bptr(cur, 0); const char* cA1 = S.aptr(cur, 1); const char* cB1 = S.bptr(cur, 1);
    if constexpr (SP2) {
        PG8_STAGE(PG8_SB(0, 0), cB, voffB); PG8_STAGE(PG8_SB(0, 1), cB + hstepB, voffB); PG8_STAGE_AH(PG8_SA(0, 0), cA, 0, false); PG8_STAGE_AH(PG8_SA(0, 1), cA, 1, false);
        if (wr == 1) PG8_BAR;
        PG8_WAIT_V(2); PG8_BAR;
        PG8_STAGE(PG8_SB(1, 0), cB1, voffB); PG8_STAGE_AH(PG8_SA(1, 0), cA1, 0, false); PG8_STAGE(PG8_SB(1, 1), cB1 + hstepB, voffB);
        if constexpr (RELAX) { PG8_WAIT_V(0); } else { PG8_WAIT_V(6); } PG8_BAR;
    } else {
        PG8_STAGE(PG8_SB(0, 0), cB, voffB); PG8_STAGE_AH(PG8_SA(0, 0), cA, 0, false); PG8_STAGE(PG8_SB(0, 1), cB + hstepB, voffB); PG8_STAGE_AH(PG8_SA(0, 1), cA, 1, false);
        if (wr == 1) PG8_BAR;
        PG8_WAIT_V(4); PG8_BAR;
        PG8_STAGE(PG8_SB(1, 0), cB1, voffB); PG8_STAGE_AH(PG8_SA(1, 0), cA1, 0, false); PG8_STAGE(PG8_SB(1, 1), cB1 + hstepB, voffB);
        PG8_WAIT_V(6); PG8_BAR;
    }
    for (;;) {
        const bool has_next = S.next(ui + 1, nxt);
        const Unit nu = has_next ? nxt : cur;
        int rawn[2][2] = {{0, 0}, {0, 0}};
        if constexpr (GATHER) { _Pragma("unroll") for (int h_ = 0; h_ < 2; ++h_) _Pragma("unroll") for (int i_ = 0; i_ < 2; ++i_) rawn[h_][i_] = S.arow_raw(nu, h_ * HALF + gR[i_]); }
        const char* nA = S.aptr(nu, 0); const char* nB = S.bptr(nu, 0); const char* nA1 = S.aptr(nu, 1); const char* nB1 = S.bptr(nu, 1);
#define PG8_ITER(t, last, WV) do { \
            if constexpr (Epi::HAS_MID) { if ((t) == Epi::MID_T) E.mid(acc, cur, wr, wc, fr, fq); } \
            const char* a1 = S.aptr(cur, (t) + 1); \
            const char* a2 = (last) ? nA : S.aptr(cur, (t) + 2); const char* b2 = (last) ? nB : S.bptr(cur, (t) + 2); \
            const char* a3 = (last) ? nA1 : S.aptr(cur, (t) + 3); const char* b3 = (last) ? nB1 : S.bptr(cur, (t) + 3); \
            PG8_LDB(B0, 0, 0); PG8_LDB(B1, 0, 1); PG8_SCHED; PG8_LDA(At, 0, 0); PG8_STAGE_AH(PG8_SA(1, 1), a1, 1, false); \
            WV; PG8_WAIT_L(0); PG8_BAR; PG8_MMA(0, 0, At, B0); PG8_MMA(0, 1, At, B1); PG8_BAR; PG8_SCHED; \
            PG8_LDA(At, 0, 1); PG8_STAGE(PG8_SB(0, 0), b2, voffB); PG8_STAGE(PG8_SB(0, 1), b2 + hstepB, voffB); PG8_STAGE_AH(PG8_SA(0, 0), a2, 0, last); \
            WV; PG8_WAIT_L(0); PG8_BAR; PG8_MMA(1, 0, At, B0); PG8_MMA(1, 1, At, B1); PG8_BAR; PG8_SCHED; \
            PG8_LDB(B0, 1, 0); PG8_LDB(B1, 1, 1); PG8_SCHED; PG8_LDA(At, 1, 0); PG8_STAGE_AH(PG8_SA(0, 1), a2, 1, last); \
            PG8_WAIT_V(8); PG8_WAIT_L(0); PG8_BAR; PG8_MMA(0, 0, At, B0); PG8_MMA(0, 1, At, B1); PG8_BAR; PG8_SCHED; \
            PG8_LDA(At, 1, 1); PG8_STAGE(PG8_SB(1, 0), b3, voffB); PG8_STAGE(PG8_SB(1, 1), b3 + hstepB, voffB); PG8_STAGE_AH(PG8_SA(1, 0), a3, 0, last); \
            PG8_WAIT_V(8); PG8_WAIT_L(0); PG8_BAR; PG8_MMA(1, 0, At, B0); PG8_MMA(1, 1, At, B1); PG8_BAR; PG8_SCHED; } while (0)
        static_assert(SP2, "only the SP2 loop is kept");
        if constexpr (GATHER) {
            if constexpr (RELAX) { PG8_ITER(0, false, PG8_WAIT_VR); for (int t = 2; t < nt - 2; t += 2) { PG8_ITER(t, false, PG8_WAIT_V(8)); } }
            else { for (int t = 0; t < nt - 2; t += 2) { PG8_ITER(t, false, PG8_WAIT_V(8)); } }
            asm volatile("" : "+v"(rawn[0][0]), "+v"(rawn[0][1]), "+v"(rawn[1][0]), "+v"(rawn[1][1]));
            _Pragma("unroll") for (int h_ = 0; h_ < 2; ++h_) _Pragma("unroll") for (int i_ = 0; i_ < 2; ++i_) { const int r_ = rawn[h_][i_]; uAn[h_][i_] = (unsigned)(r_ < 0 ? 0 : r_) * (unsigned)(pitchA * 2) + (unsigned)(gC[i_] * 2); }
            PG8_ITER(nt - 2, true, PG8_WAIT_V(8));
        } else {
            if constexpr (RELAX) { PG8_ITER(0, false, PG8_WAIT_VR); for (int t = 2; t < nt; t += 2) { const bool last = (t == nt - 2); PG8_ITER(t, last, PG8_WAIT_V(8)); } }
            else { for (int t = 0; t < nt; t += 2) { const bool last = (t == nt - 2); PG8_ITER(t, last, PG8_WAIT_V(8)); } }
        }
#undef PG8_ITER
        if constexpr (ALIGN_EPI) { if (wr == 0) PG8_BAR; }
        if constexpr (!Epi::AFTER_DRAIN) { int fr2 = fr, fq2 = fq; asm volatile("" : "+v"(fr2), "+v"(fq2)); E(acc, cur, wr, wc, fr2, fq2); }
        if (!has_next) break;
#pragma unroll
        for (int a = 0; a < 2; ++a)
#pragma unroll
            for (int b = 0; b < 2; ++b)
#pragma unroll
                for (int m = 0; m < 4; ++m)
#pragma unroll
                    for (int n = 0; n < 2; ++n) acc[a][b][m][n] = (f32x4){0.f, 0.f, 0.f, 0.f};
        cur = nxt; ++ui;
        if constexpr (GATHER) { _Pragma("unroll") for (int h_ = 0; h_ < 2; ++h_) _Pragma("unroll") for (int i_ = 0; i_ < 2; ++i_) uAc[h_][i_] = uAn[h_][i_]; }
        if constexpr (ALIGN_EPI) { if (wr == 1) PG8_BAR; }
    }
    PG8_WAIT_V(0);
    if constexpr (!ALIGN_EPI) { if (wr == 0) PG8_BAR; }
    PG8_BAR;
    if constexpr (Epi::AFTER_DRAIN) { E.fused(acc, cur, wr, wc, fr, fq, lds, wid, lane); }
#undef PG8_SA
#undef PG8_SB
#undef PG8_STAGE
#undef PG8_LDA
#undef PG8_LDB
#undef PG8_MMA
#undef PG8_WAIT_V
#undef PG8_WAIT_VR
#undef PG8_WAIT_L
#undef PG8_BAR
#undef PG8_SCHED
#undef PG8_ROWOFFS
#undef PG8_STAGE_AH
#undef PG8_DMA1
}


struct SchedMerged2 {
    int vcu, G; const char *A_attn, *A_ssd, *B_a, *B_s; size_t tstep;
    __device__ __forceinline__ bool next(int i, Unit& u) const { const int tile = vcu + i * G; if (tile >= 512) return false; u.pm = tile >> 2; u.pn = tile & 3; u.aux = 0; return true; }
    __device__ __forceinline__ const char* aptr(const Unit& u, int t) const { return (t < 8 ? A_attn : A_ssd) + (size_t)u.pm * tstep + (size_t)(t & 7) * (BK * 2); }
    __device__ __forceinline__ const char* bptr(const Unit& u, int t) const { return (t < 8 ? B_a : B_s) + (size_t)u.pn * tstep + (size_t)(t & 7) * (BK * 2); }
};
struct EpiMerged2 {
    static constexpr bool PERM = true, AFTER_DRAIN = false, HAS_MID = true; static constexpr int MID_T = 8; static constexpr int VMOPS = 32;
    const unsigned char* G8; bf16_t* MG;
    __device__ __forceinline__ void mid(f32x4 (&acc)[2][2][4][2], const Unit& u, int wr, int wc, int fr, int fq) const {
        const int row0 = u.pm * BM + wr * 64 + fr, col0 = u.pn * BM + wc * 32 + 8 * fq;
#pragma unroll
        for (int ai = 0; ai < 2; ++ai) {
            u32x2 ga[4][2], gs[4][2];
#pragma unroll
            for (int m = 0; m < 4; ++m) { const unsigned char* gp = G8 + (size_t)(row0 + ai * HALF + m * 16) * 2048 + col0;
#pragma unroll
                for (int bj = 0; bj < 2; ++bj) { ga[m][bj] = *(const u32x2*)(gp + bj * HALF); gs[m][bj] = *(const u32x2*)(gp + 1024 + bj * HALF); } }
            __builtin_amdgcn_sched_barrier(0);
#pragma unroll
            for (int m = 0; m < 4; ++m)
#pragma unroll
                for (int bj = 0; bj < 2; ++bj)
#pragma unroll
                    for (int e = 0; e < 4; ++e) {
                        const unsigned s0 = (gs[m][bj].x >> (8 * e)) & 0xffu, s1 = (gs[m][bj].y >> (8 * e)) & 0xffu;
                        acc[ai][bj][m][0][e] *= (float)((ga[m][bj].x >> (8 * e)) & 0xffu) * __builtin_amdgcn_rcpf((float)(s0 ? s0 : 1u));
                        acc[ai][bj][m][1][e] *= (float)((ga[m][bj].y >> (8 * e)) & 0xffu) * __builtin_amdgcn_rcpf((float)(s1 ? s1 : 1u)); }
            asm volatile("" ::: "memory");
            __builtin_amdgcn_sched_barrier(0);
        }
    }
    __device__ __forceinline__ void operator()(const f32x4 (&acc)[2][2][4][2], const Unit& u, int wr, int wc, int fr, int fq) const {
        const int row0 = u.pm * BM + wr * 64 + fr, col0 = u.pn * BM + wc * 32 + 8 * fq;
        u32x2 gs[2][4][2];
#pragma unroll
        for (int ai = 0; ai < 2; ++ai)
#pragma unroll
            for (int m = 0; m < 4; ++m) { const size_t row = (size_t)(row0 + ai * HALF + m * 16);
#pragma unroll
                for (int bj = 0; bj < 2; ++bj) gs[ai][m][bj] = *(const u32x2*)(G8 + row * 2048 + 1024 + col0 + bj * HALF); }
        __builtin_amdgcn_sched_barrier(0);
#pragma unroll
        for (int ai = 0; ai < 2; ++ai)
#pragma unroll
            for (int m = 0; m < 4; ++m) { const size_t row = (size_t)(row0 + ai * HALF + m * 16);
#pragma unroll
                for (int bj = 0; bj < 2; ++bj) { const int col = col0 + bj * HALF; const u32x2 g = gs[ai][m][bj];
                    f32x4 v0 = acc[ai][bj][m][0], v1 = acc[ai][bj][m][1];
#pragma unroll
                    for (int e = 0; e < 4; ++e) { const unsigned s0 = (g.x >> (8 * e)) & 0xffu, s1 = (g.y >> (8 * e)) & 0xffu;
                        v0[e] *= (float)(s0 ? s0 : 1u) * (1.f / 255.f); v1[e] *= (float)(s1 ? s1 : 1u) * (1.f / 255.f); }
                    u32x4 w; w.x = cvt_pk_bf16(v0[0], v0[1]); w.y = cvt_pk_bf16(v0[2], v0[3]); w.z = cvt_pk_bf16(v1[0], v1[1]); w.w = cvt_pk_bf16(v1[2], v1[3]);
                    *(u32x4*)(MG + row * 1024 + col) = w; } }
    }
};

struct SchedMoe2b {
    int vcu, G, ntile; const int* tbk; const char *A, *W2T; size_t tstepA; int ax0, ax1, ax2, ax3;
    __device__ __forceinline__ bool locate(int i, int& unit, int& code) const { const int uid = vcu + i * G, total = ntile * 4, nfull = (total / G) * G, ntail = total - nfull;
        const int P = MOE2_SPLIT_TAIL ? (ntail * 4 <= G ? 4 : (ntail * 2 <= G ? 2 : 1)) : 1;
        unit = uid; code = 0;
        if (uid >= nfull) { const int r = uid - nfull; if (r >= ntail * P) return false; unit = nfull + r / P; code = (P << 8) | ((r % P) << 12); }
        return true; }
    __device__ __forceinline__ void preload() { int a[4];
#pragma unroll
        for (int i = 0; i < 4; ++i) { int unit, code; const bool ok = locate(i, unit, code); a[i] = tbk[ok ? (unit >> 2) : 0]; }
        ax0 = __builtin_amdgcn_readfirstlane(a[0]); ax1 = __builtin_amdgcn_readfirstlane(a[1]); ax2 = __builtin_amdgcn_readfirstlane(a[2]); ax3 = __builtin_amdgcn_readfirstlane(a[3]); }
    __device__ __forceinline__ bool next(int i, Unit& u) const { int unit, code; if (!locate(i, unit, code)) return false;
        u.pm = unit >> 2; u.pn = unit & 3;
        u.aux = (i == 0 ? ax0 : (i == 1 ? ax1 : (i == 2 ? ax2 : (i == 3 ? ax3 : __builtin_amdgcn_readfirstlane(tbk[u.pm]))))) | code; return true; }
    __device__ __forceinline__ const char* aptr(const Unit& u, int t) const { return A + (size_t)u.pm * tstepA + (size_t)t * (BK * 2); }
    __device__ __forceinline__ const char* bptr(const Unit& u, int t) const { const int bk = u.aux & 255, g = bk / 6; int a, b; pair_of2(bk % 6, a, b); const int e = g * 4 + (t < 8 ? a : b);
        return W2T + ((size_t)e * 1024 + (size_t)u.pn * 256) * (512 * 2) + (size_t)(t & 7) * (BK * 2); }
};

struct SchedMoe1g {
    int vcu, G, ntile; const int* tbk; const int* perm; const char *H2, *W13; int ax0, ax1, ax2, ax3, ax4;
    __device__ __forceinline__ void preload() { int a[5];
#pragma unroll
        for (int i = 0; i < 5; ++i) { const int uid = vcu + i * G; a[i] = tbk[uid < ntile * 8 ? (uid >> 3) : 0]; }
        ax0 = __builtin_amdgcn_readfirstlane(a[0]); ax1 = __builtin_amdgcn_readfirstlane(a[1]); ax2 = __builtin_amdgcn_readfirstlane(a[2]); ax3 = __builtin_amdgcn_readfirstlane(a[3]); ax4 = __builtin_amdgcn_readfirstlane(a[4]); }
    __device__ __forceinline__ bool next(int i, Unit& u) const { const int uid = vcu + i * G; if (uid >= ntile * 8) return false; u.pm = uid >> 3; u.pn = uid & 7;
        u.aux = i == 0 ? ax0 : (i == 1 ? ax1 : (i == 2 ? ax2 : (i == 3 ? ax3 : (i == 4 ? ax4 : __builtin_amdgcn_readfirstlane(tbk[u.pm]))))); return true; }
    __device__ __forceinline__ int arow(const Unit& u, int r) const { const int t = perm[u.pm * 256 + r]; return t < 0 ? 0 : t; }
    __device__ __forceinline__ int arow_raw(const Unit& u, int r) const { int v; const int* a = perm + u.pm * 256 + r; asm volatile("global_load_dword %0, %1, off" : "=v"(v) : "v"(a) : "memory"); return v; }
    __device__ __forceinline__ const char* aptr(const Unit&, int t) const { return H2 + (size_t)t * (BK * 2); }
    __device__ __forceinline__ const char* bptr(const Unit& u, int t) const { const int g = u.aux / 6; int a, b; pair_of2(u.aux % 6, a, b); const int e = g * 4 + (u.pn < 4 ? a : b);
        return W13 + ((size_t)e * 1024 + (size_t)(u.pn & 3) * 256) * (1024 * 2) + (size_t)t * (BK * 2); }
};
}

namespace ssd {
typedef __attribute__((address_space(3))) unsigned char LB;
typedef __attribute__((address_space(3))) const bf16x8 Lbf8;
typedef __attribute__((address_space(3))) const u32x2 Lu2;
typedef __attribute__((address_space(3))) const f32x4 Lf4;
typedef unsigned u32x2v __attribute__((ext_vector_type(2)));
constexpr int XT_P = 272, BS_P = 144;
constexpr int OFF_XT = 0, OFF_BS = 256 * XT_P, OFF_BST = OFF_BS + 128 * BS_P, OFF_CS = OFF_BST + 64 * XT_P, OFF_F = OFF_CS + 128 * BS_P;
constexpr int F_DT0 = OFF_F, F_DT1 = OFF_F + 2048, F_CUM = OFF_F + 4096, F_SUF = OFF_F + 6144, F_WF = OFF_F + 8192, F_WB = OFF_F + 10240, LDS_END = OFF_F + 12288;
static_assert(LDS_END <= 147456 - 256, "ssd chunk LDS");
__device__ __forceinline__ unsigned cvtpk(float lo, float hi) { return gm2::cvt_pk_bf16(lo, hi); }
__device__ __forceinline__ float wave_incl_scan(float v, int lane) {
#pragma unroll
    for (int o = 1; o < 64; o <<= 1) { const float t = __shfl_up(v, o); if (lane >= o) v += t; }
    return v;
}
__device__ __forceinline__ void chunk_phase(const Params& p, LB* lds_) {
    LB* const lds = (LB*)(size_t)0;
    (void)lds_;
    const int tid = tid_opaque(), lane = tid & 63, wid = __builtin_amdgcn_readfirstlane(tid >> 6), r32 = lane & 31, hh = lane >> 5;
    const bf16_t* XBC = (const bf16_t*)(p.ws + WS_XBC); const float* DT = (const float*)(p.ws + WS_DT);
    bf16_t* YD = (bf16_t*)(p.ws + WS_YD); bf16_t* CC = (bf16_t*)(p.ws + WS_CC); float* ACUM = (float*)(p.ws + WS_ACUM); float* ST = (float*)(p.ws + WS_ST);
    for (int item = blockIdx.x; item < BATCH * NCHUNK * SSD_G; item += gridDim.x) {
        const int g = item & 1, c = (item >> 1) % NCHUNK, b = item / (2 * NCHUNK);
        const int t0 = b * SEQ + c * CHUNK;
        __syncthreads();
        if (tid < 384) {
            const int grp = tid % 96, rq = tid / 96, cl = 4 * grp;
            const int ch = cl < 256 ? 256 * g + cl : (cl < 320 ? 512 + 64 * g + (cl - 256) : 640 + 64 * g + (cl - 320));
            float w[7][4], bias[4];
#pragma unroll
            for (int k = 0; k < 7; ++k) { const f32x4 t = *(const f32x4*)(p.conv_w + k * CONV_CH + ch); w[k][0] = t[0]; w[k][1] = t[1]; w[k][2] = t[2]; w[k][3] = t[3]; }
            { const f32x4 t = *(const f32x4*)(p.conv_b + ch); bias[0] = t[0]; bias[1] = t[1]; bias[2] = t[2]; bias[3] = t[3]; }
            const bool head_pad = (c == 0 && rq == 0), tail_pad = (c == NCHUNK - 1 && rq == 3);
            float win[7][4];
#pragma unroll
            for (int k = 0; k < 7; ++k) { win[k][0] = 0.f; win[k][1] = 0.f; win[k][2] = 0.f; win[k][3] = 0.f; }
            u32x2 vin[38];
#pragma unroll
            for (int r = 0; r < 38; ++r) {
                int pos = c * CHUNK + 32 * rq + r - 3; pos = pos < 0 ? 0 : (pos >= SEQ ? SEQ - 1 : pos);
                vin[r] = *(const u32x2*)(XBC + (size_t)(b * SEQ + pos) * CONV_CH + ch);
            }
            __builtin_amdgcn_sched_barrier(0);
#pragma unroll
            for (int r = 0; r < 38; ++r) {
                u32x2 v = vin[r];
                if (r < 3) { if (head_pad) v = (u32x2){0u, 0u}; }
                if (r >= 35) { if (tail_pad) v = (u32x2){0u, 0u}; }
#pragma unroll
                for (int k = 0; k < 6; ++k) { win[k][0] = win[k + 1][0]; win[k][1] = win[k + 1][1]; win[k][2] = win[k + 1][2]; win[k][3] = win[k + 1][3]; }
                win[6][0] = gm2::bflo(v.x); win[6][1] = gm2::bfhi(v.x); win[6][2] = gm2::bflo(v.y); win[6][3] = gm2::bfhi(v.y);
                if (r >= 6) {
                    const int i = 32 * rq + r - 6;
                    float o[4];
#pragma unroll
                    for (int e = 0; e < 4; ++e) { float a = bias[e];
#pragma unroll
                        for (int k = 0; k < 7; ++k) a += w[k][e] * win[k][e];
                        o[e] = gm2::silu_e(a); }
                    const unsigned p01 = cvtpk(o[0], o[1]), p23 = cvtpk(o[2], o[3]);
                    if (cl < 256) {
                        __attribute__((address_space(3))) unsigned short* d = (__attribute__((address_space(3))) unsigned short*)(lds + OFF_XT + cl * XT_P + i * 2);
                        d[0] = (unsigned short)p01; d[XT_P / 2] = (unsigned short)(p01 >> 16); d[XT_P] = (unsigned short)p23; d[3 * XT_P / 2] = (unsigned short)(p23 >> 16);
                    } else if (cl < 320) {
                        const int n = cl - 256;
                        *(__attribute__((address_space(3))) u32x2*)(lds + OFF_BS + i * BS_P + n * 2) = (u32x2){p01, p23};
                        __attribute__((address_space(3))) unsigned short* d = (__attribute__((address_space(3))) unsigned short*)(lds + OFF_BST + n * XT_P + i * 2);
                        d[0] = (unsigned short)p01; d[XT_P / 2] = (unsigned short)(p01 >> 16); d[XT_P] = (unsigned short)p23; d[3 * XT_P / 2] = (unsigned short)(p23 >> 16);
                    } else {
                        const int n = cl - 320;
                        *(__attribute__((address_space(3))) u32x2*)(lds + OFF_CS + i * BS_P + n * 2) = (u32x2){p01, p23};
                        *(u32x2*)(CC + (size_t)(t0 + i) * 128 + 64 * g + n) = (u32x2){p01, p23};
                    }
                }
            }
        } else {
            const int i = tid - 384;
            const f32x4 d0 = *(const f32x4*)(DT + (size_t)(t0 + i) * 16 + 4 * g), d1 = *(const f32x4*)(DT + (size_t)(t0 + i) * 16 + 8 + 4 * g);
#pragma unroll
            for (int hl = 0; hl < 4; ++hl) { *(__attribute__((address_space(3))) float*)(lds + F_DT0 + (hl * 128 + i) * 4) = d0[hl]; *(__attribute__((address_space(3))) float*)(lds + F_DT1 + (hl * 128 + i) * 4) = d1[hl]; }
        }
        __syncthreads();
        {
            const int hl = wid & 3, dir = wid >> 2, h = 4 * g + hl;
            const float a = -__expf(p.a_log[dir * 8 + h]);
            const int q0 = 2 * lane, q1 = 2 * lane + 1, i0 = dir ? 127 - q0 : q0, i1 = dir ? 127 - q1 : q1;
            const int fdt = dir ? F_DT1 : F_DT0;
            const float dt_0 = *(__attribute__((address_space(3))) const float*)(lds + fdt + (hl * 128 + i0) * 4), dt_1 = *(__attribute__((address_space(3))) const float*)(lds + fdt + (hl * 128 + i1) * 4);
            const float v0 = dt_0 * a, v1 = dt_1 * a, pr = v0 + v1;
            const float incl = wave_incl_scan(pr, lane), s0 = incl - pr + v0, s1 = incl;
            const float tot = __shfl(incl, 63);
            const int fs = dir ? F_SUF : F_CUM, fw = dir ? F_WB : F_WF;
            *(__attribute__((address_space(3))) float*)(lds + fs + (hl * 128 + i0) * 4) = s0; *(__attribute__((address_space(3))) float*)(lds + fs + (hl * 128 + i1) * 4) = s1;
            *(__attribute__((address_space(3))) float*)(lds + fw + (hl * 128 + i0) * 4) = __expf(tot - s0) * dt_0; *(__attribute__((address_space(3))) float*)(lds + fw + (hl * 128 + i1) * 4) = __expf(tot - s1) * dt_1;
            ACUM[(size_t)(t0 + i0) * 16 + dir * 8 + h] = s0; ACUM[(size_t)(t0 + i1) * 16 + dir * 8 + h] = s1;
        }
        __syncthreads();
        {
            const int it = wid & 3, hp = wid >> 2, i = it * 32 + r32;
            f32x16 Gt[4];
#pragma unroll
            for (int jt = 0; jt < 4; ++jt) {
                f32x16 acc = {0.f, 0.f, 0.f, 0.f, 0.f, 0.f, 0.f, 0.f, 0.f, 0.f, 0.f, 0.f, 0.f, 0.f, 0.f, 0.f};
#pragma unroll
                for (int ks = 0; ks < 4; ++ks) {
                    const bf16x8 af = *(Lbf8*)(lds + OFF_BS + (jt * 32 + r32) * BS_P + 32 * ks + 16 * hh);
                    const bf16x8 bfr = *(Lbf8*)(lds + OFF_CS + (it * 32 + r32) * BS_P + 32 * ks + 16 * hh);
                    acc = __builtin_amdgcn_mfma_f32_32x32x16_bf16(af, bfr, acc, 0, 0, 0);
                }
                Gt[jt] = acc;
            }
#pragma unroll
            for (int hs = 0; hs < 2; ++hs) {
                const int hl = 2 * hp + hs, h = 4 * g + hl;
                const float ci = *(__attribute__((address_space(3))) const float*)(lds + F_CUM + (hl * 128 + i) * 4), si = *(__attribute__((address_space(3))) const float*)(lds + F_SUF + (hl * 128 + i) * 4);
                f32x16 Y[2];
                Y[0] = (f32x16){0.f, 0.f, 0.f, 0.f, 0.f, 0.f, 0.f, 0.f, 0.f, 0.f, 0.f, 0.f, 0.f, 0.f, 0.f, 0.f}; Y[1] = Y[0];
#pragma unroll
                for (int jt = 0; jt < 4; ++jt) {
                    unsigned mt[8];
                    const int rel = jt < it ? 0 : (jt > it ? 1 : 2);
#pragma unroll
                    for (int q = 0; q < 4; ++q) {
                        const int jb = jt * 32 + 8 * q + 4 * hh;
                        float m[4];
                        if (rel == 0) {
                            const f32x4 cj = *(Lf4*)(lds + F_CUM + (hl * 128 + jb) * 4), d0 = *(Lf4*)(lds + F_DT0 + (hl * 128 + jb) * 4);
#pragma unroll
                            for (int e = 0; e < 4; ++e) m[e] = Gt[jt][4 * q + e] * (__expf(ci - cj[e]) * d0[e]);
                        } else if (rel == 1) {
                            const f32x4 sj = *(Lf4*)(lds + F_SUF + (hl * 128 + jb) * 4), d1 = *(Lf4*)(lds + F_DT1 + (hl * 128 + jb) * 4);
#pragma unroll
                            for (int e = 0; e < 4; ++e) m[e] = Gt[jt][4 * q + e] * (__expf(si - sj[e]) * d1[e]);
                        } else {
                            const f32x4 cj = *(Lf4*)(lds + F_CUM + (hl * 128 + jb) * 4), d0 = *(Lf4*)(lds + F_DT0 + (hl * 128 + jb) * 4);
                            const f32x4 sj = *(Lf4*)(lds + F_SUF + (hl * 128 + jb) * 4), d1 = *(Lf4*)(lds + F_DT1 + (hl * 128 + jb) * 4);
#pragma unroll
                            for (int e = 0; e < 4; ++e) {
                                const int dji = (8 * q + 4 * hh + e) - r32;
                                const float wf = __expf(fminf(ci - cj[e], 0.f)) * d0[e], wb = __expf(fminf(si - sj[e], 0.f)) * d1[e];
                                m[e] = Gt[jt][4 * q + e] * ((dji <= 0 ? wf : 0.f) + (dji >= 0 ? wb : 0.f));
                            }
                        }
                        mt[2 * q] = cvtpk(m[0], m[1]); mt[2 * q + 1] = cvtpk(m[2], m[3]);
                    }
#pragma unroll
                    for (int s = 0; s < 2; ++s) {
                        const bf16x8 mf = __builtin_bit_cast(bf16x8, (u32x4){mt[4 * s], mt[4 * s + 1], mt[4 * s + 2], mt[4 * s + 3]});
#pragma unroll
                        for (int pt = 0; pt < 2; ++pt) {
                            const LB* xa = lds + OFF_XT + (hl * 64 + pt * 32 + r32) * XT_P + (jt * 32 + 16 * s + 4 * hh) * 2;
                            const u32x2 lo = *(Lu2*)(xa), hi2 = *(Lu2*)(xa + 16);
                            const bf16x8 xf = __builtin_bit_cast(bf16x8, (u32x4){lo.x, lo.y, hi2.x, hi2.y});
                            Y[pt] = __builtin_amdgcn_mfma_f32_32x32x16_bf16(xf, mf, Y[pt], 0, 0, 0);
                        }
                    }
                }
                const float dsk = p.d_skip[h];
#pragma unroll
                for (int pt = 0; pt < 2; ++pt)
#pragma unroll
                    for (int qp = 0; qp < 2; ++qp) {
                        u32x2 g[2];
#pragma unroll
                        for (int qq = 0; qq < 2; ++qq) { const int q = 2 * qp + qq, p0 = pt * 32 + 8 * q + 4 * hh;
                            float y[4];
#pragma unroll
                            for (int e = 0; e < 4; ++e) { const float xv = bf2f(*(__attribute__((address_space(3))) const unsigned short*)(lds + OFF_XT + (hl * 64 + p0 + e) * XT_P + i * 2)); y[e] = Y[pt][4 * q + e] + dsk * xv; }
                            g[qq] = (u32x2){cvtpk(y[0], y[1]), cvtpk(y[2], y[3])}; }
                        auto r0 = __builtin_amdgcn_permlane32_swap(g[0].x, g[1].x, false, false); auto r1 = __builtin_amdgcn_permlane32_swap(g[0].y, g[1].y, false, false);
                        *(u32x4*)(YD + (size_t)(t0 + i) * 512 + h * 64 + pt * 32 + 16 * qp + 8 * hh) = (u32x4){(unsigned)r0[0], (unsigned)r1[0], (unsigned)r0[1], (unsigned)r1[1]};
                    }
            }
        }
        {
            const int hl = wid & 3, dir = wid >> 2, h = 4 * g + hl, fw = dir ? F_WB : F_WF;
            f32x16 S[2][2];
#pragma unroll
            for (int a = 0; a < 2; ++a)
#pragma unroll
                for (int bb = 0; bb < 2; ++bb) S[a][bb] = (f32x16){0.f, 0.f, 0.f, 0.f, 0.f, 0.f, 0.f, 0.f, 0.f, 0.f, 0.f, 0.f, 0.f, 0.f, 0.f, 0.f};
#pragma unroll 2
            for (int ks = 0; ks < 8; ++ks) {
                const f32x4 w0 = *(Lf4*)(lds + fw + (hl * 128 + 16 * ks + 8 * hh) * 4), w1 = *(Lf4*)(lds + fw + (hl * 128 + 16 * ks + 8 * hh + 4) * 4);
                bf16x8 bfr[2];
#pragma unroll
                for (int nt = 0; nt < 2; ++nt) bfr[nt] = *(Lbf8*)(lds + OFF_BST + (nt * 32 + r32) * XT_P + 32 * ks + 16 * hh);
#pragma unroll
                for (int pt = 0; pt < 2; ++pt) {
                    const u32x4 xr = *(__attribute__((address_space(3))) const u32x4*)(lds + OFF_XT + (hl * 64 + pt * 32 + r32) * XT_P + 32 * ks + 16 * hh);
                    const u32x4 xw = {cvtpk(gm2::bflo(xr.x) * w0[0], gm2::bfhi(xr.x) * w0[1]), cvtpk(gm2::bflo(xr.y) * w0[2], gm2::bfhi(xr.y) * w0[3]),
                                      cvtpk(gm2::bflo(xr.z) * w1[0], gm2::bfhi(xr.z) * w1[1]), cvtpk(gm2::bflo(xr.w) * w1[2], gm2::bfhi(xr.w) * w1[3])};
                    const bf16x8 af = __builtin_bit_cast(bf16x8, xw);
#pragma unroll
                    for (int nt = 0; nt < 2; ++nt) S[pt][nt] = __builtin_amdgcn_mfma_f32_32x32x16_bf16(bfr[nt], af, S[pt][nt], 0, 0, 0);
                }
            }
            bf16_t* dst = (bf16_t*)ST + ((((size_t)dir * BATCH + b) * NCHUNK + c) * 8 + h) * 4096;
#pragma unroll
            for (int pt = 0; pt < 2; ++pt)
#pragma unroll
                for (int nt = 0; nt < 2; ++nt)
#pragma unroll
                    for (int gp = 0; gp < 2; ++gp) { u32x2 g[2];
#pragma unroll
                        for (int gg = 0; gg < 2; ++gg) { const int b4 = 4 * (2 * gp + gg); g[gg] = (u32x2){cvtpk(S[pt][nt][b4], S[pt][nt][b4 + 1]), cvtpk(S[pt][nt][b4 + 2], S[pt][nt][b4 + 3])}; }
                        auto r0 = __builtin_amdgcn_permlane32_swap(g[0].x, g[1].x, false, false); auto r1 = __builtin_amdgcn_permlane32_swap(g[0].y, g[1].y, false, false);
                        *(u32x4*)(dst + (pt * 32 + r32) * 64 + nt * 32 + 16 * gp + 8 * hh) = (u32x4){(unsigned)r0[0], (unsigned)r1[0], (unsigned)r0[1], (unsigned)r1[1]}; }
        }
    }
}

constexpr int VT_P = 1040;
constexpr int OFF_VT = 0, OFF_SS = 128 * VT_P, OFF_EF = OFF_SS + 8 * 128 * 4, FIN_END = OFF_EF + 2 * 8 * 128 * 4;
static_assert(FIN_END <= 147456 - 256, "ssd final LDS");
__device__ __forceinline__ void final_phase(const Params& p, LB* lds_) {
    LB* const lds = (LB*)(size_t)0; (void)lds_;
    const int tid = tid_opaque(), lane = tid & 63, h = __builtin_amdgcn_readfirstlane(tid >> 6), r32 = lane & 31, hh = lane >> 5, g = h >> 2;
    const bf16_t* YD = (const bf16_t*)(p.ws + WS_YD); const bf16_t* CC = (const bf16_t*)(p.ws + WS_CC); const float* ACUM = (const float*)(p.ws + WS_ACUM); const float* ST = (const float*)(p.ws + WS_ST);
    const bf16_t* Z = (const bf16_t*)(p.ws + WS_Z); bf16_t* SSD = (bf16_t*)(p.ws + WS_SSD);
    typedef __attribute__((address_space(3))) float LF;
    for (int item = blockIdx.x; item < BATCH * NCHUNK; item += gridDim.x) {
        const int c = item % NCHUNK, b = item / NCHUNK, t0 = b * SEQ + c * CHUNK;
        __syncthreads();
#pragma unroll
        for (int q = 0; q < 2; ++q) { const int i = lane + 64 * q;
            *(LF*)(lds + OFF_EF + ((0 * 8 + h) * 128 + i) * 4) = __expf(ACUM[(size_t)(t0 + i) * 16 + h]);
            *(LF*)(lds + OFF_EF + ((1 * 8 + h) * 128 + i) * 4) = __expf(ACUM[(size_t)(t0 + i) * 16 + 8 + h]); }
        bf16x8 cf[2][2][4];
#pragma unroll
        for (int dir = 0; dir < 2; ++dir) { const bf16_t* cs = (const bf16_t*)ST + ((((size_t)dir * BATCH + b) * NCHUNK + c) * 8 + h) * 4096;
#pragma unroll
            for (int pt = 0; pt < 2; ++pt)
#pragma unroll
                for (int ks = 0; ks < 4; ++ks) cf[dir][pt][ks] = *(const bf16x8*)(cs + (pt * 32 + r32) * 64 + 16 * ks + 8 * hh); }
        asm volatile("s_waitcnt lgkmcnt(0)" ::: "memory");
#pragma unroll 1
        for (int it = 0; it < 4; ++it) {
            f32x16 A[2][2];
#pragma unroll
            for (int dir = 0; dir < 2; ++dir)
#pragma unroll
                for (int pt = 0; pt < 2; ++pt) A[dir][pt] = (f32x16){0.f, 0.f, 0.f, 0.f, 0.f, 0.f, 0.f, 0.f, 0.f, 0.f, 0.f, 0.f, 0.f, 0.f, 0.f, 0.f};
            bf16x8 afr[4]; unsigned short ydv[16][2], zv[16][2];
#pragma unroll
            for (int ks = 0; ks < 4; ++ks) afr[ks] = *(const bf16x8*)(CC + (size_t)(t0 + it * 32 + r32) * 128 + g * 64 + 16 * ks + 8 * hh);
#pragma unroll
            for (int rg = 0; rg < 16; ++rg) { const size_t t = (size_t)(t0 + it * 32 + (rg & 3) + 8 * (rg >> 2) + 4 * hh);
#pragma unroll
                for (int pt = 0; pt < 2; ++pt) { const int col = h * 64 + pt * 32 + r32; ydv[rg][pt] = YD[t * 512 + col]; zv[rg][pt] = Z[t * 512 + col]; } }
            __builtin_amdgcn_sched_barrier(0);
#pragma unroll
            for (int ks = 0; ks < 4; ++ks) {
#pragma unroll
                for (int dir = 0; dir < 2; ++dir)
#pragma unroll
                    for (int pt = 0; pt < 2; ++pt) A[dir][pt] = __builtin_amdgcn_mfma_f32_32x32x16_bf16(afr[ks], cf[dir][pt][ks], A[dir][pt], 0, 0, 0); }
#pragma unroll
            for (int rg = 0; rg < 16; ++rg) {
                const int i = it * 32 + (rg & 3) + 8 * (rg >> 2) + 4 * hh;
                const float ef = *(LF*)(lds + OFF_EF + ((0 * 8 + h) * 128 + i) * 4), eb = *(LF*)(lds + OFF_EF + ((1 * 8 + h) * 128 + i) * 4);
                float ss = 0.f;
#pragma unroll
                for (int pt = 0; pt < 2; ++pt) { const int col = h * 64 + pt * 32 + r32;
                    const float y = (bf2f(ydv[rg][pt]) + A[0][pt][rg] * ef + A[1][pt][rg] * eb) * bf2f(zv[rg][pt]);
                    ss += y * y;
                    *(__attribute__((address_space(3))) unsigned short*)(lds + OFF_VT + i * VT_P + col * 2) = (unsigned short)f2bf(y); }
                ss = half32_sum(ss);
                if (r32 == 0) *(LF*)(lds + OFF_SS + (h * 128 + i) * 4) = ss;
            }
        }
        __syncthreads();
        const f32x4 w0 = *(const f32x4*)(p.ssd_norm_w + lane * 8), w1 = *(const f32x4*)(p.ssd_norm_w + lane * 8 + 4);
#pragma unroll 4
        for (int q = 0; q < 16; ++q) {
            const int i = h * 16 + q;
            float tot = 0.f;
#pragma unroll
            for (int k = 0; k < 8; ++k) tot += *(LF*)(lds + OFF_SS + (k * 128 + i) * 4);
            const float rstd = 1.f / sqrtf(tot * (1.f / 512.f) + EPS);
            const u32x4 v = *(__attribute__((address_space(3))) const u32x4*)(lds + OFF_VT + i * VT_P + lane * 16);
            u32x4 o; o.x = cvtpk(gm2::bflo(v.x) * rstd * w0[0], gm2::bfhi(v.x) * rstd * w0[1]); o.y = cvtpk(gm2::bflo(v.y) * rstd * w0[2], gm2::bfhi(v.y) * rstd * w0[3]);
            o.z = cvtpk(gm2::bflo(v.z) * rstd * w1[0], gm2::bfhi(v.z) * rstd * w1[1]); o.w = cvtpk(gm2::bflo(v.w) * rstd * w1[2], gm2::bfhi(v.w) * rstd * w1[3]);
            *(u32x4*)(SSD + (size_t)(t0 + i) * 512 + lane * 8) = o;
        }
    }
}
}
#ifndef NAIVE_SSDC
#define NAIVE_SSDC 0
#endif
#ifndef NAIVE_SSDF
#define NAIVE_SSDF 0
#endif
#ifndef NAIVE_P1
#define NAIVE_P1 0
#endif
#ifndef NAIVE_P4B
#define NAIVE_P4B 0
#endif
#ifndef NAIVE_P4C
#define NAIVE_P4C 0
#endif
#ifndef NAIVE_P6
#define NAIVE_P6 0
#endif
#ifndef NAIVE_P7
#define NAIVE_P7 0
#endif
__device__ __forceinline__ int vcu_of() { const int G = gridDim.x, bx = blockIdx.x; return (G % 8 == 0) ? (bx % 8) * (G / 8) + bx / 8 : bx; }
#if USE_PG8
#define GNS pg8
#define GEMM_CALL(EPI, SCHED, K, RX) pg8::gemm_phase<pg8::EPI, pg8::SCHED, true, true, RX>(lds3, K, S, E)
#else
#define GNS gm2
#define GEMM_CALL(EPI, SCHED, K, RX) gm2::gemm_phase<gm2::EPI, gm2::SCHED>(lds3, K, S, E)
#endif
__device__ __forceinline__ void phase_p1_pg8(const Params& p, PG8_LAS unsigned char* lds3) {
#if USE_PG8
    pg8::SchedProj S; S.so.init(T, 4096, gridDim.x, blockIdx.x); S.A = (const char*)wsp<bf16_t>(p, WS_H); S.B = (const char*)wsp<bf16_t>(p, WS_WIN); S.tstep = (size_t)256 * DM * 2;
#else
    gm2::SchedProj S{vcu_of(), (int)gridDim.x, (const char*)wsp<bf16_t>(p, WS_H), (const char*)wsp<bf16_t>(p, WS_WIN), (size_t)256 * DM * 2};
#endif
#if USE_PG8
    pg8::EpiInProj E{wsp<bf16_t>(p, WS_QO), wsp<bf16_t>(p, WS_K), wsp<bf16_t>(p, WS_V), wsp<bf16_t>(p, WS_Z), wsp<bf16_t>(p, WS_XBC), wsp<bf16_t>(p, WS_G), wsp<float>(p, WS_DT), p.b_gate, p.dt_bias};
#else
    gm2::EpiInProj E{p.ws, p.b_gate};
#endif
    GEMM_CALL(EpiInProj, SchedProj, DM, RELAX_P1);
}
__device__ __forceinline__ void phase_merged_pg8(const Params& p, PG8_LAS unsigned char* lds3) {
#if USE_PG8
    pg8::SchedMerged2 S{vcu_of(), (int)gridDim.x, (const char*)wsp<bf16_t>(p, WS_QO), (const char*)wsp<bf16_t>(p, WS_SSD), (const char*)wsp<bf16_t>(p, WS_WA), (const char*)wsp<bf16_t>(p, WS_WS), (size_t)256 * 512 * 2};
    pg8::EpiMerged2 E{(const unsigned char*)(p.ws + WS_G), wsp<bf16_t>(p, WS_MERGED)};
    pg8::gemm_phase2<pg8::EpiMerged2, pg8::SchedMerged2, true, true, false, RELAX_MERGED>(lds3, 512, 512, 16, S, E);
#else
    GNS::SchedMerged S{vcu_of(), (int)gridDim.x, (const char*)wsp<bf16_t>(p, WS_SSD), (const char*)wsp<bf16_t>(p, WS_QO), (const char*)wsp<bf16_t>(p, WS_WS), (const char*)wsp<bf16_t>(p, WS_WA), (size_t)256 * 512 * 2};
    GNS::EpiMerged E{wsp<bf16_t>(p, WS_G), wsp<bf16_t>(p, WS_MERGED)};
    GEMM_CALL(EpiMerged, SchedMerged, 512, false);
#endif
}
__device__ __forceinline__ void phase_wout_pg8(const Params& p, PG8_LAS unsigned char* lds3) {
    GNS::SchedWout S{vcu_of(), (int)gridDim.x, (const char*)wsp<bf16_t>(p, WS_MERGED), (const char*)wsp<bf16_t>(p, WS_WO), (size_t)256 * DM * 2};
#if USE_PG8
    pg8::EpiWout E{p.x, wsp<bf16_t>(p, WS_X1B)};
#else
    gm2::EpiWout E{p.x, p.out};
#endif
    GEMM_CALL(EpiWout, SchedWout, DM, RELAX_WOUT);
}
__device__ __forceinline__ void phase_moe1_pg8(const Params& p, PG8_LAS unsigned char* lds3) {
    const int* tbk = (const int*)(p.ws + WS_ROUTE + RT_TB);
#if USE_PG8 && FUSE_GATHER
    pg8::SchedMoe1g S{vcu_of(), (int)gridDim.x, __builtin_amdgcn_readfirstlane(tbk[TS / 256]), tbk, (const int*)(p.ws + WS_ROUTE + RT_PERM), (const char*)wsp<bf16_t>(p, WS_X1B), (const char*)wsp<bf16_t>(p, WS_W13), 0, 0, 0, 0, 0}; S.preload();
    pg8::EpiMoe1 E{wsp<bf16_t>(p, WS_HID), (const float*)(p.ws + WS_ROUTE + RT_SWA), (const float*)(p.ws + WS_ROUTE + RT_SWB), (const float*)(p.ws + WS_ROUTE + RT_SRS)};
    pg8::gemm_phase2<pg8::EpiMoe1, pg8::SchedMoe1g, true, true, true, RELAX_MOE1>(lds3, DM, DM, 16, S, E);
#else
    GNS::SchedMoe1 S{vcu_of(), (int)gridDim.x, __builtin_amdgcn_readfirstlane(tbk[TS / 256]), tbk, (const char*)wsp<bf16_t>(p, WS_XS), (const char*)wsp<bf16_t>(p, WS_W13), (size_t)256 * DM * 2};
    GNS::EpiMoe1 E{wsp<bf16_t>(p, WS_HID), (const float*)(p.ws + WS_ROUTE + RT_SWA), (const float*)(p.ws + WS_ROUTE + RT_SWB)};
    GEMM_CALL(EpiMoe1, SchedMoe1, DM, false);
#endif
}
__device__ __forceinline__ void phase_moe2_pg8(const Params& p, PG8_LAS unsigned char* lds3) {
    const int* tbk = (const int*)(p.ws + WS_ROUTE + RT_TB);
#if USE_PG8
    pg8::SchedMoe2b S{vcu_of(), (int)gridDim.x, __builtin_amdgcn_readfirstlane(tbk[TS / 256]), tbk, (const char*)wsp<bf16_t>(p, WS_HID), (const char*)wsp<bf16_t>(p, WS_W2P), (size_t)256 * 1024 * 2, 0, 0, 0, 0}; S.preload();
    pg8::EpiMoe2 E{p.out, (const int*)(p.ws + WS_ROUTE + RT_PERM), wsp<bf16_t>(p, WS_X1B)};
    pg8::gemm_phase2<pg8::EpiMoe2, pg8::SchedMoe2b, true, true, false, RELAX_MOE2>(lds3, 1024, 512, 16, S, E);
#else
    GNS::SchedMoe2 S{vcu_of(), (int)gridDim.x, __builtin_amdgcn_readfirstlane(tbk[TS / 256]), tbk, (const char*)wsp<bf16_t>(p, WS_HID), (const char*)wsp<bf16_t>(p, WS_W2P), (size_t)256 * 1024 * 2};
    GNS::EpiMoe2 E{p.out, (const int*)(p.ws + WS_ROUTE + RT_PERM)};
    GEMM_CALL(EpiMoe2, SchedMoe2, 1024, false);
#endif
}

__device__ __forceinline__ void phase_tr_w13(const Params& p, unsigned char* lds) {
    const int tid = tid_opaque(), lane = tid & 63, wave = tid >> 6;
    phase_tr_range(p, (float*)lds + wave * (64 * 33), lane, TR_EARLY, TR_W2, (int)blockIdx.x * 8 + wave, (int)gridDim.x * 8);
    __syncthreads();
}
__device__ __forceinline__ void phase_tr_w2(const Params& p, unsigned char* lds) {
    const int tid = tid_opaque(), lane = tid & 63, wave = tid >> 6;
    const int* tbk = (const int*)(p.ws + WS_ROUTE + RT_TB);
    const int G = (int)gridDim.x, ntile = __builtin_amdgcn_readfirstlane(tbk[TS / 256]), rot = (ntile * 8) % G, vcu = vcu_of();
    if (vcu >= rot) phase_tr_range(p, (float*)lds + wave * (64 * 33), lane, TR_W2, TR_TOTAL, (vcu - rot) * 8 + wave, (G - rot) * 8);
}
constexpr int LDS_BYTES = 147456;
__global__ void __launch_bounds__(512, 2) k_mega(Params p) {
    extern __shared__ __attribute__((aligned(16))) unsigned char lds[];
    PG8_LAS unsigned char* lds3 = (PG8_LAS unsigned char*)lds;
    volatile LAS unsigned* MISC = (volatile LAS unsigned*)(lds3 + MISC_OFF);
    if (threadIdx.x < 64) MISC[threadIdx.x] = 0u;
    __syncthreads();
    XcdBarrier bar = xcd_barrier_post((unsigned*)(p.ws + WS_CTL) + CW_BAR, MISC + 8);
#define GRID_BAR() xcd_barrier(bar)
    phase_p0(p, lds); GRID_BAR();
#if NAIVE_P1
    phase_p1(p);
#else
    phase_p1_pg8(p, lds3); phase_dt(p);
#endif
    GRID_BAR();
    phase_rope(p);
#if NAIVE_SSDC
    phase_ssd_chunk_naive(p, lds);
#else
    ssd::chunk_phase(p, (ssd::LB*)lds);
#endif
    GRID_BAR();
    phase_scan(p);
#if NAIVE_ATTN
    phase_attn_naive(p);
#else
    phase_attn(p, lds);
#endif
    GRID_BAR();
#if NAIVE_SSDF
    phase_ssd_final_naive(p, lds);
#else
    ssd::final_phase(p, (ssd::LB*)lds);
#endif
    GRID_BAR();
#if NAIVE_P4B
    phase_merged_naive(p);
#else
    phase_merged_pg8(p, lds3);
#endif
    GRID_BAR();
#if NAIVE_P4C
    phase_wout_naive(p);
#else
    phase_wout_pg8(p, lds3);
#endif
    GRID_BAR();
    phase_route(p, lds); GRID_BAR();
    phase_gather(p, lds); GRID_BAR();
#if NAIVE_P6
    phase_moe1_naive(p);
#else
    phase_moe1_pg8(p, lds3);
#endif
    phase_tr_w2(p, lds);
    GRID_BAR();
#if NAIVE_P7
    phase_moe2_naive(p);
#else
    phase_moe2_pg8(p, lds3);
#endif
}

extern "C" void kernel_launch(void* const* d_in, const int* in_sizes, int n_in, void* d_out, int out_size, void* d_ws, size_t ws_size, hipStream_t stream) {
    if (n_in != 23 || out_size != T * DM || ws_size < WS_END) { fprintf(stderr, "kernel_launch: unexpected shapes (n_in %d out %d ws %zu need %zu)\n", n_in, out_size, ws_size, (size_t)WS_END); return; }
    Params p{};
    const float** f = (const float**)&p;
    for (int i = 0; i < 23; ++i) f[i] = (const float*)d_in[i];
    p.out = (float*)d_out; p.ws = (unsigned char*)d_ws;
    static int grid_blocks = 0;
    if (!grid_blocks) {
        int dev = 0, cus = 0, per_cu = 0;
        (void)hipGetDevice(&dev); (void)hipDeviceGetAttribute(&cus, hipDeviceAttributeMultiprocessorCount, dev);
        (void)hipFuncSetAttribute((const void*)k_mega, hipFuncAttributeMaxDynamicSharedMemorySize, LDS_BYTES);
        (void)hipOccupancyMaxActiveBlocksPerMultiprocessor(&per_cu, (const void*)k_mega, 512, LDS_BYTES);
        if (per_cu < 1) { fprintf(stderr, "kernel_launch: occupancy query says %d blocks/CU\n", per_cu); per_cu = 1; }
        grid_blocks = cus * 1;
        fprintf(stderr, "kernel_launch: cus %d per_cu %d grid %d\n", cus, per_cu, grid_blocks);
    }
    (void)hipMemsetAsync((char*)d_ws + WS_CTL, 0, 1 * MiB, stream);
    void* args[] = {&p};
    hipError_t e = hipLaunchCooperativeKernel((const void*)k_mega, dim3(grid_blocks), dim3(512), args, LDS_BYTES, stream);
    if (e != hipSuccess) fprintf(stderr, "cooperative launch failed: %s (grid %d)\n", hipGetErrorString(e), grid_blocks);
}
```

```cpp
#include <hip/hip_runtime.h>
#include <hip/hip_cooperative_groups.h>
#include <cstdio>
#include <cstdint>
namespace cg = cooperative_groups;

#ifndef ONE_LAUNCH
#define ONE_LAUNCH 0
#endif

__device__ __forceinline__ int tid_opaque() { int t = threadIdx.x; asm volatile("" : "+v"(t)); return t; }
#ifndef USE_PG8
#define USE_PG8 1
#endif
#ifndef MOE2_SPLIT_TAIL
#define MOE2_SPLIT_TAIL 1
#endif
#ifndef BARRIER_WORK
#define BARRIER_WORK 1
#endif
#ifndef FUSE_GATHER
#define FUSE_GATHER 1
#endif
typedef unsigned short bf16_t;
typedef short bf16x8 __attribute__((ext_vector_type(8)));
typedef float f32x4 __attribute__((ext_vector_type(4)));
typedef float f32x16 __attribute__((ext_vector_type(16)));
typedef unsigned u32x4 __attribute__((ext_vector_type(4)));
typedef unsigned u32x2 __attribute__((ext_vector_type(2)));

constexpr int BATCH = 8, SEQ = 4096, DM = 1024, T = BATCH * SEQ;
constexpr int NQH = 8, NKVH = 2, HD = 64, ATTN_W = 512, KV_W = 128;
constexpr int SSD_W = 512, SSD_H = 8, SSD_G = 2, DSTATE = 64, DCONV = 7, CONV_CH = 768, CHUNK = 128, NCHUNK = SEQ / CHUNK;
constexpr int IN_PROJ = 4112, NPROJ = 4352;
constexpr int NE = 16, NG = 4, EPG = 4, DE = 512;
constexpr int NBUCKET = 24;
constexpr int TS = T + NBUCKET * 256;
constexpr int NRT = T / 128;
constexpr float EPS = 1e-6f;
constexpr float C2 = 0.125f * 1.4426950408889634f;

constexpr size_t MiB = 1u << 20;
constexpr size_t al(size_t x) { return (x + 255) & ~(size_t)255; }
constexpr size_t WS_CTL = 0;
constexpr size_t WS_WIN = 1 * MiB;
constexpr size_t WS_WA = WS_WIN + al((size_t)NPROJ * DM * 2);
constexpr size_t WS_WS = WS_WA + al((size_t)DM * 512 * 2);
constexpr size_t WS_WO = WS_WS + al((size_t)DM * 512 * 2);
constexpr size_t WS_W13 = WS_WO + al((size_t)DM * DM * 2);
constexpr size_t WS_W2P = WS_W13 + al((size_t)NE * 1024 * DM * 2);
constexpr size_t WS_H = WS_W2P + al((size_t)NBUCKET * DM * 1024 * 2);
constexpr size_t WS_YD = WS_H;
constexpr size_t WS_CC = WS_H + (size_t)T * 512 * 2;
constexpr size_t WS_QO = WS_H + al((size_t)T * DM * 2);
constexpr size_t WS_XBC = WS_QO + al((size_t)T * 512 * 2);
constexpr size_t WS_SSD = WS_XBC;
constexpr size_t WS_K = WS_XBC + al((size_t)T * 768 * 2);
constexpr size_t WS_V = WS_K + al((size_t)T * 128 * 2);
constexpr size_t WS_Z = WS_V + al((size_t)T * 128 * 2);
constexpr size_t WS_G = WS_Z + al((size_t)T * 512 * 2);
constexpr size_t WS_HID = WS_G;
constexpr size_t WS_X1B = WS_QO;
constexpr size_t WS_DT = WS_G + al((size_t)T * 2048 * 2);
constexpr size_t WS_ACUM = WS_DT + al((size_t)T * 16 * 4);
constexpr size_t WS_ROUTE = WS_ACUM + al((size_t)T * 16 * 4);
constexpr size_t WS_ST = WS_ROUTE + 2 * MiB;
constexpr size_t WS_MERGED = WS_ST;
constexpr size_t WS_XS = WS_ST;
constexpr size_t WS_END = WS_ST + al((size_t)TS * DM * 2);
static_assert((size_t)2 * BATCH * NCHUNK * 8 * 64 * 64 * 4 <= (size_t)TS * DM * 2, "ST fits in the XS region");
static_assert(WS_END <= (size_t)512 * MiB, "workspace map exceeds 512 MiB");
static_assert(WS_X1B + (size_t)T * DM * 2 <= WS_G, "x1 (bf16) overlay");
constexpr size_t RT_BUCKET = 0;
constexpr size_t RT_RANK = RT_BUCKET + (size_t)T * 4;
constexpr size_t RT_WA = RT_RANK + (size_t)T * 4;
constexpr size_t RT_WB = RT_WA + (size_t)T * 4;
constexpr size_t RT_CNT = RT_WB + (size_t)T * 4;
constexpr size_t RT_PERM = RT_CNT + al((size_t)NRT * NBUCKET * 4);
constexpr size_t RT_TB = RT_PERM + al((size_t)TS * 4);
constexpr size_t RT_SWA = RT_TB + 1024;
constexpr size_t RT_SWB = RT_SWA + al((size_t)TS * 4);
constexpr size_t RT_WRT = RT_SWB + al((size_t)TS * 4);
constexpr size_t RT_RSTD = RT_WRT + al((size_t)32 * DM * 2);
constexpr size_t RT_SRS = RT_RSTD + al((size_t)T * 4);
static_assert(RT_SRS + al((size_t)TS * 4) <= 2 * MiB, "routing records");
static_assert(RT_WRT + 65536 <= 2 * MiB, "routing records");

struct Params {
    const float *x, *norm_mix_w, *w_in, *b_gate, *q_norm_w, *k_norm_w, *w_attn_o, *conv_w, *conv_b, *dt_bias, *a_log, *d_skip, *ssd_norm_w, *w_ssd_o, *w_out,
        *norm_ffn_w, *w_rg, *b_rg, *w_re, *b_re, *w1, *w3, *w2;
    float* out; unsigned char* ws;
};

__device__ __forceinline__ unsigned f2bf(float f) { unsigned u = __builtin_bit_cast(unsigned, f); return (u + 0x7fffu + ((u >> 16) & 1u)) >> 16; }
__device__ __forceinline__ float bf2f(unsigned short b) { return __builtin_bit_cast(float, (unsigned)b << 16); }
__device__ __forceinline__ unsigned pk2(float lo, float hi) { return f2bf(lo) | (f2bf(hi) << 16); }
template <int CTRL> __device__ __forceinline__ float dpp_f(float v) { return __builtin_bit_cast(float, __builtin_amdgcn_update_dpp(0, __builtin_bit_cast(int, v), CTRL, 0xf, 0xf, false)); }
__device__ __forceinline__ float row16_sum(float v) { v += dpp_f<0x121>(v); v += dpp_f<0x122>(v); v += dpp_f<0x124>(v); v += dpp_f<0x128>(v); return v; }
__device__ __forceinline__ float half32_sum(float v) { v = row16_sum(v); const unsigned u = __builtin_bit_cast(unsigned, v);
    auto rr = __builtin_amdgcn_permlane16_swap(u, u, false, false); return __builtin_bit_cast(float, (unsigned)rr[0]) + __builtin_bit_cast(float, (unsigned)rr[1]); }
__device__ __forceinline__ float wave_sum(float v) { v = half32_sum(v); const unsigned u = __builtin_bit_cast(unsigned, v);
    auto rr = __builtin_amdgcn_permlane32_swap(u, u, false, false); return __builtin_bit_cast(float, (unsigned)rr[0]) + __builtin_bit_cast(float, (unsigned)rr[1]); }
__device__ __forceinline__ float silu_f(float v) { return v / (1.f + __expf(-v)); }
__device__ __forceinline__ float sigmoid_f(float v) { return 1.f / (1.f + __expf(-v)); }
__device__ __forceinline__ float softplus_f(float v) { return v > 20.f ? v : log1pf(__expf(v)); }

template <class T_> __device__ __forceinline__ T_* wsp(const Params& p, size_t off) { return (T_*)(p.ws + off); }

namespace gm2 {
#define PG8_LAS __attribute__((address_space(3)))
constexpr int BM = 256, BK = 64, TILE_B = BM * BK * 2, STAGE_B = 2 * TILE_B, LDS_NEED = 2 * STAGE_B;
__device__ __forceinline__ int lds_byte(int r, int c) { const int st = (r >> 4) * 2 + (c >> 5), ob = (r & 15) * 64 + (c & 31) * 2; return st * 1024 + (ob ^ (((ob >> 9) & 1) << 5)); }
__device__ __forceinline__ void stage_rc(int b, int& R, int& C) { const int st = b >> 10, sb = b & 1023, swz = sb ^ (((sb >> 9) & 1) << 5); R = (st >> 1) * 16 + swz / 64; C = (st & 1) * 32 + (swz % 64) / 2; }
__device__ __forceinline__ int perm32(int rho) { const int n = rho >> 4, i = rho & 15; return 8 * (i >> 2) + 4 * n + (i & 3); }
struct Unit { int pm, pn, aux; };
typedef float f32x2_t __attribute__((ext_vector_type(2))); typedef __bf16 bf16x2_t __attribute__((ext_vector_type(2)));
__device__ __forceinline__ unsigned cvt_pk_bf16(float lo, float hi) { f32x2_t v = {lo, hi}; bf16x2_t b = __builtin_convertvector(v, bf16x2_t); return __builtin_bit_cast(unsigned, b); }

template <class Epi, class Sched>
__device__ __forceinline__ void gemm_phase(PG8_LAS unsigned char* lds, const int K, const Sched& S, const Epi& E) {
    int tid_ = threadIdx.x; asm volatile("" : "+v"(tid_));
    const int tid = tid_, wid = __builtin_amdgcn_readfirstlane(tid >> 6), lane = tid & 63, wr = wid >> 2, wc = wid & 3, fr = lane & 15, fq = lane >> 4;
    const int nt = K / BK;
    unsigned voffA[4], voffB[4];
#pragma unroll
    for (int i = 0; i < 4; ++i) { int R, C; stage_rc(tid * 16 + i * 8192, R, C); const int Rb = Epi::PERM ? ((R & ~31) + perm32(R & 31)) : R;
        voffA[i] = (unsigned)(R * K + C) * 2u; voffB[i] = (unsigned)(Rb * K + C) * 2u; }
    const unsigned ldsw = (unsigned)wid * 1024u;
    const int aoff = lds_byte(wr * 128 + fr, fq * 8), boff = lds_byte(wc * 64 + fr, fq * 8);
#ifndef GM2_REGSTAGE
#define GM2_REGSTAGE 0
#endif
#if GM2_REGSTAGE
#define GM2_STAGE(buf, abase, bbase, kt) do { _Pragma("unroll") for (int _i = 0; _i < 4; ++_i) { \
        const u32x4 va_ = *(const u32x4*)((abase) + (size_t)(kt) * (BK * 2) + voffA[_i]); const u32x4 vb_ = *(const u32x4*)((bbase) + (size_t)(kt) * (BK * 2) + voffB[_i]); \
        *(PG8_LAS u32x4*)(lds + (buf) * STAGE_B + ldsw + _i * 8192 + lane * 16) = va_; *(PG8_LAS u32x4*)(lds + (buf) * STAGE_B + TILE_B + ldsw + _i * 8192 + lane * 16) = vb_; } } while (0)
#else
#define GM2_STAGE(buf, abase, bbase, kt) do { _Pragma("unroll") for (int _i = 0; _i < 4; ++_i) { \
        __builtin_amdgcn_global_load_lds((const unsigned*)((abase) + (size_t)(kt) * (BK * 2) + voffA[_i]), (PG8_LAS unsigned*)(lds + (buf) * STAGE_B + ldsw + _i * 8192), 16, 0, 0); \
        __builtin_amdgcn_global_load_lds((const unsigned*)((bbase) + (size_t)(kt) * (BK * 2) + voffB[_i]), (PG8_LAS unsigned*)(lds + (buf) * STAGE_B + TILE_B + ldsw + _i * 8192), 16, 0, 0); } } while (0)
#endif
#define GM2_WAIT_V0() asm volatile("s_waitcnt vmcnt(0)" ::: "memory")
    Unit cur, nxt;
    if (!S.next(0, cur)) return;
    const char* cA = S.abase(cur); const char* cB = S.bbase(cur);
    GM2_STAGE(0, cA, cB, 0); GM2_WAIT_V0(); __syncthreads();
    for (int ui = 0;; ++ui) {
        const bool has_next = S.next(ui + 1, nxt);
        const char* nA = has_next ? S.abase(nxt) : cA; const char* nB = has_next ? S.bbase(nxt) : cB;
        f32x4 acc[8][4];
#pragma unroll
        for (int m = 0; m < 8; ++m)
#pragma unroll
            for (int n = 0; n < 4; ++n) acc[m][n] = (f32x4){0.f, 0.f, 0.f, 0.f};
        for (int t = 0; t < nt; ++t) {
            const int cb = t & 1;
            if (t + 1 < nt) { GM2_STAGE(cb ^ 1, cA, cB, t + 1); }
            else if (has_next) { GM2_STAGE(cb ^ 1, nA, nB, 0); }
#pragma unroll
            for (int ks = 0; ks < 2; ++ks) {
                bf16x8 At[8], Bf[4];
#pragma unroll
                for (int n = 0; n < 4; ++n) Bf[n] = *(const PG8_LAS bf16x8*)(lds + cb * STAGE_B + TILE_B + boff + n * 2048 + ks * 1024);
#pragma unroll
                for (int m = 0; m < 8; ++m) At[m] = *(const PG8_LAS bf16x8*)(lds + cb * STAGE_B + aoff + m * 2048 + ks * 1024);
#pragma unroll
                for (int m = 0; m < 8; ++m)
#pragma unroll
                    for (int n = 0; n < 4; ++n) acc[m][n] = __builtin_amdgcn_mfma_f32_16x16x32_bf16(Bf[n], At[m], acc[m][n], 0, 0, 0);
                __builtin_amdgcn_sched_group_barrier(0x100, 6, 0);
#pragma unroll
                for (int m = 0; m < 6; ++m) { __builtin_amdgcn_sched_group_barrier(0x008, 4, 0); __builtin_amdgcn_sched_group_barrier(0x100, 1, 0); }
                __builtin_amdgcn_sched_group_barrier(0x008, 8, 0);
                __builtin_amdgcn_sched_barrier(0);
            }
            GM2_WAIT_V0(); __syncthreads();
        }
        { int fr2 = fr, fq2 = fq; asm volatile("" : "+v"(fr2), "+v"(fq2)); E(acc, cur, wr, wc, fr2, fq2); }
        if (!has_next) break;
        cur = nxt; cA = nA; cB = nB;
    }
#undef GM2_STAGE
#undef GM2_WAIT_V0
}

struct SchedProj {
    int vcu, G; const char* A; const char* B; size_t tstep;
    __device__ __forceinline__ bool next(int i, Unit& u) const { const int uid = vcu + i * G; if (uid >= 128 * 16) return false; u.pm = uid >> 4; u.pn = uid & 15; u.aux = 0; return true; }
    __device__ __forceinline__ const char* abase(const Unit& u) const { return A + (size_t)u.pm * tstep; }
    __device__ __forceinline__ const char* bbase(const Unit& u) const { return B + (size_t)u.pn * tstep; }
};
struct SchedMerged {
    int vcu, G; const char *A0, *A1, *B0, *B1; size_t tstep;
    __device__ __forceinline__ bool next(int i, Unit& u) const { const int tile = vcu + (i >> 1) * G; if (tile >= 512) return false; u.pm = tile >> 2; u.pn = tile & 3; u.aux = i & 1; return true; }
    __device__ __forceinline__ const char* abase(const Unit& u) const { return (u.aux ? A1 : A0) + (size_t)u.pm * tstep; }
    __device__ __forceinline__ const char* bbase(const Unit& u) const { return (u.aux ? B1 : B0) + (size_t)u.pn * tstep; }
};
struct SchedWout {
    int vcu, G; const char *A, *B; size_t tstep;
    __device__ __forceinline__ bool next(int i, Unit& u) const { const int tile = vcu + i * G; if (tile >= 512) return false; u.pm = tile >> 2; u.pn = tile & 3; u.aux = 0; return true; }
    __device__ __forceinline__ const char* abase(const Unit& u) const { return A + (size_t)u.pm * tstep; }
    __device__ __forceinline__ const char* bbase(const Unit& u) const { return B + (size_t)u.pn * tstep; }
};
__device__ __forceinline__ void pair_of2(int pidx, int& a, int& b) { a = pidx < 3 ? 0 : (pidx < 5 ? 1 : 2); b = pidx < 3 ? pidx + 1 : (pidx < 5 ? pidx - 1 : 3); }
struct SchedMoe1 {
    int vcu, G, ntile; const int* tbk; const char *A, *W13; size_t tstep;
    __device__ __forceinline__ bool next(int i, Unit& u) const { const int uid = vcu + i * G; if (uid >= ntile * 8) return false; u.pm = uid >> 3; u.pn = uid & 7; u.aux = __builtin_amdgcn_readfirstlane(tbk[u.pm]); return true; }
    __device__ __forceinline__ const char* abase(const Unit& u) const { return A + (size_t)u.pm * tstep; }
    __device__ __forceinline__ const char* bbase(const Unit& u) const { const int g = u.aux / 6; int a, b; pair_of2(u.aux % 6, a, b); const int e = g * 4 + (u.pn < 4 ? a : b);
        return W13 + ((size_t)e * 1024 + (size_t)(u.pn & 3) * 256) * (1024 * 2); }
};
struct SchedMoe2 {
    int vcu, G, ntile; const int* tbk; const char *A, *W2P; size_t tstep;
    __device__ __forceinline__ bool next(int i, Unit& u) const { const int uid = vcu + i * G; if (uid >= ntile * 4) return false; u.pm = uid >> 2; u.pn = uid & 3; u.aux = __builtin_amdgcn_readfirstlane(tbk[u.pm]); return true; }
    __device__ __forceinline__ const char* abase(const Unit& u) const { return A + (size_t)u.pm * tstep; }
    __device__ __forceinline__ const char* bbase(const Unit& u) const { return W2P + ((size_t)u.aux * 1024 + (size_t)u.pn * 256) * (1024 * 2); }
};

__device__ __forceinline__ float silu_e(float v) { return v * __builtin_amdgcn_rcpf(1.f + __builtin_amdgcn_exp2f(-1.4426950408889634f * v)); }
__device__ __forceinline__ float sigm_e(float v) { return __builtin_amdgcn_rcpf(1.f + __builtin_amdgcn_exp2f(-1.4426950408889634f * v)); }
__device__ __forceinline__ float bflo(unsigned w) { return __builtin_bit_cast(float, w << 16); }
__device__ __forceinline__ float bfhi(unsigned w) { return __builtin_bit_cast(float, w & 0xffff0000u); }
__device__ __forceinline__ u32x4 pack8(const f32x4& v0, const f32x4& v1) { u32x4 w; w.x = cvt_pk_bf16(v0[0], v0[1]); w.y = cvt_pk_bf16(v0[2], v0[3]); w.z = cvt_pk_bf16(v1[0], v1[1]); w.w = cvt_pk_bf16(v1[2], v1[3]); return w; }
__device__ __forceinline__ float softplus_e(float v) {
    const float e = __builtin_amdgcn_exp2f(1.4426950408889634f * fminf(v, 20.f));
    const float s = e * (1.f - e * (0.5f - e * 0.33333334f));
    const float l = 0.6931471805599453f * __builtin_amdgcn_logf(1.f + e);
    const float r = e < 0.03f ? s : l;
    return v > 20.f ? v : r;
}
struct EpiInProj {
    static constexpr bool PERM = true;
    unsigned char* ws; const float* b_gate;
    template <int LD, bool ACT> static __device__ __forceinline__ void store_plain(const f32x4 (&acc)[8][4], bf16_t* base, int row0) {
#pragma unroll
        for (int m = 0; m < 8; ++m) { bf16_t* rp = base + (size_t)(row0 + m * 16) * LD;
#pragma unroll
            for (int n2 = 0; n2 < 2; ++n2) { f32x4 v0 = acc[m][2 * n2], v1 = acc[m][2 * n2 + 1];
                if (ACT) {
#pragma unroll
                    for (int e = 0; e < 4; ++e) { v0[e] = silu_e(v0[e]); v1[e] = silu_e(v1[e]); } }
                *(u32x4*)(rp + n2 * 32) = pack8(v0, v1); }
            if (m & 1) asm volatile("" ::: "memory"); }
    }
    __device__ __forceinline__ void operator()(const f32x4 (&acc)[8][4], const Unit& u, int wr, int wc, int fr, int fq) const {
        const int row0 = u.pm * BM + wr * 128 + fr, pn = u.pn, lc = wc * 64 + 8 * fq;
        if (pn >= 8) {
            const int colt = (pn - 8) * BM + lc; bf16_t* G = (bf16_t*)(ws + WS_G);
            f32x4 bv[2][2];
#pragma unroll
            for (int n2 = 0; n2 < 2; ++n2) { bv[n2][0] = *(const f32x4*)(b_gate + colt + n2 * 32); bv[n2][1] = *(const f32x4*)(b_gate + colt + n2 * 32 + 4); }
#pragma unroll
            for (int m = 0; m < 8; ++m) { bf16_t* rp = G + (size_t)(row0 + m * 16) * 2048 + colt;
#pragma unroll
                for (int n2 = 0; n2 < 2; ++n2) { f32x4 v0 = acc[m][2 * n2] + bv[n2][0], v1 = acc[m][2 * n2 + 1] + bv[n2][1];
#pragma unroll
                    for (int e = 0; e < 4; ++e) { v0[e] = sigm_e(v0[e]); v1[e] = sigm_e(v1[e]); }
                    *(u32x4*)(rp + n2 * 32) = pack8(v0, v1); }
                if (m & 1) asm volatile("" ::: "memory"); }
        } else if (pn < 2) store_plain<512, false>(acc, (bf16_t*)(ws + WS_QO) + pn * BM + lc, row0);
        else if (pn == 2) { if (wc < 2) store_plain<128, false>(acc, (bf16_t*)(ws + WS_K) + lc, row0); else store_plain<128, false>(acc, (bf16_t*)(ws + WS_V) + (lc - 128), row0); }
        else if (pn < 5) store_plain<512, true>(acc, (bf16_t*)(ws + WS_Z) + (pn - 3) * BM + lc, row0);
        else store_plain<768, false>(acc, (bf16_t*)(ws + WS_XBC) + (pn - 5) * BM + lc, row0);
    }
};
struct EpiMerged {
    static constexpr bool PERM = true;
    const bf16_t* G; bf16_t* MG;
    __device__ __forceinline__ void operator()(const f32x4 (&acc)[8][4], const Unit& u, int wr, int wc, int fr, int fq) const {
        const int row0 = u.pm * BM + wr * 128 + fr, col0 = u.pn * BM + wc * 64 + 8 * fq, goff = u.aux ? 0 : 1024;
#pragma unroll
        for (int m = 0; m < 8; ++m) { const size_t row = (size_t)(row0 + m * 16);
#pragma unroll
            for (int n2 = 0; n2 < 2; ++n2) { const int col = col0 + n2 * 32;
                const u32x4 gv = *(const u32x4*)(G + row * 2048 + goff + col);
                f32x4 v0 = acc[m][2 * n2], v1 = acc[m][2 * n2 + 1];
                v0[0] *= bflo(gv.x); v0[1] *= bfhi(gv.x); v0[2] *= bflo(gv.y); v0[3] *= bfhi(gv.y); v1[0] *= bflo(gv.z); v1[1] *= bfhi(gv.z); v1[2] *= bflo(gv.w); v1[3] *= bfhi(gv.w);
                bf16_t* dst = MG + row * 1024 + col;
                if (u.aux) { const u32x4 ov = *(const u32x4*)dst;
                    v0[0] += bflo(ov.x); v0[1] += bfhi(ov.x); v0[2] += bflo(ov.y); v0[3] += bfhi(ov.y); v1[0] += bflo(ov.z); v1[1] += bfhi(ov.z); v1[2] += bflo(ov.w); v1[3] += bfhi(ov.w); }
                *(u32x4*)dst = pack8(v0, v1); }
            asm volatile("" ::: "memory"); }
    }
};
struct EpiWout {
    static constexpr bool PERM = false;
    const float* x; float* out;
    __device__ __forceinline__ void operator()(const f32x4 (&acc)[8][4], const Unit& u, int wr, int wc, int fr, int fq) const {
        const int row0 = u.pm * BM + wr * 128 + fr, col0 = u.pn * BM + wc * 64 + 4 * fq;
#pragma unroll
        for (int m = 0; m < 8; ++m) { const size_t off = (size_t)(row0 + m * 16) * 1024 + col0;
#pragma unroll
            for (int n = 0; n < 4; ++n) *(f32x4*)(out + off + n * 16) = *(const f32x4*)(x + off + n * 16) + acc[m][n];
            if (m & 1) asm volatile("" ::: "memory"); }
    }
};
struct EpiMoe1 {
    static constexpr bool PERM = true;
    bf16_t* HID; const float* SWA; const float* SWB;
    __device__ __forceinline__ void operator()(const f32x4 (&acc)[8][4], const Unit& u, int wr, int wc, int fr, int fq) const {
        const int row0 = u.pm * BM + wr * 128 + fr, slot = u.pn >> 2, hc = slot * 512 + (u.pn & 3) * 128 + 32 * wc + 4 * fq;
        const float* SW = slot ? SWB : SWA;
#pragma unroll
        for (int m = 0; m < 8; ++m) { const size_t row = (size_t)(row0 + m * 16); const float w = SW[row];
#pragma unroll
            for (int n2 = 0; n2 < 2; ++n2) { const f32x4 v0 = acc[m][2 * n2], v1 = acc[m][2 * n2 + 1];
                float h0 = w * silu_e(v0[0]) * v0[1], h1 = w * silu_e(v0[2]) * v0[3], h2 = w * silu_e(v1[0]) * v1[1], h3 = w * silu_e(v1[2]) * v1[3];
                if (w == 0.f) { h0 = 0.f; h1 = 0.f; h2 = 0.f; h3 = 0.f; }
                u32x2 o; o.x = cvt_pk_bf16(h0, h1); o.y = cvt_pk_bf16(h2, h3);
                *(u32x2*)(HID + row * 1024 + hc + 16 * n2) = o; } }
    }
};
struct EpiMoe2 {
    static constexpr bool PERM = false;
    float* out; const int* perm;
    __device__ __forceinline__ void operator()(const f32x4 (&acc)[8][4], const Unit& u, int wr, int wc, int fr, int fq) const {
        const int row0 = u.pm * BM + wr * 128 + fr, col0 = u.pn * BM + wc * 64 + 4 * fq;
#pragma unroll
        for (int m = 0; m < 8; ++m) { const int tok = perm[row0 + m * 16];
            if (tok >= 0) { float* op = out + (size_t)tok * 1024 + col0;
#pragma unroll
                for (int n = 0; n < 4; ++n) { f32x4* q = (f32x4*)(op + n * 16); *q = *q + acc[m][n]; } } }
    }
};
}


#define GAS __attribute__((address_space(1)))
#define LAS __attribute__((address_space(3)))
typedef GAS unsigned gu32;
#define RLX_AGENT __ATOMIC_RELAXED, __HIP_MEMORY_SCOPE_AGENT
constexpr int CW_BAR = 4096;
constexpr int MISC_OFF = 147456 - 256;
#define XB_TMO      128
#define XB_XCNT(j)  (256  + 64 * (j))
#define XB_XSUB(j)  (1280 + 64 * (j))
#define XB_XGEN(j)  (2304 + 64 * (j))
#define XB_TOP      3328
#define XB_TOPGEN   3392
#define XCD_BAR_WORDS 3456
#define XB_SPIN_CAP (1u << 18)

__device__ __forceinline__ unsigned xb_ld(unsigned* p)              { return __hip_atomic_load(p, __ATOMIC_RELAXED, __HIP_MEMORY_SCOPE_AGENT); }
__device__ __forceinline__ unsigned xb_add(unsigned* p, unsigned v) { return __hip_atomic_fetch_add(p, v, __ATOMIC_RELAXED, __HIP_MEMORY_SCOPE_AGENT); }
__device__ __forceinline__ unsigned xb_xcc_id() { return (unsigned)__builtin_amdgcn_s_getreg((3 << 11) | 20) & 0xFu; }
#define XB_SPIN(cond, bar) do { unsigned _sp = 0; while (cond) { __builtin_amdgcn_s_sleep(1); \
    if ((++_sp & 255u) == 0u) { if (xb_ld(&(bar)[XB_TMO])) break; if (_sp > XB_SPIN_CAP) { atomicAdd(&(bar)[XB_TMO], 1u); break; } } } } while (0)

struct XcdBarrier {
    unsigned* bar; unsigned x;
    volatile LAS unsigned* st;
};

__device__ __forceinline__ XcdBarrier xcd_barrier_post(unsigned* bar, volatile LAS unsigned* st) {
    XcdBarrier b; b.bar = bar; b.x = xb_xcc_id(); b.st = st;
    if (threadIdx.x == 0) (void)xb_add(&bar[XB_XCNT(b.x)], 1u);
    return b;
}
__device__ __forceinline__ void xcd_barrier_complete(unsigned* bar, unsigned x, unsigned& nloc, unsigned& nx) {
    const unsigned G = gridDim.x * gridDim.y * gridDim.z;
    unsigned sum, cnt, mine, sp = 0u;
    for (;;) {
        sum = 0u; cnt = 0u; mine = 0u;
#pragma unroll
        for (unsigned j = 0; j < 16; ++j) { const unsigned c = xb_ld(&bar[XB_XCNT(j)]); sum += c; cnt += (c > 0u) ? 1u : 0u; mine = (j == x) ? c : mine; }
        if (sum == G) break;
        __builtin_amdgcn_s_sleep(1);
        if ((++sp & 255u) == 0u) { if (xb_ld(&bar[XB_TMO])) break; if (sp > XB_SPIN_CAP) { atomicAdd(&bar[XB_TMO], 1u); break; } }
    }
    nloc = mine > 0u ? mine : 1u; nx = cnt > 0u ? cnt : 1u;
}

__device__ __forceinline__ void xcd_barrier(const XcdBarrier& b) {
    asm volatile("s_waitcnt vmcnt(0)" ::: "memory");
    __syncthreads();
    if (threadIdx.x == 0) {
        unsigned* bar = b.bar;
        __builtin_amdgcn_s_waitcnt(0);
        unsigned nloc = b.st[0], nx = b.st[1];
        if (nloc == 0u) { xcd_barrier_complete(bar, b.x, nloc, nx); b.st[0] = nloc; b.st[1] = nx; }
        const unsigned old = xb_add(&bar[XB_XSUB(b.x)], 1u);
        const unsigned gen = old / nloc;
        if (old + 1u == (gen + 1u) * nloc) {
            __builtin_amdgcn_fence(__ATOMIC_RELEASE, "agent");
            asm volatile("s_waitcnt vmcnt(0)" ::: "memory");
            const unsigned og = xb_add(&bar[XB_TOP], 1u);
            const unsigned tg = og / nx;
            if (og + 1u == (tg + 1u) * nx) xb_add(&bar[XB_TOPGEN], 1u);
            else XB_SPIN(xb_ld(&bar[XB_TOPGEN]) == tg, bar);
            __builtin_amdgcn_fence(__ATOMIC_ACQUIRE, "agent");
            asm volatile("s_waitcnt vmcnt(0)" ::: "memory");
        } else {
            XB_SPIN(xb_ld(&bar[XB_TOPGEN]) == gen, bar);
            __builtin_amdgcn_fence(__ATOMIC_ACQUIRE, "agent");
            asm volatile("s_waitcnt vmcnt(0)" ::: "memory");
        }
    }
    __syncthreads();
}

struct TrJob { const float* W; int ldw, K, sc0, ncols; bf16_t* dst; int ldd, dr0, dstride, dk0; bf16_t* dst2; int dk2; bf16_t* dst3; int dk3; const float* ks = nullptr; };
__device__ __forceinline__ int tr_items(const TrJob& j) { return (j.K / 64) * ((j.ncols + 31) / 32); }
constexpr int tr_items_c(int K, int ncols) { return (K / 64) * ((ncols + 31) / 32); }
__device__ __forceinline__ void tr_item(const TrJob& j, int item, float* scr  , int lane) {
    const int nblk = (j.ncols + 31) / 32, kb = item / nblk, nb = item % nblk, k0 = 64 * kb, n0 = 32 * nb;
    const int nvalid = min(32, j.ncols - n0);
    {
        f32x4 v[8]; const int n4 = 4 * (lane & 7), kr = lane >> 3; const float* src = j.W + (size_t)(k0 + kr) * j.ldw + j.sc0 + n0 + (n4 < nvalid ? n4 : 0);
#pragma unroll
        for (int i = 0; i < 8; ++i) v[i] = *(const f32x4*)(src + (size_t)(8 * i) * j.ldw);
#pragma unroll
        for (int i = 0; i < 8; ++i) { float* d = scr + (8 * i + kr) * 33 + n4; d[0] = v[i][0]; d[1] = v[i][1]; d[2] = v[i][2]; d[3] = v[i][3]; }
    }
    __builtin_amdgcn_s_waitcnt(0xc07f); asm volatile("" ::: "memory");
    const int c = lane & 7;
    f32x4 ka = {1.f, 1.f, 1.f, 1.f}, kc = ka;
    if (j.ks) { ka = *(const f32x4*)(j.ks + k0 + 8 * c); kc = *(const f32x4*)(j.ks + k0 + 8 * c + 4); }
#pragma unroll
    for (int jj = 0; jj < 4; ++jj) { const int n = (lane >> 3) + 8 * jj; const float* s = scr + (8 * c) * 33 + n;
        u32x4 o; o.x = pk2(s[0 * 33] * ka[0], s[1 * 33] * ka[1]); o.y = pk2(s[2 * 33] * ka[2], s[3 * 33] * ka[3]); o.z = pk2(s[4 * 33] * kc[0], s[5 * 33] * kc[1]); o.w = pk2(s[6 * 33] * kc[2], s[7 * 33] * kc[3]);
        if (n < nvalid) { const size_t ro = (size_t)(j.dr0 + (n0 + n) * j.dstride) * j.ldd + k0 + 8 * c; *(u32x4*)(j.dst + ro + j.dk0) = o;
            if (j.dst2) *(u32x4*)(j.dst2 + ro + j.dk2) = o; if (j.dst3) *(u32x4*)(j.dst3 + ro + j.dk3) = o; } }
    __builtin_amdgcn_s_waitcnt(0xc07f); asm volatile("" ::: "memory");
}
__device__ __forceinline__ void pair_of(int pidx, int& a, int& b) {
    a = pidx < 3 ? 0 : (pidx < 5 ? 1 : 2); b = pidx < 3 ? pidx + 1 : (pidx < 5 ? pidx - 1 : 3);
}
constexpr int TR_WIN = 2064, TR_EARLY = 3088, TR_W2 = TR_EARLY + 32 * 256, TR_TOTAL = TR_W2 + 16 * 256;
__device__ __forceinline__ void tr_mkjob(const Params& p, int g, TrJob& j, int& it) {
    bf16_t* WinT = wsp<bf16_t>(p, WS_WIN);
    if (g < 1024) { it = g; j = TrJob{p.w_in, IN_PROJ, DM, 0, 2048, WinT, DM, 0, 1, 0, nullptr, 0, nullptr, 0}; }
    else if (g < 2048) { it = g - 1024; j = TrJob{p.w_in, IN_PROJ, DM, 2064, 2048, WinT, DM, 2048, 1, 0, nullptr, 0, nullptr, 0}; }
    else if (g < 2064) { it = g - 2048; j = TrJob{p.w_in, IN_PROJ, DM, 2048, 16, WinT, DM, 4096, 1, 0, nullptr, 0, nullptr, 0}; }
    else if (g < 2320) { it = g - 2064; j = TrJob{p.w_attn_o, DM, 512, 0, DM, wsp<bf16_t>(p, WS_WA), 512, 0, 1, 0, nullptr, 0, nullptr, 0}; }
    else if (g < 2576) { it = g - 2320; j = TrJob{p.w_ssd_o, DM, 512, 0, DM, wsp<bf16_t>(p, WS_WS), 512, 0, 1, 0, nullptr, 0, nullptr, 0}; }
    else if (g < TR_EARLY) { it = g - 2576; j = TrJob{p.w_out, DM, DM, 0, DM, wsp<bf16_t>(p, WS_WO), DM, 0, 1, 0, nullptr, 0, nullptr, 0}; }
    else { const int q = (g - TR_EARLY) >> 8, e = q & 15; it = (g - TR_EARLY) & 255;
        if (q < 16) j = TrJob{p.w1 + (size_t)e * DM * DE, DE, DM, 0, DE, wsp<bf16_t>(p, WS_W13) + (size_t)e * 1024 * DM, DM, 0, 2, 0, nullptr, 0, nullptr, 0, p.norm_ffn_w};
        else if (q < 32) j = TrJob{p.w3 + (size_t)e * DM * DE, DE, DM, 0, DE, wsp<bf16_t>(p, WS_W13) + (size_t)e * 1024 * DM, DM, 1, 2, 0, nullptr, 0, nullptr, 0, p.norm_ffn_w};
        else j = TrJob{p.w2 + (size_t)e * DE * DM, DM, DE, 0, DM, wsp<bf16_t>(p, WS_W2P) + (size_t)e * 1024 * 512, 512, 0, 1, 0, nullptr, 0, nullptr, 0}; }
}
static_assert(tr_items_c(DM, 2048) == 1024 && tr_items_c(DM, 16) == 16 && tr_items_c(512, DM) == 256 && tr_items_c(DM, DM) == 512 && tr_items_c(DM, DE) == 256 && tr_items_c(DE, DM) == 256, "item counts of the flat transpose table");
__device__ __forceinline__ void phase_tr_range(const Params& p, float* scr, int lane, int g0, int g1, int w, int nw) {
    for (int g = g0 + w; g < g1; g += nw) { TrJob j; int it; tr_mkjob(p, g, j, it); tr_item(j, it, scr, lane); }
}
__device__ __forceinline__ void xcd_barrier_work(const XcdBarrier& b, const Params& p, unsigned char* lds, int g0, int g1) {
    asm volatile("s_waitcnt vmcnt(0)" ::: "memory");
    __syncthreads();
    const int tid = tid_opaque(), wave = tid >> 6;
    if (wave == 0) {
      if (tid == 0) {
        unsigned* bar = b.bar;
        __builtin_amdgcn_s_waitcnt(0);
        unsigned nloc = b.st[0], nx = b.st[1];
        if (nloc == 0u) { xcd_barrier_complete(bar, b.x, nloc, nx); b.st[0] = nloc; b.st[1] = nx; }
        const unsigned old = xb_add(&bar[XB_XSUB(b.x)], 1u);
        const unsigned gen = old / nloc;
        if (old + 1u == (gen + 1u) * nloc) {
            __builtin_amdgcn_fence(__ATOMIC_RELEASE, "agent");
            asm volatile("s_waitcnt vmcnt(0)" ::: "memory");
            const unsigned og = xb_add(&bar[XB_TOP], 1u);
            const unsigned tg = og / nx;
            if (og + 1u == (tg + 1u) * nx) xb_add(&bar[XB_TOPGEN], 1u);
            else XB_SPIN(xb_ld(&bar[XB_TOPGEN]) == tg, bar);
            __builtin_amdgcn_fence(__ATOMIC_ACQUIRE, "agent");
            asm volatile("s_waitcnt vmcnt(0)" ::: "memory");
        } else {
            XB_SPIN(xb_ld(&bar[XB_TOPGEN]) == gen, bar);
            __builtin_amdgcn_fence(__ATOMIC_ACQUIRE, "agent");
            asm volatile("s_waitcnt vmcnt(0)" ::: "memory");
        }
      }
    } else {
        if (g0 == TR_WIN + 1152 && wave <= 2) {
            bf16_t* WRT = (bf16_t*)(p.ws + WS_ROUTE + RT_WRT);
            for (int i = blockIdx.x * 128 + tid - 64; i < 32 * DM; i += gridDim.x * 128) { const int n = i >> 10, k = i & 1023;
                const float v = n < 4 ? p.w_rg[k * 4 + n] : (n < 20 ? p.w_re[k * 16 + (n - 4)] : 0.f); WRT[i] = (bf16_t)f2bf(v * p.norm_ffn_w[k]); } }
        phase_tr_range(p, (float*)lds + wave * (64 * 33), tid & 63, g0, g1, (wave - 1) * (int)gridDim.x + (int)blockIdx.x, (int)gridDim.x * 7);
        asm volatile("s_waitcnt vmcnt(0)" ::: "memory");
    }
    __syncthreads();
}
__device__ __forceinline__ void phase_p0(const Params& p, unsigned char* lds) {
    const int tid = tid_opaque(), lane = tid & 63, wave = tid >> 6;
    float* scr = (float*)lds + wave * (64 * 33);
    const int gw = blockIdx.x * 8 + wave, NGW = gridDim.x * 8;
    bf16_t* WinT = wsp<bf16_t>(p, WS_WIN);
    phase_tr_range(p, scr, lane, 0, TR_WIN, gw, NGW);
    { u32x4 z = {0u, 0u, 0u, 0u}; u32x4* d = (u32x4*)(WinT + (size_t)4112 * DM); const int n16 = (NPROJ - 4112) * DM * 2 / 16;
      for (int i = blockIdx.x * 512 + tid; i < n16; i += gridDim.x * 512) d[i] = z; }
    bf16_t* H = wsp<bf16_t>(p, WS_H);
    {
        const f32x4* wr = (const f32x4*)p.norm_mix_w;
        f32x4 w4[4];
#pragma unroll
        for (int jj = 0; jj < 4; ++jj) w4[jj] = wr[2 * lane + (jj & 1) + 128 * (jj >> 1)];
        for (int m = gw; m + 3 * NGW < T; m += 4 * NGW) {
            f32x4 v[4][4];
#pragma unroll
            for (int r = 0; r < 4; ++r) { const f32x4* xr = (const f32x4*)(p.x + (size_t)(m + r * NGW) * DM);
#pragma unroll
                for (int jj = 0; jj < 4; ++jj) v[r][jj] = xr[2 * lane + (jj & 1) + 128 * (jj >> 1)]; }
            __builtin_amdgcn_sched_barrier(0);
#pragma unroll
            for (int r = 0; r < 4; ++r) { float s = 0.f;
#pragma unroll
                for (int jj = 0; jj < 4; ++jj) s += (v[r][jj].x * v[r][jj].x + v[r][jj].y * v[r][jj].y) + (v[r][jj].z * v[r][jj].z + v[r][jj].w * v[r][jj].w);
                const float rstd = 1.f / sqrtf(wave_sum(s) * (1.f / DM) + EPS);
                u32x4* o16 = (u32x4*)(H + (size_t)(m + r * NGW) * DM);
#pragma unroll
                for (int hf = 0; hf < 2; ++hf) { const f32x4 a = v[r][2 * hf], b = v[r][2 * hf + 1], wa = w4[2 * hf], wb = w4[2 * hf + 1];
                    o16[lane + 64 * hf] = (u32x4){pk2(a.x * rstd * wa.x, a.y * rstd * wa.y), pk2(a.z * rstd * wa.z, a.w * rstd * wa.w), pk2(b.x * rstd * wb.x, b.y * rstd * wb.y), pk2(b.z * rstd * wb.z, b.w * rstd * wb.w)}; } }
        }
    }
}

template <class AF, class BF, class Epi>
__device__ __forceinline__ void gemm_naive(int M, int N, int K, const AF& af, const BF& bf, const Epi& epi) {
    const int lane = threadIdx.x & 63, gw = blockIdx.x * 8 + (threadIdx.x >> 6), NGW = gridDim.x * 8;
    const int tn = N / 32, nt = (M / 32) * tn, r = lane & 31, h = lane >> 5;
    for (int t = gw; t < nt; t += NGW) {
        const int pm = t / tn, pn = t % tn;
        const bf16_t* a = af(pm * 32 + r) + 8 * h; const bf16_t* b = bf(pm * 32, pn * 32 + r) + 8 * h;
        f32x16 acc = {0.f, 0.f, 0.f, 0.f, 0.f, 0.f, 0.f, 0.f, 0.f, 0.f, 0.f, 0.f, 0.f, 0.f, 0.f, 0.f};
        for (int k = 0; k < K; k += 16) { const bf16x8 av = *(const bf16x8*)(a + k), bv = *(const bf16x8*)(b + k); acc = __builtin_amdgcn_mfma_f32_32x32x16_bf16(av, bv, acc, 0, 0, 0); }
#pragma unroll
        for (int i = 0; i < 16; ++i) epi(pm * 32 + (i & 3) + 8 * (i >> 2) + 4 * h, pn * 32 + r, acc[i]);
    }
}

__device__ __forceinline__ void phase_p1(const Params& p) {
    const bf16_t* H = wsp<bf16_t>(p, WS_H); const bf16_t* W = wsp<bf16_t>(p, WS_WIN);
    bf16_t *QO = wsp<bf16_t>(p, WS_QO), *Kb = wsp<bf16_t>(p, WS_K), *Vb = wsp<bf16_t>(p, WS_V), *Z = wsp<bf16_t>(p, WS_Z), *XBC = wsp<bf16_t>(p, WS_XBC), *G = wsp<bf16_t>(p, WS_G);
    float* DT = wsp<float>(p, WS_DT); const float* b_gate = p.b_gate; const float* dt_bias = p.dt_bias;
    auto af = [=](int row) { return H + (size_t)row * DM; };
    auto bf = [=](int, int col) { return W + (size_t)col * DM; };
    auto epi = [=](int row, int c, float v) {
        if (c < 512) QO[(size_t)row * 512 + c] = (bf16_t)f2bf(v);
        else if (c < 640) Kb[(size_t)row * 128 + (c - 512)] = (bf16_t)f2bf(v);
        else if (c < 768) Vb[(size_t)row * 128 + (c - 640)] = (bf16_t)f2bf(v);
        else if (c < 1280) Z[(size_t)row * 512 + (c - 768)] = (bf16_t)f2bf(silu_f(v));
        else if (c < 2048) XBC[(size_t)row * 768 + (c - 1280)] = (bf16_t)f2bf(v);
        else if (c < 4096) G[(size_t)row * 2048 + (c - 2048)] = (bf16_t)f2bf(sigmoid_f(v + b_gate[c - 2048]));
        else if (c < 4112) DT[(size_t)row * 16 + (c - 4096)] = softplus_f(v + dt_bias[c - 4096]);
    };
    gemm_naive(T, NPROJ, DM, af, bf, epi);
}

__device__ __forceinline__ void phase_dt(const Params& p, unsigned char* lds) {
    const bf16_t* H = wsp<bf16_t>(p, WS_H); const bf16_t* W = wsp<bf16_t>(p, WS_WIN) + (size_t)4096 * DM;
    float* DT = wsp<float>(p, WS_DT); const float* dt_bias = p.dt_bias;
    const int tid = tid_opaque(), lane = tid & 63, wave = tid >> 6, NGW = gridDim.x * 8, r = lane & 31, h = lane >> 5;
    const float bias = dt_bias[r & 15];
    float* red = (float*)lds + (wave >> 1) * (16 * 64);
    __syncthreads();
    for (int task0 = blockIdx.x * 8; task0 < 2 * (T / 32); task0 += NGW) {
        const int task = task0 + wave, t = task >> 1, kh = task & 1;
        const bf16_t* a = H + (size_t)(t * 32 + r) * DM + 8 * h + kh * 512; const bf16_t* b = W + (size_t)r * DM + 8 * h + kh * 512;
        f32x16 acc = {0.f, 0.f, 0.f, 0.f, 0.f, 0.f, 0.f, 0.f, 0.f, 0.f, 0.f, 0.f, 0.f, 0.f, 0.f, 0.f};
#pragma unroll 1
        for (int k0 = 0; k0 < 512; k0 += 256) {
            bf16x8 av[16], bv[16];
#pragma unroll
            for (int u = 0; u < 16; ++u) { av[u] = *(const bf16x8*)(a + k0 + 16 * u); bv[u] = *(const bf16x8*)(b + k0 + 16 * u); }
            __builtin_amdgcn_sched_barrier(0);
#pragma unroll
            for (int u = 0; u < 16; ++u) acc = __builtin_amdgcn_mfma_f32_32x32x16_bf16(av[u], bv[u], acc, 0, 0, 0);
            __builtin_amdgcn_sched_barrier(0);
        }
        if (kh == 1) {
#pragma unroll
            for (int i = 0; i < 16; ++i) red[i * 64 + lane] = acc[i]; }
        __syncthreads();
        if (kh == 0 && r < 16) {
#pragma unroll
            for (int i = 0; i < 16; ++i) { const int row = t * 32 + (i & 3) + 8 * (i >> 2) + 4 * h; DT[(size_t)row * 16 + r] = softplus_f(acc[i] + red[i * 64 + lane] + bias); }
        }
        __syncthreads();
    }
}
__device__ __forceinline__ void phase_p1_check(const Params& p) {
    const bf16_t* H = wsp<bf16_t>(p, WS_H); const bf16_t* W = wsp<bf16_t>(p, WS_WIN);
    bf16_t *QO = wsp<bf16_t>(p, WS_QO), *Kb = wsp<bf16_t>(p, WS_K), *Vb = wsp<bf16_t>(p, WS_V), *Z = wsp<bf16_t>(p, WS_Z), *XBC = wsp<bf16_t>(p, WS_XBC), *G = wsp<bf16_t>(p, WS_G);
    float* DT = wsp<float>(p, WS_DT); const float* b_gate = p.b_gate; const float* dt_bias = p.dt_bias;
    unsigned* ctl = (unsigned*)(p.ws + WS_CTL);
    auto af = [=](int row) { return H + (size_t)row * DM; };
    auto bf = [=](int, int col) { return W + (size_t)col * DM; };
    auto cmp2 = [=](float got, float want, int type, int row, int c) { if (!(fabsf(got - want) <= 0.03f + 0.03f * fabsf(want))) { if (c < 4096) ctl[8192 + (row >> 8) * 16 + (c >> 8)] = 1u; } };
    #define cmp(g_, w_, t_) cmp2(g_, w_, t_, row, c)
    auto epi = [=](int row, int c, float v) {
        if (c < 512) cmp(bf2f(QO[(size_t)row * 512 + c]), v, 0);
        else if (c < 640) cmp(bf2f(Kb[(size_t)row * 128 + (c - 512)]), v, 1);
        else if (c < 768) cmp(bf2f(Vb[(size_t)row * 128 + (c - 640)]), v, 2);
        else if (c < 1280) cmp(bf2f(Z[(size_t)row * 512 + (c - 768)]), silu_f(v), 3);
        else if (c < 2048) cmp(bf2f(XBC[(size_t)row * 768 + (c - 1280)]), v, 4);
        else if (c < 4096) cmp(bf2f(G[(size_t)row * 2048 + (c - 2048)]), sigmoid_f(v + b_gate[c - 2048]), 5);
        else if (c < 4112) cmp(DT[(size_t)row * 16 + (c - 4096)], softplus_f(v + dt_bias[c - 4096]), 6);
    };
    gemm_naive(T, NPROJ, DM, af, bf, epi);
}
#ifndef PROBE_SEL
#define PROBE_SEL 4
#endif
#ifndef PROBE_MODE
#define PROBE_MODE 1
#endif
__device__ __forceinline__ void phase_probe_out(const Params& p) {
    const unsigned* ctl = (const unsigned*)(p.ws + WS_CTL);
    __shared__ unsigned cnt[4];
    if (threadIdx.x == 0) { cnt[0] = 1000000u; cnt[1] = 0u; cnt[2] = 0u; cnt[3] = 0u; }
    __syncthreads();
    for (int i = threadIdx.x; i < 2048; i += 512) if (ctl[8192 + i]) { const unsigned v = (unsigned)(i & 255); atomicMin(&cnt[0], v); atomicMax(&cnt[1], v); atomicAdd(&cnt[2], 1u); atomicOr(&cnt[3], 1u << (i >> 8)); }
    __syncthreads();
#if PROBE_MODE == 0
    const float f = 1.f + (float)(cnt[0] + 1);
    const float V = 100.f * (float)(cnt[1] + 1);
#else
    const float f = 1.f + (float)(cnt[2]);
    const float V = 100.f * (float)(cnt[3] + 1);
#endif
    for (size_t i = (size_t)blockIdx.x * 512 + threadIdx.x; i < (size_t)T * DM; i += (size_t)gridDim.x * 512) p.out[i] = (i == 0) ? V : p.x[i] * f;
}
#undef cmp
__device__ __forceinline__ void phase_rope(const Params& p) {
    bf16_t* Kb = wsp<bf16_t>(p, WS_K);
    const int nth = gridDim.x * 512;
    for (int idx = blockIdx.x * 512 + tid_opaque(); idx < T * 2; idx += nth) {
        const int t = idx >> 1, hh = idx & 1;
        bf16_t* ptr = Kb + (size_t)t * 128 + hh * 64;
        const float* nw = p.k_norm_w;
        float x[64];
#pragma unroll
        for (int c = 0; c < 8; ++c) { const u32x4 v = *(const u32x4*)(ptr + 8 * c);
            x[8 * c + 0] = bf2f(v.x & 0xffff); x[8 * c + 1] = bf2f(v.x >> 16); x[8 * c + 2] = bf2f(v.y & 0xffff); x[8 * c + 3] = bf2f(v.y >> 16);
            x[8 * c + 4] = bf2f(v.z & 0xffff); x[8 * c + 5] = bf2f(v.z >> 16); x[8 * c + 6] = bf2f(v.w & 0xffff); x[8 * c + 7] = bf2f(v.w >> 16); }
        float ss = 0.f;
#pragma unroll
        for (int d = 0; d < 64; ++d) ss += x[d] * x[d];
        const float rstd = 1.f / sqrtf(ss * (1.f / 64.f) + EPS);
#pragma unroll
        for (int d = 0; d < 64; ++d) x[d] = x[d] * rstd * nw[d];
        const int pos = t % SEQ; const float frow = (float)(pos / 64), fcol = (float)(pos % 64);
        float o[64];
#pragma unroll
        for (int i = 0; i < 16; ++i) {
            const float inv = exp2f(-(float)i * (13.287712379549449f / 16.f));
            const float ar = frow * inv, ac = fcol * inv;
            const float cr = __cosf(ar), sr = __sinf(ar), cc = __cosf(ac), s2 = __sinf(ac);
            o[i] = x[i] * cr - x[i + 16] * sr; o[i + 16] = x[i + 16] * cr + x[i] * sr;
            o[32 + i] = x[32 + i] * cc - x[48 + i] * s2; o[48 + i] = x[48 + i] * cc + x[32 + i] * s2;
        }
#pragma unroll
        for (int c = 0; c < 8; ++c) { u32x4 v; v.x = pk2(o[8 * c], o[8 * c + 1]); v.y = pk2(o[8 * c + 2], o[8 * c + 3]); v.z = pk2(o[8 * c + 4], o[8 * c + 5]); v.w = pk2(o[8 * c + 6], o[8 * c + 7]);
            *(u32x4*)(ptr + 8 * c) = v; }
    }
}

__device__ __forceinline__ void phase_ssd_chunk_naive(const Params& p, unsigned char* lds) {
    const int tid = tid_opaque();
    bf16_t* xs = (bf16_t*)lds;
    bf16_t* Bs = xs + 128 * 256;
    bf16_t* Cs = Bs + 128 * 64;
    float* dts = (float*)(Cs + 128 * 64);
    float* cum = dts + 2 * 4 * 128;
    float* suf = cum + 4 * 128;
    const bf16_t* XBC = wsp<bf16_t>(p, WS_XBC); const float* DT = wsp<float>(p, WS_DT);
    bf16_t* YD = wsp<bf16_t>(p, WS_YD); bf16_t* CC = wsp<bf16_t>(p, WS_CC); float* ACUM = wsp<float>(p, WS_ACUM); float* ST = wsp<float>(p, WS_ST);
    for (int item = blockIdx.x; item < BATCH * NCHUNK * SSD_G; item += gridDim.x) {
        const int g = item & 1, c = (item >> 1) % NCHUNK, b = item / (2 * NCHUNK);
        const int t0 = b * SEQ + c * CHUNK;
        __syncthreads();
        for (int idx = tid; idx < 128 * 384; idx += 512) {
            const int i = idx / 384, cl = idx % 384;
            const int ch = cl < 256 ? 256 * g + cl : (cl < 320 ? 512 + 64 * g + (cl - 256) : 640 + 64 * g + (cl - 320));
            float acc = p.conv_b[ch];
#pragma unroll
            for (int k = 0; k < DCONV; ++k) { const int pos = c * CHUNK + i + k - 3;
                if (pos >= 0 && pos < SEQ) acc += p.conv_w[k * CONV_CH + ch] * bf2f(XBC[(size_t)(b * SEQ + pos) * CONV_CH + ch]); }
            const bf16_t v = (bf16_t)f2bf(silu_f(acc));
            if (cl < 256) xs[i * 256 + cl] = v; else if (cl < 320) Bs[i * 64 + (cl - 256)] = v; else { Cs[i * 64 + (cl - 320)] = v; CC[(size_t)(t0 + i) * 128 + 64 * g + (cl - 320)] = v; }
        }
        for (int idx = tid; idx < 2 * 4 * 128; idx += 512) { const int dir = idx >> 9, hl = (idx >> 7) & 3, i = idx & 127; dts[idx] = DT[(size_t)(t0 + i) * 16 + dir * 8 + 4 * g + hl]; }
        __syncthreads();
        if (tid < 4) { const int hl = tid; const float a = -__expf(p.a_log[4 * g + hl]); float s = 0.f;
            for (int i = 0; i < 128; ++i) { s += dts[hl * 128 + i] * a; cum[hl * 128 + i] = s; ACUM[(size_t)(t0 + i) * 16 + 4 * g + hl] = s; } }
        else if (tid >= 64 && tid < 68) { const int hl = tid - 64; const float a = -__expf(p.a_log[8 + 4 * g + hl]); float s = 0.f;
            for (int i = 127; i >= 0; --i) { s += dts[512 + hl * 128 + i] * a; suf[hl * 128 + i] = s; ACUM[(size_t)(t0 + i) * 16 + 8 + 4 * g + hl] = s; } }
        __syncthreads();
        {
            const int hl = tid >> 7, i = tid & 127, h = 4 * g + hl;
            float Cr[64], y[64];
#pragma unroll
            for (int n = 0; n < 64; ++n) { Cr[n] = bf2f(Cs[i * 64 + n]); y[n] = 0.f; }
            const float ci = cum[hl * 128 + i], si = suf[hl * 128 + i];
            for (int j = 0; j < 128; ++j) {
                float cb = 0.f;
#pragma unroll
                for (int n = 0; n < 64; ++n) cb += Cr[n] * bf2f(Bs[j * 64 + n]);
                float w = 0.f;
                if (j <= i) w += __expf(ci - cum[hl * 128 + j]) * dts[hl * 128 + j];
                if (j >= i) w += __expf(si - suf[hl * 128 + j]) * dts[512 + hl * 128 + j];
                const float s = cb * w;
#pragma unroll
                for (int q = 0; q < 64; ++q) y[q] += s * bf2f(xs[j * 256 + hl * 64 + q]);
            }
            const float dsk = p.d_skip[h];
#pragma unroll
            for (int q = 0; q < 64; q += 2) { const float y0 = y[q] + dsk * bf2f(xs[i * 256 + hl * 64 + q]), y1 = y[q + 1] + dsk * bf2f(xs[i * 256 + hl * 64 + q + 1]);
                *(unsigned*)(YD + (size_t)(t0 + i) * 512 + h * 64 + q) = pk2(y0, y1); }
        }
        {
            const int combo = tid >> 6, hl = combo & 3, dir = combo >> 2, n = tid & 63, h = 4 * g + hl;
            float acc[64];
#pragma unroll
            for (int q = 0; q < 64; ++q) acc[q] = 0.f;
            const float ref = dir == 0 ? cum[hl * 128 + 127] : suf[hl * 128 + 0];
            for (int j = 0; j < 128; ++j) {
                const float wj = __expf(ref - (dir == 0 ? cum[hl * 128 + j] : suf[hl * 128 + j])) * dts[dir * 512 + hl * 128 + j];
                const float bw = bf2f(Bs[j * 64 + n]) * wj;
#pragma unroll
                for (int q = 0; q < 64; ++q) acc[q] += bf2f(xs[j * 256 + hl * 64 + q]) * bw;
            }
            float* dst = ST + ((((size_t)dir * BATCH + b) * NCHUNK + c) * 8 + h) * 4096;
#pragma unroll
            for (int q = 0; q < 64; ++q) dst[q * 64 + n] = acc[q];
        }
    }
}

__device__ __forceinline__ void phase_scan(const Params& p) {
    bf16_t* ST = wsp<bf16_t>(p, WS_ST); const float* ACUM = wsp<float>(p, WS_ACUM);
    const int tid = tid_opaque();
    if (tid < 256) {
        for (int idx = blockIdx.x * 256 + tid; idx < 2 * BATCH * 8 * 512; idx += gridDim.x * 256) {
            const int e = (idx & 511) * 8, h = (idx >> 9) & 7, b = (idx >> 12) & 7, dir = idx >> 15;
            u32x4* base = (u32x4*)(ST + (((size_t)dir * BATCH + b) * NCHUNK * 8 + h) * 4096 + e);
            float c[8] = {0.f, 0.f, 0.f, 0.f, 0.f, 0.f, 0.f, 0.f};
#pragma unroll
            for (int kb = 0; kb < NCHUNK; kb += 16) {
                u32x4 s[16]; float dec[16];
#pragma unroll
                for (int k = 0; k < 16; ++k) { const int ck = dir ? NCHUNK - 1 - (kb + k) : kb + k; s[k] = base[(size_t)ck * 8 * 512]; }
#pragma unroll
                for (int k = 0; k < 16; ++k) { const int ck = dir ? NCHUNK - 1 - (kb + k) : kb + k; dec[k] = dir == 0 ? ACUM[(size_t)(b * SEQ + ck * CHUNK + 127) * 16 + h] : ACUM[(size_t)(b * SEQ + ck * CHUNK) * 16 + 8 + h]; }
                __builtin_amdgcn_sched_barrier(0);
#pragma unroll
                for (int k = 0; k < 16; ++k) { const int ck = dir ? NCHUNK - 1 - (kb + k) : kb + k;
                    base[(size_t)ck * 8 * 512] = (u32x4){pk2(c[0], c[1]), pk2(c[2], c[3]), pk2(c[4], c[5]), pk2(c[6], c[7])};
                    const float d = __expf(dec[k]); const u32x4 v = s[k];
                    c[0] = c[0] * d + bf2f(v.x & 0xffff); c[1] = c[1] * d + bf2f(v.x >> 16); c[2] = c[2] * d + bf2f(v.y & 0xffff); c[3] = c[3] * d + bf2f(v.y >> 16);
                    c[4] = c[4] * d + bf2f(v.z & 0xffff); c[5] = c[5] * d + bf2f(v.z >> 16); c[6] = c[6] * d + bf2f(v.w & 0xffff); c[7] = c[7] * d + bf2f(v.w >> 16); }
                __builtin_amdgcn_sched_barrier(0);
            }
        }
    }
}

__device__ __forceinline__ void phase_attn_naive(const Params& p) {
    bf16_t* QO = wsp<bf16_t>(p, WS_QO); const bf16_t* Kb = wsp<bf16_t>(p, WS_K); const bf16_t* Vb = wsp<bf16_t>(p, WS_V);
    const int nth = gridDim.x * 512;
    for (int idx = blockIdx.x * 512 + tid_opaque(); idx < BATCH * NQH * SEQ; idx += nth) {
        const int qi = idx % SEQ, h = (idx / SEQ) % NQH, b = idx / (SEQ * NQH), kvh = h / 4;
        bf16_t* qp = QO + (size_t)(b * SEQ + qi) * 512 + h * 64;
        float q[64], o[64];
#pragma unroll
        for (int d = 0; d < 64; ++d) { q[d] = bf2f(qp[d]); o[d] = 0.f; }
        float m = -1e30f, l = 0.f;
        const bf16_t* kp = Kb + (size_t)b * SEQ * 128 + kvh * 64; const bf16_t* vp = Vb + (size_t)b * SEQ * 128 + kvh * 64;
        for (int j = 0; j < SEQ; ++j) {
            float s = 0.f;
#pragma unroll
            for (int c = 0; c < 8; ++c) { const u32x4 v = *(const u32x4*)(kp + (size_t)j * 128 + 8 * c);
                s += q[8 * c] * bf2f(v.x & 0xffff) + q[8 * c + 1] * bf2f(v.x >> 16) + q[8 * c + 2] * bf2f(v.y & 0xffff) + q[8 * c + 3] * bf2f(v.y >> 16)
                   + q[8 * c + 4] * bf2f(v.z & 0xffff) + q[8 * c + 5] * bf2f(v.z >> 16) + q[8 * c + 6] * bf2f(v.w & 0xffff) + q[8 * c + 7] * bf2f(v.w >> 16); }
            if (s > m) { const float f = exp2f(m - s); l *= f;
#pragma unroll
                for (int d = 0; d < 64; ++d) o[d] *= f;
                m = s; }
            const float pr = exp2f(s - m); l += pr;
#pragma unroll
            for (int c = 0; c < 8; ++c) { const u32x4 v = *(const u32x4*)(vp + (size_t)j * 128 + 8 * c);
                o[8 * c] += pr * bf2f(v.x & 0xffff); o[8 * c + 1] += pr * bf2f(v.x >> 16); o[8 * c + 2] += pr * bf2f(v.y & 0xffff); o[8 * c + 3] += pr * bf2f(v.y >> 16);
                o[8 * c + 4] += pr * bf2f(v.z & 0xffff); o[8 * c + 5] += pr * bf2f(v.z >> 16); o[8 * c + 6] += pr * bf2f(v.w & 0xffff); o[8 * c + 7] += pr * bf2f(v.w >> 16); }
        }
        const float il = 1.f / l;
#pragma unroll
        for (int d = 0; d < 64; d += 2) *(unsigned*)(qp + d) = pk2(o[d] * il, o[d + 1] * il);
    }
}

__device__ __forceinline__ void phase_ssd_final_naive(const Params& p, unsigned char* lds) {
    const int tid = tid_opaque();
    float* cs = (float*)lds;
    float* ssum = cs + 8 * 4096;
    const bf16_t* YD = wsp<bf16_t>(p, WS_YD); const bf16_t* CC = wsp<bf16_t>(p, WS_CC); const float* ACUM = wsp<float>(p, WS_ACUM); const float* ST = wsp<float>(p, WS_ST);
    const bf16_t* Z = wsp<bf16_t>(p, WS_Z); bf16_t* SSD = wsp<bf16_t>(p, WS_SSD);
    for (int item = blockIdx.x; item < BATCH * NCHUNK; item += gridDim.x) {
        const int c = item % NCHUNK, b = item / NCHUNK, t0 = b * SEQ + c * CHUNK;
        const int i = tid & 127, hq = tid >> 7, t = t0 + i;
        float ss = 0.f;
        for (int s = 0; s < 2; ++s) {
            __syncthreads();
            for (int idx = tid; idx < 8 * 4096; idx += 512) { const int mtx = idx >> 12, e = idx & 4095, hh = 2 * (mtx >> 1) + s, dir = mtx & 1;
                cs[idx] = ST[((((size_t)dir * BATCH + b) * NCHUNK + c) * 8 + hh) * 4096 + e]; }
            __syncthreads();
            const int h = 2 * hq + s, g = h >> 2;
            float Cr[64];
#pragma unroll
            for (int n = 0; n < 64; ++n) Cr[n] = bf2f(CC[(size_t)t * 128 + 64 * g + n]);
            const float ef = __expf(ACUM[(size_t)t * 16 + h]), eb = __expf(ACUM[(size_t)t * 16 + 8 + h]);
            const float* cf = cs + (hq * 2 + 0) * 4096; const float* cbk = cs + (hq * 2 + 1) * 4096;
#pragma unroll 2
            for (int q = 0; q < 64; ++q) {
                float af = 0.f, ab = 0.f;
#pragma unroll
                for (int n = 0; n < 64; ++n) { af += Cr[n] * cf[q * 64 + n]; ab += Cr[n] * cbk[q * 64 + n]; }
                const float y = bf2f(YD[(size_t)t * 512 + h * 64 + q]) + af * ef + ab * eb;
                const float v = y * bf2f(Z[(size_t)t * 512 + h * 64 + q]);
                SSD[(size_t)t * 512 + h * 64 + q] = (bf16_t)f2bf(v); ss += v * v;
            }
        }
        ssum[hq * 128 + i] = ss;
        __syncthreads();
        const float tot = ssum[i] + ssum[128 + i] + ssum[256 + i] + ssum[384 + i];
        const float rstd = 1.f / sqrtf(tot * (1.f / 512.f) + EPS);
        for (int q = 0; q < 128; q += 2) { const int col = 2 * hq * 64 + q;
            const unsigned u = *(const unsigned*)(SSD + (size_t)t * 512 + col);
            *(unsigned*)(SSD + (size_t)t * 512 + col) = pk2(bf2f(u & 0xffff) * rstd * p.ssd_norm_w[col], bf2f(u >> 16) * rstd * p.ssd_norm_w[col + 1]); }
    }
}

__device__ __forceinline__ void phase_merged_naive(const Params& p) {
    const bf16_t* AT = wsp<bf16_t>(p, WS_QO); const bf16_t* SS = wsp<bf16_t>(p, WS_SSD); const bf16_t* Wa = wsp<bf16_t>(p, WS_WA); const bf16_t* Wsd = wsp<bf16_t>(p, WS_WS);
    const bf16_t* G = wsp<bf16_t>(p, WS_G); bf16_t* MG = wsp<bf16_t>(p, WS_MERGED);
    const int lane = tid_opaque() & 63, gw = blockIdx.x * 8 + (tid_opaque() >> 6), NGW = gridDim.x * 8, r = lane & 31, h = lane >> 5;
    const int tn = DM / 32, nt = (T / 32) * tn;
    for (int t = gw; t < nt; t += NGW) {
        const int pm = t / tn, pn = t % tn;
        const bf16_t* a1 = AT + (size_t)(pm * 32 + r) * 512 + 8 * h; const bf16_t* a2 = SS + (size_t)(pm * 32 + r) * 512 + 8 * h;
        const bf16_t* b1 = Wa + (size_t)(pn * 32 + r) * 512 + 8 * h; const bf16_t* b2 = Wsd + (size_t)(pn * 32 + r) * 512 + 8 * h;
        f32x16 c1 = {0.f, 0.f, 0.f, 0.f, 0.f, 0.f, 0.f, 0.f, 0.f, 0.f, 0.f, 0.f, 0.f, 0.f, 0.f, 0.f}, c2 = c1;
        for (int k = 0; k < 512; k += 16) {
            c1 = __builtin_amdgcn_mfma_f32_32x32x16_bf16(*(const bf16x8*)(a1 + k), *(const bf16x8*)(b1 + k), c1, 0, 0, 0);
            c2 = __builtin_amdgcn_mfma_f32_32x32x16_bf16(*(const bf16x8*)(a2 + k), *(const bf16x8*)(b2 + k), c2, 0, 0, 0); }
#pragma unroll
        for (int i = 0; i < 16; ++i) { const int row = pm * 32 + (i & 3) + 8 * (i >> 2) + 4 * h, col = pn * 32 + r;
            const float ga = bf2f(G[(size_t)row * 2048 + col]), gs = bf2f(G[(size_t)row * 2048 + 1024 + col]);
            MG[(size_t)row * DM + col] = (bf16_t)f2bf(ga * c1[i] + gs * c2[i]); }
    }
}
__device__ __forceinline__ void phase_wout_naive(const Params& p) {
    const bf16_t* MG = wsp<bf16_t>(p, WS_MERGED); const bf16_t* Wo = wsp<bf16_t>(p, WS_WO); const float* x = p.x; float* out = p.out;
    auto af = [=](int row) { return MG + (size_t)row * DM; };
    auto bf = [=](int, int col) { return Wo + (size_t)col * DM; };
    auto epi = [=](int row, int col, float v) { out[(size_t)row * DM + col] = x[(size_t)row * DM + col] + v; };
    gemm_naive(T, DM, DM, af, bf, epi);
}

typedef __attribute__((ext_vector_type(2))) __bf16 bf2_t;
struct bf2x4 { bf2_t a, b, c, d; };
__device__ __forceinline__ void phase_route(const Params& p, unsigned char* lds) {
    const int tid = tid_opaque(), lane = tid & 63, wave = tid >> 6;
    float* lg = (float*)lds;
    int* bk_l = (int*)(lds + 128 * 32 * 4);
    const bf16_t* WRT = (const bf16_t*)(p.ws + WS_ROUTE + RT_WRT);
    int* tb = (int*)(p.ws + WS_ROUTE + RT_BUCKET); int* trk = (int*)(p.ws + WS_ROUTE + RT_RANK); float* twa = (float*)(p.ws + WS_ROUTE + RT_WA); float* twb = (float*)(p.ws + WS_ROUTE + RT_WB);
    int* cnt = (int*)(p.ws + WS_ROUTE + RT_CNT); float* RSTD = (float*)(p.ws + WS_ROUTE + RT_RSTD);
    float* ssq = (float*)(lds + 128 * 32 * 4 + 512);
    const bf16_t* X1 = wsp<bf16_t>(p, WS_X1B);
    for (int tile = blockIdx.x; tile < NRT; tile += gridDim.x) {
        __syncthreads();
        {
            const int rt = wave & 3, kh = wave >> 2, r = lane & 31, hh = lane >> 5;
            const bf16_t* a = X1 + (size_t)(tile * 128 + rt * 32 + r) * DM + kh * 512 + 8 * hh; const bf16_t* b = WRT + (size_t)r * DM + kh * 512 + 8 * hh;
            f32x16 acc = {0.f, 0.f, 0.f, 0.f, 0.f, 0.f, 0.f, 0.f, 0.f, 0.f, 0.f, 0.f, 0.f, 0.f, 0.f, 0.f};
            float ss = 0.f;
            {
                bf16x8 av[32], bv[16];
#pragma unroll
                for (int u = 0; u < 16; ++u) { av[u] = *(const bf16x8*)(a + 16 * u); bv[u] = *(const bf16x8*)(b + 16 * u); }
#pragma unroll
                for (int u = 0; u < 16; ++u) av[16 + u] = *(const bf16x8*)(a + 256 + 16 * u);
                __builtin_amdgcn_sched_barrier(0);
#pragma unroll
                for (int u = 0; u < 16; ++u) { acc = __builtin_amdgcn_mfma_f32_32x32x16_bf16(av[u], bv[u], acc, 0, 0, 0);
                    const bf2x4 q = __builtin_bit_cast(bf2x4, av[u]);
                    ss = __builtin_amdgcn_fdot2_f32_bf16(q.a, q.a, ss, false); ss = __builtin_amdgcn_fdot2_f32_bf16(q.b, q.b, ss, false);
                    ss = __builtin_amdgcn_fdot2_f32_bf16(q.c, q.c, ss, false); ss = __builtin_amdgcn_fdot2_f32_bf16(q.d, q.d, ss, false); }
                __builtin_amdgcn_sched_barrier(0);
#pragma unroll
                for (int u = 0; u < 16; ++u) bv[u] = *(const bf16x8*)(b + 256 + 16 * u);
                __builtin_amdgcn_sched_barrier(0);
#pragma unroll
                for (int u = 0; u < 16; ++u) { acc = __builtin_amdgcn_mfma_f32_32x32x16_bf16(av[16 + u], bv[u], acc, 0, 0, 0);
                    const bf2x4 q = __builtin_bit_cast(bf2x4, av[16 + u]);
                    ss = __builtin_amdgcn_fdot2_f32_bf16(q.a, q.a, ss, false); ss = __builtin_amdgcn_fdot2_f32_bf16(q.b, q.b, ss, false);
                    ss = __builtin_amdgcn_fdot2_f32_bf16(q.c, q.c, ss, false); ss = __builtin_amdgcn_fdot2_f32_bf16(q.d, q.d, ss, false); }
                __builtin_amdgcn_sched_barrier(0);
            }
            ssq[(kh * 2 + hh) * 128 + rt * 32 + r] = ss;
            if (kh == 1) {
#pragma unroll
                for (int i = 0; i < 16; ++i) lg[(rt * 32 + (i & 3) + 8 * (i >> 2) + 4 * hh) * 32 + r] = acc[i];
            }
            __syncthreads();
            if (kh == 0) {
#pragma unroll
                for (int i = 0; i < 16; ++i) lg[(rt * 32 + (i & 3) + 8 * (i >> 2) + 4 * hh) * 32 + r] += acc[i];
            }
        }
        __syncthreads();
        int rk_c = 0, my_c = 0, bk_c = 0;
        if (tid < 128) {
            const int m = tile * 128 + tid; const float* L = lg + tid * 32; const float rs = 1.f / sqrtf(((ssq[tid] + ssq[128 + tid]) + (ssq[256 + tid] + ssq[384 + tid])) * (1.f / DM) + EPS); RSTD[m] = rs;
            float gl[4]; float gm = -1e30f;
#pragma unroll
            for (int g = 0; g < 4; ++g) { gl[g] = L[g] * rs + p.b_rg[g]; gm = fmaxf(gm, gl[g]); }
            float gs = 0.f; int gi = 0; float gbest = -1e30f;
#pragma unroll
            for (int g = 0; g < 4; ++g) { const float e = __expf(gl[g] - gm); gs += e; if (gl[g] > gbest) { gbest = gl[g]; gi = g; } }
            const float gval = __expf(gbest - gm) / gs;
            float fl[4]; float fm = -1e30f;
#pragma unroll
            for (int e = 0; e < 4; ++e) { fl[e] = L[4 + 4 * gi + e] * rs + p.b_re[4 * gi + e]; fm = fmaxf(fm, fl[e]); }
            int i0 = 0; float b0 = -1e30f;
#pragma unroll
            for (int e = 0; e < 4; ++e) if (fl[e] > b0) { b0 = fl[e]; i0 = e; }
            int i1 = 0; float b1 = -1e30f;
#pragma unroll
            for (int e = 0; e < 4; ++e) if (e != i0 && fl[e] > b1) { b1 = fl[e]; i1 = e; }
            const float e0 = __expf(b0 - fm), e1 = __expf(b1 - fm); const float w0 = e0 / (e0 + e1) * gval, w1 = e1 / (e0 + e1) * gval;
            const int a = min(i0, i1), bb = max(i0, i1); const float wa = (i0 < i1) ? w0 : w1, wb = (i0 < i1) ? w1 : w0;
            const int pidx = a == 0 ? bb - 1 : (a == 1 ? bb + 1 : 5);
            const int bucket = gi * 6 + pidx;
            tb[m] = bucket; twa[m] = wa; twb[m] = wb;
            const unsigned long long below = (1ull << lane) - 1ull; int rk = 0, myc = 0;
#pragma unroll
            for (int k = 0; k < NBUCKET; ++k) { const unsigned long long mk = __ballot(bucket == k); if (bucket == k) rk = __popcll(mk & below); if (lane == k) myc = __popcll(mk); }
            if (wave == 0) { if (lane < NBUCKET) bk_l[lane] = myc; trk[m] = rk; }
            rk_c = rk; my_c = myc; bk_c = bucket;
        }
        __syncthreads();
        if (wave == 1) { trk[tile * 128 + tid] = rk_c + bk_l[bk_c]; if (lane < NBUCKET) cnt[tile * NBUCKET + lane] = bk_l[lane] + my_c; }
    }
}

__device__ __forceinline__ void phase_gather(const Params& p, unsigned char* lds) {
    const int tid = tid_opaque(), lane = tid & 63, wave = tid >> 6;
    int* cl = (int*)lds;
    int* start = cl + NRT * NBUCKET;
    int* tot = start + 32;
    int* lt = tot + 32;
    const int* cnt = (const int*)(p.ws + WS_ROUTE + RT_CNT); const int* tb = (const int*)(p.ws + WS_ROUTE + RT_BUCKET); const int* trk = (const int*)(p.ws + WS_ROUTE + RT_RANK);
    int* perm = (int*)(p.ws + WS_ROUTE + RT_PERM); int* tbk = (int*)(p.ws + WS_ROUTE + RT_TB);
    float* swa = (float*)(p.ws + WS_ROUTE + RT_SWA); float* swb = (float*)(p.ws + WS_ROUTE + RT_SWB);
    const float* twa = (const float*)(p.ws + WS_ROUTE + RT_WA); const float* twb = (const float*)(p.ws + WS_ROUTE + RT_WB);
    const float* RSTD = (const float*)(p.ws + WS_ROUTE + RT_RSTD); float* srs = (float*)(p.ws + WS_ROUTE + RT_SRS);
    static_assert(NRT * NBUCKET == 3 * 512 * 4 && NRT % 64 == 0 && NRT > NBUCKET, "count table = three 16-byte loads per thread");
    for (int tile = blockIdx.x; tile < NRT; tile += gridDim.x) {
        const int m = tile * 128 + (tid & 127);
        const u32x4 c0 = ((const u32x4*)cnt)[tid], c1 = ((const u32x4*)cnt)[tid + 512], c2 = ((const u32x4*)cnt)[tid + 1024];
        const int bkt = tb[m], rk = trk[m]; const float wa = twa[m], wb = twb[m], rs = RSTD[m];
        __builtin_amdgcn_sched_barrier(0);
        __syncthreads();
        ((u32x4*)cl)[tid] = c0; ((u32x4*)cl)[tid + 512] = c1; ((u32x4*)cl)[tid + 1024] = c2;
        __syncthreads();
        for (int k = wave; k < NBUCKET; k += 8) { int sa = 0, sl = 0;
#pragma unroll
            for (int q = 0; q < NRT / 64; ++q) { const int t = lane + 64 * q; const int c = cl[t * NBUCKET + k]; sa += c; sl += (t < tile) ? c : 0; }
            const float fa = wave_sum((float)sa), fl = wave_sum((float)sl);
            if (lane == 0) { tot[k] = (int)fa; lt[k] = (int)fl; } }
        __syncthreads();
        if (tid < 128) { int st = 0;
#pragma unroll
            for (int j = 0; j < NBUCKET; ++j) { const int pj = (tot[j] + 255) & ~255; st += (j < bkt) ? pj : 0; }
            const int d = st + lt[bkt] + rk; perm[d] = m; swa[d] = wa; swb[d] = wb; srs[d] = rs; }
        if (tile < NBUCKET) {
            int st = 0, pk = 0, tk = 0;
#pragma unroll
            for (int j = 0; j < NBUCKET; ++j) { const int tj = tot[j], pj = (tj + 255) & ~255; st += (j < tile) ? pj : 0; if (j == tile) { pk = pj; tk = tj; } }
            for (int r = st + tk + tid; r < st + pk; r += 512) { perm[r] = -1; swa[r] = 0.f; swb[r] = 0.f; srs[r] = 0.f; }
        } else if (tile == NBUCKET) {
            int a = 0;
            for (int t = tid; t < TS / 256; t += 512) { int bk = -1; a = 0;
#pragma unroll
                for (int j = 0; j < NBUCKET; ++j) { const int pj = (tot[j] + 255) & ~255; if (t * 256 >= a && t * 256 < a + pj) bk = j; a += pj; }
                tbk[t] = bk; }
            if (tid == 0) { a = 0;
#pragma unroll
                for (int j = 0; j < NBUCKET; ++j) a += (tot[j] + 255) & ~255;
                tbk[TS / 256] = a / 256; }
        }
    }
}
__device__ __forceinline__ void phase_gather_old(const Params& p, unsigned char* lds) {
    const int tid = tid_opaque(), lane = tid & 63, wave = tid >> 6;
    int* cl = (int*)lds;
    int* start = cl + NRT * NBUCKET;
    int* tot = start + 32;
    int* mybase = tot + 32;
    const int* cnt = (const int*)(p.ws + WS_ROUTE + RT_CNT); const int* tb = (const int*)(p.ws + WS_ROUTE + RT_BUCKET); const int* trk = (const int*)(p.ws + WS_ROUTE + RT_RANK);
    int* perm = (int*)(p.ws + WS_ROUTE + RT_PERM); int* tbk = (int*)(p.ws + WS_ROUTE + RT_TB);
    float* swa = (float*)(p.ws + WS_ROUTE + RT_SWA); float* swb = (float*)(p.ws + WS_ROUTE + RT_SWB);
    const float* twa = (const float*)(p.ws + WS_ROUTE + RT_WA); const float* twb = (const float*)(p.ws + WS_ROUTE + RT_WB);
    const float* RSTD = (const float*)(p.ws + WS_ROUTE + RT_RSTD); float* srs = (float*)(p.ws + WS_ROUTE + RT_SRS);
    const bf16_t* H2 = wsp<bf16_t>(p, WS_H); bf16_t* XS = wsp<bf16_t>(p, WS_XS);
    for (int i = tid; i < NRT * NBUCKET; i += 512) cl[i] = cnt[i];
    __syncthreads();
    for (int k = wave; k < NBUCKET; k += 8) { int s = 0;
#pragma unroll
        for (int q = 0; q < NRT / 64; ++q) s += cl[(lane + 64 * q) * NBUCKET + k];
#pragma unroll
        for (int o = 1; o < 64; o <<= 1) s += __shfl_xor(s, o);
        if (lane == 0) tot[k] = s; }
    __syncthreads();
    if (tid == 0) { int s = 0; for (int k = 0; k < NBUCKET; ++k) { start[k] = s; s += (tot[k] + 255) & ~255; } start[NBUCKET] = s; }
    __syncthreads();
    if (blockIdx.x == 0) {
        for (int k = 0; k < NBUCKET; ++k) { const int lo = start[k] + tot[k], hi = start[k + 1]; for (int r = lo + tid; r < hi; r += 512) { perm[r] = -1; swa[r] = 0.f; swb[r] = 0.f; srs[r] = 0.f; } }
        const int ntile = start[NBUCKET] / 256;
        for (int t = tid; t < TS / 256; t += 512) { int bk = -1; if (t < ntile) { for (int k = 0; k < NBUCKET; ++k) if (t * 256 >= start[k] && t * 256 < start[k + 1]) bk = k; } tbk[t] = bk; }
        if (tid == 0) tbk[TS / 256] = ntile;
    }
    for (int tile = blockIdx.x; tile < NRT; tile += gridDim.x) {
        __syncthreads();
        for (int k = wave; k < NBUCKET; k += 8) { int s = 0;
#pragma unroll
            for (int q = 0; q < NRT / 64; ++q) { const int t = lane + 64 * q; s += (t < tile) ? cl[t * NBUCKET + k] : 0; }
#pragma unroll
            for (int o = 1; o < 64; o <<= 1) s += __shfl_xor(s, o);
            if (lane == 0) mybase[k] = start[k] + s; }
        __syncthreads();
#if USE_PG8 && FUSE_GATHER
        if (lane < 16) {
            const int m = tile * 128 + wave * 16 + lane;
            const int bkt = tb[m], rk = trk[m]; const float wa = twa[m], wb = twb[m], rs = RSTD[m];
            const int d = mybase[bkt] + rk;
            perm[d] = m; swa[d] = wa; swb[d] = wb; srs[d] = rs;
        }
#else
        {
            int dest[16];
#pragma unroll
            for (int q = 0; q < 16; ++q) { const int m = tile * 128 + wave * 16 + q; dest[q] = mybase[tb[m]] + trk[m]; }
#pragma unroll
            for (int q = 0; q < 16; ++q) { const int m = tile * 128 + wave * 16 + q; if (lane == 0) { perm[dest[q]] = m; swa[dest[q]] = twa[m]; swb[dest[q]] = twb[m]; } }
#if !(USE_PG8 && FUSE_GATHER)
#pragma unroll
            for (int q0 = 0; q0 < 16; q0 += 8) {
                u32x4 v0[8], v1[8];
#pragma unroll
                for (int q = 0; q < 8; ++q) { const u32x4* src = (const u32x4*)(H2 + (size_t)(tile * 128 + wave * 16 + q0 + q) * DM); v0[q] = src[lane]; v1[q] = src[64 + lane]; }
#pragma unroll
                for (int q = 0; q < 8; ++q) { u32x4* dst = (u32x4*)(XS + (size_t)dest[q0 + q] * DM); dst[lane] = v0[q]; dst[64 + lane] = v1[q]; }
            }
#endif
        }
#endif
    }
}

__device__ __forceinline__ void phase_moe1_naive(const Params& p) {
    const bf16_t* XS = wsp<bf16_t>(p, WS_XS); const bf16_t* W13 = wsp<bf16_t>(p, WS_W13); bf16_t* HID = wsp<bf16_t>(p, WS_HID);
    const int* perm = (const int*)(p.ws + WS_ROUTE + RT_PERM); const int* tbk = (const int*)(p.ws + WS_ROUTE + RT_TB);
    const float* twa = (const float*)(p.ws + WS_ROUTE + RT_WA); const float* twb = (const float*)(p.ws + WS_ROUTE + RT_WB);
    const int lane = tid_opaque() & 63, gw = blockIdx.x * 8 + (tid_opaque() >> 6), NGW = gridDim.x * 8, r = lane & 31, h = lane >> 5;
    const int nrows = tbk[TS / 256] * 256, tn = 1024 / 32, nt = (nrows / 32) * tn;
    for (int t = gw; t < nt; t += NGW) {
        const int pm = t / tn, pn = t % tn, bucket = tbk[pm / 8], g = bucket / 6; int a, b; pair_of(bucket % 6, a, b);
        const int slot = pn >> 4, e = g * 4 + (slot ? b : a), j0 = (pn & 15) * 32;
        const bf16_t* ap = XS + (size_t)(pm * 32 + r) * DM + 8 * h;
        const bf16_t* b1 = W13 + ((size_t)e * 1024 + 2 * (j0 + r)) * DM + 8 * h; const bf16_t* b3 = b1 + DM;
        f32x16 c1 = {0.f, 0.f, 0.f, 0.f, 0.f, 0.f, 0.f, 0.f, 0.f, 0.f, 0.f, 0.f, 0.f, 0.f, 0.f, 0.f}, c3 = c1;
        for (int k = 0; k < DM; k += 16) { const bf16x8 av = *(const bf16x8*)(ap + k);
            c1 = __builtin_amdgcn_mfma_f32_32x32x16_bf16(av, *(const bf16x8*)(b1 + k), c1, 0, 0, 0);
            c3 = __builtin_amdgcn_mfma_f32_32x32x16_bf16(av, *(const bf16x8*)(b3 + k), c3, 0, 0, 0); }
#pragma unroll
        for (int i = 0; i < 16; ++i) { const int row = pm * 32 + (i & 3) + 8 * (i >> 2) + 4 * h; const int tok = perm[row];
            const float w = tok < 0 ? 0.f : (slot ? twb[tok] : twa[tok]);
            HID[(size_t)row * 1024 + slot * 512 + j0 + r] = (bf16_t)f2bf(w * silu_f(c1[i]) * c3[i]); }
    }
}
__device__ __forceinline__ void phase_moe2_naive(const Params& p) {
    const bf16_t* HID = wsp<bf16_t>(p, WS_HID); const bf16_t* W2P = wsp<bf16_t>(p, WS_W2P); float* out = p.out;
    const int* perm = (const int*)(p.ws + WS_ROUTE + RT_PERM); const int* tbk = (const int*)(p.ws + WS_ROUTE + RT_TB);
    const int nrows = tbk[TS / 256] * 256;
    auto af = [=](int row) { return HID + (size_t)row * 1024; };
    auto bf = [=](int row0, int col) { return W2P + ((size_t)tbk[row0 / 256] * 1024 + col) * 1024; };
    auto epi = [=](int row, int col, float v) { const int tok = perm[row]; if (tok >= 0) out[(size_t)tok * DM + col] += v; };
    gemm_naive(nrows, DM, 1024, af, bf, epi);
}


#include <hip/hip_bf16.h>
namespace attn_body {
using bf16=__hip_bfloat16;
using bf16x8=__attribute__((ext_vector_type(8)))short;
using s16x4=__attribute__((ext_vector_type(4)))short;
using f32x16=__attribute__((ext_vector_type(16)))float;
using u32x4=__attribute__((ext_vector_type(4)))unsigned;
constexpr int BATCH=8,NHEAD=8,SEQ=4096,D=64,QP=512,KP=128;
constexpr int NW=8,QBLK=32,QB=QBLK*NW,KVBLK=64,NQB=SEQ/QB;
constexpr int ATTN_UNIT_ROWS=QB;
__device__ __forceinline__ int crow(int r,int hi){return (r&3)+8*(r>>2)+4*hi;}
#define SBAR() __builtin_amdgcn_sched_barrier(0)
__device__ __forceinline__ void cmask(f32x16&p0,f32x16&p1,int jb,int qrel,int hi){
  const float NEG=-INFINITY; int kb=64*jb+4*hi;
  #pragma unroll
  for(int r=0;r<16;++r){int kv=kb+(r&3)+8*(r>>2); if(kv>qrel)p0[r]=NEG; if(kv+32>qrel)p1[r]=NEG;}
}

constexpr int NSLOT=3, SLOTB=8192;
constexpr int LDS_K=0, LDS_V=NSLOT*SLOTB, LDS_WS=2*NSLOT*SLOTB, LDS_OST=LDS_WS+NW*64*4, LDS_BYTES=LDS_OST+NW*4096;
constexpr float C2=0.125f*1.4426950408889634f;
__device__ __forceinline__ void glds16(const void*gsrc,unsigned lds_dst){unsigned keep;
  asm volatile("s_mov_b32 %0, m0\n\ts_mov_b32 m0, %2\n\ts_nop 0\n\tglobal_load_lds_dwordx4 %1, off\n\ts_mov_b32 m0, %0":"=&s"(keep):"v"(gsrc),"s"(lds_dst):"memory");}
__device__ __forceinline__ float max3f(float a,float b,float c){float r;asm("v_max3_f32 %0, %1, %2, %3":"=v"(r):"v"(a),"v"(b),"v"(c));return r;}
__device__ __forceinline__ float max2f(float a,float b){float r;asm("v_max_f32_e32 %0, %1, %2":"=v"(r):"v"(a),"v"(b));return r;}
__device__ __forceinline__ float fadd_s(float a,float b){float r;asm("v_add_f32_e32 %0, %1, %2":"=v"(r):"v"(a),"v"(b));return r;}
__device__ __forceinline__ float fsub_s(float a,float b){float r;asm("v_sub_f32_e32 %0, %1, %2":"=v"(r):"v"(a),"v"(b));return r;}
typedef float f32x2_t __attribute__((ext_vector_type(2))); typedef __bf16 bf16x2_t __attribute__((ext_vector_type(2)));
__device__ __forceinline__ unsigned cvtpk_s(float lo,float hi){f32x2_t v={lo,hi};bf16x2_t b=__builtin_convertvector(v,bf16x2_t);return __builtin_bit_cast(unsigned,b);}
#define WAIT_BAR(N) asm volatile("s_waitcnt vmcnt(" #N ") lgkmcnt(0)\n\ts_barrier":::"memory")

__device__ __forceinline__ void qkt(f32x16&p0,f32x16&p1,const char*Kslot,const bf16x8*qr,const f32x16&negm,int r32,int hi){
  const char*kb=Kslot+hi*1024+r32*16;
  #pragma unroll
  for(int d0=0;d0<4;++d0){
    const bf16x8 b0=*reinterpret_cast<const bf16x8*>(kb+d0*2048);
    const bf16x8 b1=*reinterpret_cast<const bf16x8*>(kb+d0*2048+512);
    if(d0==0){p0=__builtin_amdgcn_mfma_f32_32x32x16_bf16(b0,qr[0],negm,0,0,0);p1=__builtin_amdgcn_mfma_f32_32x32x16_bf16(b1,qr[0],negm,0,0,0);}
    else{p0=__builtin_amdgcn_mfma_f32_32x32x16_bf16(b0,qr[d0],p0,0,0,0);p1=__builtin_amdgcn_mfma_f32_32x32x16_bf16(b1,qr[d0],p1,0,0,0);}}
}
typedef __attribute__((address_space(3))) const char* lds_cptr;
typedef short v4i16_t __attribute__((ext_vector_type(4)));
__device__ __forceinline__ void kload8(bf16x8*kf,lds_cptr kp){
  kf[0]=*(const __attribute__((address_space(3))) bf16x8*)(kp);      kf[1]=*(const __attribute__((address_space(3))) bf16x8*)(kp+512);
  kf[2]=*(const __attribute__((address_space(3))) bf16x8*)(kp+2048); kf[3]=*(const __attribute__((address_space(3))) bf16x8*)(kp+2560);
  kf[4]=*(const __attribute__((address_space(3))) bf16x8*)(kp+4096); kf[5]=*(const __attribute__((address_space(3))) bf16x8*)(kp+4608);
  kf[6]=*(const __attribute__((address_space(3))) bf16x8*)(kp+6144); kf[7]=*(const __attribute__((address_space(3))) bf16x8*)(kp+6656);
}
__device__ __forceinline__ void kload2(bf16x8*kf,lds_cptr kp,int j){ kf[2*j]=*(const __attribute__((address_space(3))) bf16x8*)(kp+j*2048); kf[2*j+1]=*(const __attribute__((address_space(3))) bf16x8*)(kp+j*2048+512); }
__device__ __forceinline__ s16x4 vtr(lds_cptr p){ return __builtin_bit_cast(s16x4,__builtin_amdgcn_ds_read_tr16_b64_v4i16((__attribute__((address_space(3))) v4i16_t*)p)); }
__device__ __forceinline__ float rowmax(const f32x16&p0,const f32x16&p1){
  float a=max3f(p0[0],p0[1],p1[0]),b=max3f(p0[2],p0[3],p1[1]);a=max3f(a,p1[2],p1[3]);
  #pragma unroll
  for(int r=4;r<16;r+=4){a=max3f(a,p0[r],p0[r+1]);b=max3f(b,p0[r+2],p0[r+3]);a=max3f(a,p1[r],p1[r+1]);b=max3f(b,p1[r+2],p1[r+3]);}
  const float m=max2f(a,b);
  auto rr=__builtin_amdgcn_permlane32_swap(__float_as_uint(m),__float_as_uint(m),false,false);
  return max2f(__uint_as_float(rr[0]),__uint_as_float(rr[1]));
}
__device__ __forceinline__ void pv(f32x16*o,int vb,bf16x8 pa0,bf16x8 pa1,bf16x8 pa2,bf16x8 pa3){
  #pragma unroll
  for(int d0=0;d0<2;++d0){s16x4 lo[4],hi[4];
    #pragma unroll
    for(int ks=0;ks<4;++ks){
      asm volatile("ds_read_b64_tr_b16 %0,%1 offset:%c2":"=&v"(lo[ks]):"v"(vb),"i"(d0*4096+ks*1024):"memory");
      asm volatile("ds_read_b64_tr_b16 %0,%1 offset:%c2":"=&v"(hi[ks]):"v"(vb),"i"(d0*4096+ks*1024+512):"memory");}
    asm volatile("s_waitcnt lgkmcnt(0)":::"memory");SBAR();
    #define PK(k) (bf16x8){lo[k][0],lo[k][1],lo[k][2],lo[k][3],hi[k][0],hi[k][1],hi[k][2],hi[k][3]}
    o[d0]=__builtin_amdgcn_mfma_f32_32x32x16_bf16(pa0,PK(0),o[d0],0,0,0);
    o[d0]=__builtin_amdgcn_mfma_f32_32x32x16_bf16(pa1,PK(1),o[d0],0,0,0);
    o[d0]=__builtin_amdgcn_mfma_f32_32x32x16_bf16(pa2,PK(2),o[d0],0,0,0);
    o[d0]=__builtin_amdgcn_mfma_f32_32x32x16_bf16(pa3,PK(3),o[d0],0,0,0);
    #undef PK
  }
}

#ifndef ATTN_STORE16
#define ATTN_STORE16(p,v) (*(u32x4*)(p)=(v))
#endif
template<int THRL> __device__ __forceinline__ void attn_unit(int b,int h,int qb,const bf16*Q,const bf16*__restrict__ K,const bf16*__restrict__ V,bf16*O,char*shm,const float*qnw){
  int tid_=threadIdx.x; asm volatile("":"+v"(tid_));
  const int tid=tid_,lane=tid&63,r32=lane&31,hi=lane>>5; const int wid=__builtin_amdgcn_readfirstlane(tid>>6);
  const long rowbase=(long)b*SEQ; const int q0=qb*QB;
  const bf16*Qw=Q+(rowbase+q0+wid*QBLK)*QP+h*D;
  const bf16*Kh=K+rowbase*KP+(h>>2)*D,*Vh=V+rowbase*KP+(h>>2)*D;
  const unsigned lds0=(unsigned)(uintptr_t)shm;
  float*wsf=(float*)(shm+LDS_WS)+wid*64;
  const bf16*ksrc=Kh+(long)lane*KP+wid*8;
  const bf16*vsrc=Vh+(long)(16*(wid&3)+(lane>>2))*KP+(wid>>2)*32+(lane&3)*8;
  const unsigned kdst=lds0+LDS_K+wid*1024, vdst=lds0+LDS_V+wid*1024;
  #define DMA_K(t,slot) glds16(ksrc+(long)(t)*KVBLK*KP,(unsigned)__builtin_amdgcn_readfirstlane(kdst+(slot)))
  #define DMA_V(t,slot) glds16(vsrc+(long)(t)*KVBLK*KP,(unsigned)__builtin_amdgcn_readfirstlane(vdst+(slot)))
  const int vb0=(int)(lds0+LDS_V)+((lane>>4)&1)*32+(lane&3)*8+(4*hi+((lane&15)>>2))*64;
  const char*Kbase=shm+LDS_K; bf16x8 kf[8];
  const lds_cptr shm3=(lds_cptr)shm; const lds_cptr kp0=shm3+LDS_K+hi*1024+r32*16; const lds_cptr vp0=shm3+LDS_V+((lane>>4)&1)*32+(lane&3)*8+(4*hi+((lane&15)>>2))*64;
  const int NT=SEQ/KVBLK;
  DMA_K(0,0);DMA_V(0,0);DMA_K(1,SLOTB);
  bf16x8 qr[4];
  #pragma unroll
  for(int d0=0;d0<4;++d0)qr[d0]=*reinterpret_cast<const bf16x8*>(&Qw[(long)r32*QP+d0*16+hi*8]);
  {
    float qf[4][8];
    #pragma unroll
    for(int d0=0;d0<4;++d0){
      #pragma unroll
      for(int j=0;j<8;++j)qf[d0][j]=__uint_as_float(((unsigned)(unsigned short)qr[d0][j])<<16);}
    float ss=0.f;
    #pragma unroll
    for(int d0=0;d0<4;++d0){
      #pragma unroll
      for(int j=0;j<8;++j)ss+=qf[d0][j]*qf[d0][j];}
    {auto rr=__builtin_amdgcn_permlane32_swap(__float_as_uint(ss),__float_as_uint(ss),false,false);ss=__uint_as_float(rr[0])+__uint_as_float(rr[1]);}
    const float rstd=1.0f/sqrtf(ss*(1.0f/64.0f)+1e-6f);
    #pragma unroll
    for(int d0=0;d0<4;++d0){
      #pragma unroll
      for(int j=0;j<8;++j)qf[d0][j]*=rstd*qnw[d0*16+hi*8+j];}
    const int pos=q0+wid*QBLK+r32; const float frow=(float)(pos>>6),fcol=(float)(pos&63);
    #pragma unroll
    for(int j=0;j<8;++j){
      const float inv=exp2f(-(float)(hi*8+j)*(13.287712379549449f/16.f));
      const float ar=frow*inv,ac=fcol*inv; const float cr=__cosf(ar),sr=__sinf(ar),cc=__cosf(ac),sc=__sinf(ac);
      const float a0=qf[0][j],a1=qf[1][j],a2=qf[2][j],a3=qf[3][j];
      qf[0][j]=(a0*cr-a1*sr)*C2; qf[1][j]=(a1*cr+a0*sr)*C2; qf[2][j]=(a2*cc-a3*sc)*C2; qf[3][j]=(a3*cc+a2*sc)*C2;}
    #pragma unroll
    for(int d0=0;d0<4;++d0){ u32x4 w={cvtpk_s(qf[d0][0],qf[d0][1]),cvtpk_s(qf[d0][2],qf[d0][3]),cvtpk_s(qf[d0][4],qf[d0][5]),cvtpk_s(qf[d0][6],qf[d0][7])}; qr[d0]=__builtin_bit_cast(bf16x8,w);}
  }
  float zf_=0.f;asm volatile("":"+v"(zf_));
  const f32x16 z16_={zf_,zf_,zf_,zf_,zf_,zf_,zf_,zf_,zf_,zf_,zf_,zf_,zf_,zf_,zf_,zf_};
  float mhat=0.f,l_reg=0.f;f32x16 o[2];o[0]=z16_;o[1]=z16_;f32x16 negm=z16_;asm volatile("":"+v"(negm));
  const int qrel=wid*QBLK+r32;
  #define CMASK(P0,P1,t) do{}while(0)
  bool resc=false;
  #define START(P0,P1) do{ const float rm=rowmax(P0,P1); resc=false; \
    { const float dl=rm; mhat=fadd_s(mhat,dl); \
      _Pragma("unroll") for(int r=0;r<16;++r){P0[r]=fsub_s(P0[r],dl);P1[r]=fsub_s(P1[r],dl);} \
      _Pragma("unroll") for(int r=0;r<16;++r)negm[r]=-mhat; asm volatile("":"+v"(negm)); } \
    _Pragma("unroll") for(int r=0;r<16;++r)P0[r]=__builtin_amdgcn_exp2f(P0[r]); }while(0)
  #define RESC() do{ if(resc){ asm volatile("s_waitcnt lgkmcnt(0)":::"memory"); \
      _Pragma("unroll") for(int d_=0;d_<2;++d_) _Pragma("unroll") for(int r=0;r<16;++r)o[d_][r]*=wsf[crow(r,hi)]; } }while(0)
  f32x16 pA0,pA1,pB0,pB1;
  int sl_prev=0,sl_cur=0,sl_next=SLOTB;
  #define ROT() do{sl_prev=sl_cur;sl_cur=sl_next;sl_next=(sl_next==(NSLOT-1)*SLOTB)?0:sl_next+SLOTB;}while(0)
  DMA_K(2,2*SLOTB);
  WAIT_BAR(3);
  qkt(pA0,pA1,Kbase,qr,negm,r32,hi);asm volatile("s_nop 15\n\ts_nop 7":"+v"(pA0),"+v"(pA1));CMASK(pA0,pA1,0);
  START(pA0,pA1);
  _Pragma("unroll") for(int r=0;r<16;++r)pA1[r]=__builtin_amdgcn_exp2f(pA1[r]);
  WAIT_BAR(0);
  DMA_K(3,0);DMA_V(1,SLOTB);
  ROT();
  kload8(kf,kp0+sl_cur);
  WAIT_BAR(2);
  s16x4 vlo[8],vhi[8]; u32x4 pw0,pw1,pw2,pw3;
  #define PKW(P,B) cvtpk_s(P[B],P[B+1])
  #define PAF(k) __builtin_bit_cast(bf16x8,pw##k)
  #define VFR(i) (bf16x8){vlo[i][0],vlo[i][1],vlo[i][2],vlo[i][3],vhi[i][0],vhi[i][1],vhi[i][2],vhi[i][3]}
  #define PIN(x) asm volatile("":"+v"(x))
  #define MX3(a,b,c) __builtin_fmaxf(__builtin_fmaxf((a),(b)),(c))
  #define GAPA(MF,A0,A1,A2,A3,W0,W1,PW) do{ MF; sacc+=A0; sacc+=A1; sacc+=A2; sacc+=A3; PIN(sacc); W0; W1; PIN(PW); SBAR(); }while(0)
  #define EX(v) __builtin_amdgcn_exp2f(v)
  #define GAPB(MF,X,B) do{ MF; X[B]=EX(X[B]); X[B+1]=EX(X[B+1]); X[B+2]=EX(X[B+2]); X[B+3]=EX(X[B+3]); PIN(X); SBAR(); }while(0)
  #define VRD(i) do{ vlo[i]=vtr(vp_+(((i)>>2)*4096+((i)&3)*1024)); vhi[i]=vtr(vp_+(((i)>>2)*4096+((i)&3)*1024+512)); }while(0)
  #define KRD(G,j) do{ if(G){ kload2(kf,kp0+sl_next,j); SBAR(); } }while(0)
  #define STEP(C0,C1,P0,P1,t,GK,GV,GL) do{ SBAR(); \
    const lds_cptr vp_=vp0+sl_prev; \
    VRD(0); SBAR(); float sacc=(P0[0]+P0[1]); \
    GAPA(C0=__builtin_amdgcn_mfma_f32_32x32x16_bf16(kf[0],qr[0],negm,0,0,0), P0[2],P0[3],P0[4],P0[5],     pw0[0]=PKW(P0,0), pw0[1]=PKW(P0,2), pw0); \
    VRD(4); SBAR(); GAPA(C1=__builtin_amdgcn_mfma_f32_32x32x16_bf16(kf[1],qr[0],negm,0,0,0), P0[6],P0[7],P0[8],P0[9],     pw0[2]=PKW(P0,4), pw0[3]=PKW(P0,6), pw0); \
    VRD(1); SBAR(); GAPA(C0=__builtin_amdgcn_mfma_f32_32x32x16_bf16(kf[2],qr[1],C0,0,0,0),   P0[10],P0[11],P0[12],P0[13], pw1[0]=PKW(P0,8), pw1[1]=PKW(P0,10), pw1); \
    VRD(5); SBAR(); GAPA(C1=__builtin_amdgcn_mfma_f32_32x32x16_bf16(kf[3],qr[1],C1,0,0,0),   P0[14],P0[15],P1[0],P1[1],   pw1[2]=PKW(P0,12),pw1[3]=PKW(P0,14), pw1); \
    VRD(2); SBAR(); GAPA(C0=__builtin_amdgcn_mfma_f32_32x32x16_bf16(kf[4],qr[2],C0,0,0,0),   P1[2],P1[3],P1[4],P1[5],     pw2[0]=PKW(P1,0), pw2[1]=PKW(P1,2), pw2); \
    VRD(6); SBAR(); GAPA(C1=__builtin_amdgcn_mfma_f32_32x32x16_bf16(kf[5],qr[2],C1,0,0,0),   P1[6],P1[7],P1[8],P1[9],     pw2[2]=PKW(P1,4), pw2[3]=PKW(P1,6), pw2); \
    VRD(3); SBAR(); GAPA(C0=__builtin_amdgcn_mfma_f32_32x32x16_bf16(kf[6],qr[3],C0,0,0,0),   P1[10],P1[11],P1[12],P1[13], pw3[0]=PKW(P1,8), pw3[1]=PKW(P1,10), pw3); \
    VRD(7); SBAR(); GAPA(C1=__builtin_amdgcn_mfma_f32_32x32x16_bf16(kf[7],qr[3],C1,0,0,0),   P1[14],P1[15],0.f,0.f,       pw3[2]=PKW(P1,12),pw3[3]=PKW(P1,14), pw3); \
    l_reg+=sacc; \
    if(GK){DMA_K((t)+3,sl_cur);} if(GV){DMA_V((t)+1,sl_next);} \
    CMASK(C0,C1,t); \
    { float a=MX3(C0[0],C0[1],C1[0]),b=MX3(C0[2],C0[3],C1[1]); a=MX3(a,C1[2],C1[3]); \
      _Pragma("unroll") for(int r=4;r<16;r+=4){a=MX3(a,C0[r],C0[r+1]);b=MX3(b,C0[r+2],C0[r+3]);a=MX3(a,C1[r],C1[r+1]);b=MX3(b,C1[r+2],C1[r+3]);} \
      float rm=__builtin_fmaxf(a,b); { auto rr=__builtin_amdgcn_permlane32_swap(__float_as_uint(rm),__float_as_uint(rm),false,false); rm=__builtin_fmaxf(__uint_as_float(rr[0]),__uint_as_float(rr[1])); } \
      resc=false; \
      if(__builtin_expect(__any(rm>(float)THRL),0)){ const float dl=__builtin_fmaxf(rm,0.f); mhat+=dl; \
        _Pragma("unroll") for(int r=0;r<16;++r){C0[r]-=dl;C1[r]-=dl;} \
        _Pragma("unroll") for(int r=0;r<16;++r)negm[r]=-mhat; asm volatile("":"+v"(negm)); \
        const float f=__builtin_amdgcn_exp2f(-dl); l_reg*=f; if(hi==0)wsf[r32]=f; resc=true; } } \
    SBAR(); \
    GAPB(o[0]=__builtin_amdgcn_mfma_f32_32x32x16_bf16(PAF(0),VFR(0),o[0],0,0,0), C0,0); \
    GAPB(o[1]=__builtin_amdgcn_mfma_f32_32x32x16_bf16(PAF(0),VFR(4),o[1],0,0,0), C0,4); \
    KRD(GL,0); GAPB(o[0]=__builtin_amdgcn_mfma_f32_32x32x16_bf16(PAF(1),VFR(1),o[0],0,0,0), C0,8); \
    KRD(GL,1); GAPB(o[1]=__builtin_amdgcn_mfma_f32_32x32x16_bf16(PAF(1),VFR(5),o[1],0,0,0), C0,12); \
    KRD(GL,2); GAPB(o[0]=__builtin_amdgcn_mfma_f32_32x32x16_bf16(PAF(2),VFR(2),o[0],0,0,0), C1,0); \
    KRD(GL,3); GAPB(o[1]=__builtin_amdgcn_mfma_f32_32x32x16_bf16(PAF(2),VFR(6),o[1],0,0,0), C1,4); \
    GAPB(o[0]=__builtin_amdgcn_mfma_f32_32x32x16_bf16(PAF(3),VFR(3),o[0],0,0,0), C1,8); \
    GAPB(o[1]=__builtin_amdgcn_mfma_f32_32x32x16_bf16(PAF(3),VFR(7),o[1],0,0,0), C1,12); \
    }while(0)
  int t=1;
  #undef CMASK
  #define CMASK(P0,P1,t) do{}while(0)
  for(;t+5<NT;t+=2){
    STEP(pB0,pB1,pA0,pA1,t,true,true,true);     WAIT_BAR(2); RESC(); ROT();
    STEP(pA0,pA1,pB0,pB1,t+1,true,true,true);   WAIT_BAR(2); RESC(); ROT();
  }
  #undef CMASK
  #define CMASK(P0,P1,t) do{}while(0)
  #define ENDW(tt) do{ if((tt)+3<NT){WAIT_BAR(2);} else if((tt)+2<NT){WAIT_BAR(1);} else {WAIT_BAR(0);} }while(0)
  for(;t+1<NT;t+=2){
    STEP(pB0,pB1,pA0,pA1,t,(t+3<NT),(t+1<NT),(t+1<NT));       ENDW(t);   RESC(); ROT();
    STEP(pA0,pA1,pB0,pB1,t+1,(t+4<NT),(t+2<NT),(t+2<NT));     ENDW(t+1); RESC(); ROT();
  }
  STEP(pB0,pB1,pA0,pA1,NT-1,false,false,false); RESC();
  { float sacc=pB0[0]+pB0[1]; _Pragma("unroll") for(int r=2;r<16;++r)sacc+=pB0[r]; _Pragma("unroll") for(int r=0;r<16;++r)sacc+=pB1[r]; l_reg+=sacc;
    pw0=(u32x4){PKW(pB0,0),PKW(pB0,2),PKW(pB0,4),PKW(pB0,6)};pw1=(u32x4){PKW(pB0,8),PKW(pB0,10),PKW(pB0,12),PKW(pB0,14)};pw2=(u32x4){PKW(pB1,0),PKW(pB1,2),PKW(pB1,4),PKW(pB1,6)};pw3=(u32x4){PKW(pB1,8),PKW(pB1,10),PKW(pB1,12),PKW(pB1,14)};
    SBAR(); pv(o,vb0+sl_cur,PAF(0),PAF(1),PAF(2),PAF(3)); }
  #undef PKW
  #undef PAF
  #undef VFR
  #undef PIN
  #undef MX3
  #undef GAPA
  #undef GAPB
  #undef EX
  #undef VRD
  #undef KRD
  #undef STEP
  #undef ENDW
  {auto rr=__builtin_amdgcn_permlane32_swap(__float_as_uint(l_reg),__float_as_uint(l_reg),false,false);l_reg=__uint_as_float(rr[0])+__uint_as_float(rr[1]);}
  if(hi==0)wsf[32+r32]=l_reg;asm volatile("s_waitcnt lgkmcnt(0)":::"memory");
  float rli[16];
  #pragma unroll
  for(int r=0;r<16;++r)rli[r]=__builtin_amdgcn_rcpf(wsf[32+crow(r,hi)]);
  bf16*Ow=O+(rowbase+q0+wid*QBLK)*QP+h*D;
  { bf16*stg=(bf16*)(shm+LDS_OST)+wid*2048;
    #pragma unroll
    for(int r=0;r<16;++r){const int orow=crow(r,hi);
      #pragma unroll
      for(int d0=0;d0<2;++d0)stg[orow*64+d0*32+r32]=__float2bfloat16(o[d0][r]*rli[r]);}
    asm volatile("s_waitcnt lgkmcnt(0)":::"memory");
    #pragma unroll
    for(int i=0;i<4;++i){const int row=i*8+(lane>>3),ch=lane&7; const u32x4 v=*(const u32x4*)(stg+row*64+ch*8); ATTN_STORE16(Ow+(long)row*QP+ch*8,v);} }
  asm volatile("s_waitcnt lgkmcnt(0)\n\ts_barrier":::"memory");
  #undef DMA_K
  #undef DMA_V
  #undef CMASK
  #undef START
  #undef RESC
  #undef ROT
}
constexpr int ATTN_LDS_BYTES=LDS_BYTES;
#undef SBAR
#undef WAIT_BAR
}

#ifndef NAIVE_ATTN
#define NAIVE_ATTN 0
#endif
__device__ __forceinline__ void attn_convert(const Params& p, unsigned char* lds) {
    const int tid = tid_opaque(), lane = tid & 63, wave = tid >> 6;
    phase_tr_range(p, (float*)lds + wave * (64 * 33), lane, TR_WIN, TR_W2, (int)blockIdx.x * 8 + wave, (int)gridDim.x * 8);
    __syncthreads();
}
__device__ __forceinline__ void phase_attn(const Params& p, unsigned char* lds) {
    const int G = gridDim.x, bx = blockIdx.x, vcu = (G % 8 == 0) ? (bx % 8) * (G / 8) + bx / 8 : bx;
    attn_body::bf16* QO = (attn_body::bf16*)(p.ws + WS_QO); const attn_body::bf16* Kb = (const attn_body::bf16*)(p.ws + WS_K); const attn_body::bf16* Vb = (const attn_body::bf16*)(p.ws + WS_V);
    constexpr int NU = BATCH * NQH * (SEQ / 256);
    const int nmine = (NU - vcu + G - 1) / G, slot = (vcu & 3) < nmine ? (vcu & 3) : 0;
    int i = 0;
    for (int u = vcu; u < NU; u += G, ++i) {
#if !BARRIER_WORK
        if (i == slot) { attn_convert(p, lds); }
#else
        if (i == slot) { phase_scan(p); }
#endif
        const int bk = u >> 6, x = u & 63, b = bk >> 1, h = (bk & 1) * 4 + (x >> 4), qb = x & 15;
        attn_body::attn_unit<8>(b, h, qb, QO, Kb, Vb, QO, (char*)lds, p.q_norm_w);
    }
}

#ifndef RELAX_P1
#define RELAX_P1 true
#endif
#ifndef RELAX_WOUT
#define RELAX_WOUT true
#endif
#ifndef RELAX_MERGED
#define RELAX_MERGED true
#endif
#ifndef RELAX_MOE1
#define RELAX_MOE1 true
#endif
#ifndef RELAX_MOE2
#define RELAX_MOE2 false
#endif
#ifndef PG8_ASM_DMA
#define PG8_ASM_DMA 1
#endif
__device__ __forceinline__ void pg8_dma16(const void* sbase, unsigned voff, unsigned ldsaddr) { unsigned keep;
    asm volatile("s_mov_b32 %0, m0\n\ts_mov_b32 m0, %3\n\ts_nop 0\n\tglobal_load_lds_dwordx4 %1, %2\n\ts_mov_b32 m0, %0" : "=&s"(keep) : "v"(voff), "s"(sbase), "s"(ldsaddr) : "memory"); }
namespace pg8 {
constexpr int BM = 256, BK = 64, HALF = 128, HTB = HALF * BK * 2  , STAGE_BYTES = 8 * HTB, NXCD = 8, WGM = 8;
__host__ __device__ __forceinline__ int lds_byte(int r, int c) { const int st = (r >> 4) * 2 + (c >> 5), rr = r & 15, cc = c & 31, ob = rr * 64 + cc * 2; return st * 1024 + (ob ^ (((ob >> 9) & 1) << 5)); }
__host__ __device__ __forceinline__ void stage_rc(int b, int& R, int& C) { const int st = b / 1024, sb = b % 1024, swz = sb ^ (((sb >> 9) & 1) << 5); R = (st >> 1) * 16 + swz / 64; C = (st & 1) * 32 + (swz % 64) / 2; }
__host__ __device__ __forceinline__ int perm32(int rho) { const int n = rho >> 4, i = rho & 15; return 8 * (i >> 2) + 4 * n + (i & 3); }
struct Unit { int pm, pn, aux; };
#ifndef P1_WGM
#define P1_WGM 8
#endif
struct StaticOrder {
    int nM, nN, nwg, G, c;
    __host__ __device__ void init(int M, int N, int G_, int c_) { nM = M / BM; nN = N / BM; nwg = nM * nN; G = G_; c = c_; }
    __host__ __device__ bool next(int i, Unit& u) const {
        const long L = (long)i * G + c; if (L >= nwg) return false;
        int wgid = (int)L; { const int q = nwg / NXCD, r = nwg % NXCD, xcd = wgid % NXCD, off = wgid / NXCD; wgid = (xcd < r ? xcd * (q + 1) : r * (q + 1) + (xcd - r) * q) + off; }
        const int nig = P1_WGM * nN, gid = wgid / nig, fm = gid * P1_WGM, gsz = (nM - fm) < P1_WGM ? (nM - fm) : P1_WGM;
        u.pm = fm + ((wgid % nig) % gsz); u.pn = (wgid % nig) / gsz; u.aux = 0; return true;
    }
};
__device__ __forceinline__ unsigned cvt_pk_bf16(float lo, float hi) { return gm2::cvt_pk_bf16(lo, hi); }
template <class Epi, class Sched, bool ALIGN_EPI = false, bool SP2 = false, bool RELAX = false>
__device__ __forceinline__ void gemm_phase(PG8_LAS unsigned char* lds, const int K, const Sched& S, const Epi& E) {
    int tid_ = threadIdx.x; asm volatile("" : "+v"(tid_));
    const int tid = tid_, wid = __builtin_amdgcn_readfirstlane(tid >> 6), lane = tid & 63, wr = wid >> 2, wc = wid & 3, fr = lane & 15, fq = lane >> 4;
    const int nt = K / BK;
    unsigned voffA[2], voffB[2];
#pragma unroll
    for (int i = 0; i < 2; ++i) { int R, C; stage_rc(tid * 16 + i * 8192, R, C); const int Rb = Epi::PERM ? ((R & ~31) + perm32(R & 31)) : R;
        voffA[i] = (unsigned)(R * K + C) * 2u; voffB[i] = (unsigned)(Rb * K + C) * 2u; }
    const size_t kstep = (size_t)(BK * 2);
    const size_t hstep = (size_t)HALF * K * 2;
    const unsigned ldsw = (unsigned)wid * 1024u;
    const int aoff = lds_byte(wr * 64 + fr, fq * 8), boff = lds_byte(wc * 32 + fr, fq * 8);
#define PG8_SA(b, h) (((b) * 2 + (h)) * HTB)
#define PG8_SB(b, h) ((4 + (b) * 2 + (h)) * HTB)
#if PG8_ASM_DMA
#define PG8_STAGE(bufoff, gbase, voff) do { _Pragma("unroll") for (int _i = 0; _i < 2; ++_i) \
        pg8_dma16((const void*)(gbase), (voff)[_i], (unsigned)(size_t)(lds + (bufoff) + ldsw + _i * 8192)); } while (0)
#else
#define PG8_STAGE(bufoff, gbase, voff) do { _Pragma("unroll") for (int _i = 0; _i < 2; ++_i) \
        __builtin_amdgcn_global_load_lds((const unsigned*)((const char*)(gbase) + (voff)[_i]), (PG8_LAS unsigned*)(lds + (bufoff) + ldsw + _i * 8192), 16, 0, 0); } while (0)
#endif
#define PG8_LDA(dst, b, h) do { _Pragma("unroll") for (int m = 0; m < 4; ++m) _Pragma("unroll") for (int k = 0; k < 2; ++k) dst[m][k] = *(const PG8_LAS bf16x8*)(lds + PG8_SA(b, h) + aoff + m * 2048 + k * 1024); } while (0)
#define PG8_LDB(dst, b, h) do { _Pragma("unroll") for (int n = 0; n < 2; ++n) _Pragma("unroll") for (int k = 0; k < 2; ++k) dst[n][k] = *(const PG8_LAS bf16x8*)(lds + PG8_SB(b, h) + boff + n * 2048 + k * 1024); } while (0)
#define PG8_MMA(ai, bj, At, Bt) do { __builtin_amdgcn_s_setprio(1); _Pragma("unroll") for (int m = 0; m < 4; ++m) _Pragma("unroll") for (int n = 0; n < 2; ++n) _Pragma("unroll") for (int k = 0; k < 2; ++k) \
        acc[ai][bj][m][n] = __builtin_amdgcn_mfma_f32_16x16x32_bf16(Bt[n][k], At[m][k], acc[ai][bj][m][n], 0, 0, 0); __builtin_amdgcn_s_setprio(0); } while (0)
#define PG8_WAIT_V(n) asm volatile("s_waitcnt vmcnt(" #n ")" ::: "memory")
#define PG8_WAIT_VR asm volatile("s_waitcnt vmcnt(%0)" :: "n"(8 + (Epi::VMOPS > 55 ? 55 : Epi::VMOPS)) : "memory")
#define PG8_WAIT_L(n) asm volatile("s_waitcnt lgkmcnt(" #n ")" ::: "memory")
#define PG8_BAR __builtin_amdgcn_s_barrier()
#define PG8_SCHED __builtin_amdgcn_sched_barrier(0)
    Unit cur, nxt; int ui = 0;
    if (!S.next(0, cur)) return;
    f32x4 acc[2][2][4][2];
#pragma unroll
    for (int a = 0; a < 2; ++a)
#pragma unroll
        for (int b = 0; b < 2; ++b)
#pragma unroll
            for (int m = 0; m < 4; ++m)
#pragma unroll
                for (int n = 0; n < 2; ++n) acc[a][b][m][n] = (f32x4){0.f, 0.f, 0.f, 0.f};
    bf16x8 At[4][2], B0[2][2], B1[2][2];
    const char* cA = S.abase(cur); const char* cB = S.bbase(cur);
    if constexpr (SP2) {
        PG8_STAGE(PG8_SB(0, 0), cB, voffB); PG8_STAGE(PG8_SB(0, 1), cB + hstep, voffB); PG8_STAGE(PG8_SA(0, 0), cA, voffA); PG8_STAGE(PG8_SA(0, 1), cA + hstep, voffA);
        if (wr == 1) PG8_BAR;
        PG8_WAIT_V(2); PG8_BAR;
        PG8_STAGE(PG8_SB(1, 0), cB + kstep, voffB); PG8_STAGE(PG8_SA(1, 0), cA + kstep, voffA); PG8_STAGE(PG8_SB(1, 1), cB + hstep + kstep, voffB);
        if constexpr (RELAX) { PG8_WAIT_V(0); } else { PG8_WAIT_V(6); } PG8_BAR;
    } else {
        PG8_STAGE(PG8_SB(0, 0), cB, voffB); PG8_STAGE(PG8_SA(0, 0), cA, voffA); PG8_STAGE(PG8_SB(0, 1), cB + hstep, voffB); PG8_STAGE(PG8_SA(0, 1), cA + hstep, voffA);
        if (wr == 1) PG8_BAR;
        PG8_WAIT_V(4); PG8_BAR;
        PG8_STAGE(PG8_SB(1, 0), cB + kstep, voffB); PG8_STAGE(PG8_SA(1, 0), cA + kstep, voffA); PG8_STAGE(PG8_SB(1, 1), cB + hstep + kstep, voffB);
        PG8_WAIT_V(6); PG8_BAR;
    }
    for (;;) {
        const bool has_next = S.next(ui + 1, nxt);
        const char* nA = has_next ? S.abase(nxt) : cA; const char* nB = has_next ? S.bbase(nxt) : cB;
#define PG8_ITER(t, last, WV) do { \
            const char* a1 = cA + (size_t)((t) + 1) * kstep; \
            const char* a2 = (last) ? nA : cA + (size_t)((t) + 2) * kstep; const char* b2 = (last) ? nB : cB + (size_t)((t) + 2) * kstep; \
            const char* a3 = a2 + kstep; const char* b3 = b2 + kstep; \
            PG8_LDB(B0, 0, 0); PG8_LDB(B1, 0, 1); PG8_SCHED; PG8_LDA(At, 0, 0); PG8_STAGE(PG8_SA(1, 1), a1 + hstep, voffA); \
            WV; PG8_WAIT_L(0); PG8_BAR; PG8_MMA(0, 0, At, B0); PG8_MMA(0, 1, At, B1); PG8_BAR; PG8_SCHED; \
            PG8_LDA(At, 0, 1); PG8_STAGE(PG8_SB(0, 0), b2, voffB); PG8_STAGE(PG8_SB(0, 1), b2 + hstep, voffB); PG8_STAGE(PG8_SA(0, 0), a2, voffA); \
            WV; PG8_WAIT_L(0); PG8_BAR; PG8_MMA(1, 0, At, B0); PG8_MMA(1, 1, At, B1); PG8_BAR; PG8_SCHED; \
            PG8_LDB(B0, 1, 0); PG8_LDB(B1, 1, 1); PG8_SCHED; PG8_LDA(At, 1, 0); PG8_STAGE(PG8_SA(0, 1), a2 + hstep, voffA); \
            PG8_WAIT_V(8); PG8_WAIT_L(0); PG8_BAR; PG8_MMA(0, 0, At, B0); PG8_MMA(0, 1, At, B1); PG8_BAR; PG8_SCHED; \
            PG8_LDA(At, 1, 1); PG8_STAGE(PG8_SB(1, 0), b3, voffB); PG8_STAGE(PG8_SB(1, 1), b3 + hstep, voffB); PG8_STAGE(PG8_SA(1, 0), a3, voffA); \
            PG8_WAIT_V(8); PG8_WAIT_L(0); PG8_BAR; PG8_MMA(1, 0, At, B0); PG8_MMA(1, 1, At, B1); PG8_BAR; PG8_SCHED; } while (0)
        static_assert(SP2, "only the SP2 loop is kept");
        if constexpr (RELAX) { PG8_ITER(0, false, PG8_WAIT_VR); for (int t = 2; t < nt; t += 2) { const bool last = (t == nt - 2); PG8_ITER(t, last, PG8_WAIT_V(8)); } }
        else { for (int t = 0; t < nt; t += 2) { const bool last = (t == nt - 2); PG8_ITER(t, last, PG8_WAIT_V(8)); } }
#undef PG8_ITER
        if constexpr (ALIGN_EPI) { if (wr == 0) PG8_BAR; }
        if constexpr (!Epi::AFTER_DRAIN) { int fr2 = fr, fq2 = fq; asm volatile("" : "+v"(fr2), "+v"(fq2)); E(acc, cur, wr, wc, fr2, fq2); }
        if (!has_next) break;
#pragma unroll
        for (int a = 0; a < 2; ++a)
#pragma unroll
            for (int b = 0; b < 2; ++b)
#pragma unroll
                for (int m = 0; m < 4; ++m)
#pragma unroll
                    for (int n = 0; n < 2; ++n) acc[a][b][m][n] = (f32x4){0.f, 0.f, 0.f, 0.f};
        cur = nxt; cA = nA; cB = nB; ++ui;
        if constexpr (ALIGN_EPI) { if (wr == 1) PG8_BAR; }
    }
    PG8_WAIT_V(0);
    if constexpr (!ALIGN_EPI) { if (wr == 0) PG8_BAR; }
    PG8_BAR;
    if constexpr (Epi::AFTER_DRAIN) { E.fused(acc, cur, wr, wc, fr, fq, lds, wid, lane); }
#undef PG8_SA
#undef PG8_SB
#undef PG8_STAGE
#undef PG8_LDA
#undef PG8_LDB
#undef PG8_MMA
#undef PG8_WAIT_V
#undef PG8_WAIT_VR
#undef PG8_WAIT_L
#undef PG8_BAR
#undef PG8_SCHED
}

struct SchedProj {
    StaticOrder so; const char* A; const char* B; size_t tstep;
    __device__ __forceinline__ bool next(int i, Unit& u) const { return so.next(i, u); }
    __device__ __forceinline__ const char* abase(const Unit& u) const { return A + (size_t)u.pm * tstep; }
    __device__ __forceinline__ const char* bbase(const Unit& u) const { return B + (size_t)u.pn * tstep; }
};
struct SchedMerged {
    int vcu, G; const char *A0, *A1, *B0, *B1; size_t tstep;
    __device__ __forceinline__ bool next(int i, Unit& u) const { const int tile = vcu + (i >> 1) * G; if (tile >= 512) return false; u.pm = tile >> 2; u.pn = tile & 3; u.aux = i & 1; return true; }
    __device__ __forceinline__ const char* abase(const Unit& u) const { return (u.aux ? A1 : A0) + (size_t)u.pm * tstep; }
    __device__ __forceinline__ const char* bbase(const Unit& u) const { return (u.aux ? B1 : B0) + (size_t)u.pn * tstep; }
};
struct SchedWout {
    int vcu, G; const char *A, *B; size_t tstep;
    __device__ __forceinline__ bool next(int i, Unit& u) const { const int tile = vcu + i * G; if (tile >= 512) return false; u.pm = tile >> 2; u.pn = tile & 3; u.aux = 0; return true; }
    __device__ __forceinline__ const char* abase(const Unit& u) const { return A + (size_t)u.pm * tstep; }
    __device__ __forceinline__ const char* bbase(const Unit& u) const { return B + (size_t)u.pn * tstep; }
};
__device__ __forceinline__ void pair_of2(int pidx, int& a, int& b) { a = pidx < 3 ? 0 : (pidx < 5 ? 1 : 2); b = pidx < 3 ? pidx + 1 : (pidx < 5 ? pidx - 1 : 3); }
struct SchedMoe1 {
    int vcu, G, ntile; const int* tbk; const char *A, *W13; size_t tstep;
    __device__ __forceinline__ bool next(int i, Unit& u) const { const int uid = vcu + i * G; if (uid >= ntile * 8) return false; u.pm = uid >> 3; u.pn = uid & 7; u.aux = __builtin_amdgcn_readfirstlane(tbk[u.pm]); return true; }
    __device__ __forceinline__ const char* abase(const Unit& u) const { return A + (size_t)u.pm * tstep; }
    __device__ __forceinline__ const char* bbase(const Unit& u) const { const int g = u.aux / 6; int a, b; pair_of2(u.aux % 6, a, b); const int e = g * 4 + (u.pn < 4 ? a : b);
        return W13 + ((size_t)e * 1024 + (size_t)(u.pn & 3) * 256) * (1024 * 2); }
};
struct SchedMoe2 {
    int vcu, G, ntile; const int* tbk; const char *A, *W2P; size_t tstep;
    __device__ __forceinline__ bool next(int i, Unit& u) const { const int uid = vcu + i * G; if (uid >= ntile * 4) return false; u.pm = uid >> 2; u.pn = uid & 3; u.aux = __builtin_amdgcn_readfirstlane(tbk[u.pm]); return true; }
    __device__ __forceinline__ const char* abase(const Unit& u) const { return A + (size_t)u.pm * tstep; }
    __device__ __forceinline__ const char* bbase(const Unit& u) const { return W2P + ((size_t)u.aux * 1024 + (size_t)u.pn * 256) * (1024 * 2); }
};

typedef float f32x2 __attribute__((ext_vector_type(2)));
__device__ __forceinline__ float silu_e(float v) { return v * __builtin_amdgcn_rcpf(1.f + __builtin_amdgcn_exp2f(-1.4426950408889634f * v)); }
__device__ __forceinline__ float sigm_e(float v) { return __builtin_amdgcn_rcpf(1.f + __builtin_amdgcn_exp2f(-1.4426950408889634f * v)); }
struct EpiInProj {
    static constexpr bool PERM = true, AFTER_DRAIN = false; static constexpr int VMOPS = 12;
    bf16_t *QO, *Kb, *Vb, *Z, *XBC, *G; float* DT; const float* b_gate; const float* dt_bias;
    __device__ __forceinline__ void operator()(const f32x4 (&acc)[2][2][4][2], const Unit& u, int wr, int wc, int fr, int fq) const {
        const int row0 = u.pm * BM + wr * 64 + fr, pn = u.pn, lc = wc * 32 + 8 * fq;
        if (pn >= 8) {
            const int colt = (pn - 8) * BM + lc;
            f32x4 bv[2][2];
#pragma unroll
            for (int bj = 0; bj < 2; ++bj)
#pragma unroll
                for (int n = 0; n < 2; ++n) bv[bj][n] = *(const f32x4*)(b_gate + colt + bj * HALF + 4 * n);
#pragma unroll
            for (int ai = 0; ai < 2; ++ai)
#pragma unroll
                for (int mp = 0; mp < 2; ++mp)
#pragma unroll
                    for (int bj = 0; bj < 2; ++bj) { unsigned qq[2][2];
#pragma unroll
                        for (int mm = 0; mm < 2; ++mm) { const f32x4 v0 = acc[ai][bj][2 * mp + mm][0] + bv[bj][0], v1 = acc[ai][bj][2 * mp + mm][1] + bv[bj][1];
                            unsigned q0 = 0u, q1 = 0u;
#pragma unroll
                            for (int e = 0; e < 4; ++e) { q0 |= (unsigned)__builtin_rintf(255.f * sigm_e(v0[e])) << (8 * e); q1 |= (unsigned)__builtin_rintf(255.f * sigm_e(v1[e])) << (8 * e); }
                            qq[mm][0] = q0; qq[mm][1] = q1; }
                        auto r0 = __builtin_amdgcn_permlane16_swap(qq[0][0], qq[1][0], false, false); auto r1 = __builtin_amdgcn_permlane16_swap(qq[0][1], qq[1][1], false, false);
                        const u32x4 w = {(unsigned)r0[0], (unsigned)r1[0], (unsigned)r0[1], (unsigned)r1[1]};
                        unsigned char* dst = (unsigned char*)G + (size_t)(row0 + ai * HALF + (2 * mp + (fq & 1)) * 16) * 2048 + (pn - 8) * BM + wc * 32 + 8 * (fq & ~1) + bj * HALF;
                        *(u32x4*)dst = w; }
            return;
        }
        bf16_t* base0; bf16_t* base1; int ld;
        if (pn < 2) { base0 = QO + pn * BM + lc; base1 = base0 + HALF; ld = 512; }
        else if (pn == 2) { base0 = Kb + lc; base1 = Vb + lc; ld = 128; }
        else if (pn < 5) { base0 = Z + (pn - 3) * BM + lc; base1 = base0 + HALF; ld = 512; }
        else { base0 = XBC + (pn - 5) * BM + lc; base1 = base0 + HALF; ld = 768; }
        const bool act = (pn == 3 || pn == 4);
#pragma unroll
        for (int ai = 0; ai < 2; ++ai)
#pragma unroll
            for (int m = 0; m < 4; ++m) { const size_t ro = (size_t)(row0 + ai * HALF + m * 16) * ld;
#pragma unroll
                for (int bj = 0; bj < 2; ++bj) { f32x4 v0 = acc[ai][bj][m][0], v1 = acc[ai][bj][m][1];
                    if (act) {
#pragma unroll
                        for (int e = 0; e < 4; ++e) { v0[e] = silu_e(v0[e]); v1[e] = silu_e(v1[e]); } }
                    u32x4 w; w.x = cvt_pk_bf16(v0[0], v0[1]); w.y = cvt_pk_bf16(v0[2], v0[3]); w.z = cvt_pk_bf16(v1[0], v1[1]); w.w = cvt_pk_bf16(v1[2], v1[3]);
                    *(u32x4*)((bj ? base1 : base0) + ro) = w; } }
    }
};
__device__ __forceinline__ float bflo(unsigned w) { return __builtin_bit_cast(float, w << 16); }
__device__ __forceinline__ float bfhi(unsigned w) { return __builtin_bit_cast(float, w & 0xffff0000u); }
struct EpiMerged {
    static constexpr bool PERM = true, AFTER_DRAIN = false;
    const bf16_t* G; bf16_t* MG;
    __device__ __forceinline__ void operator()(const f32x4 (&acc)[2][2][4][2], const Unit& u, int wr, int wc, int fr, int fq) const {
        const int row0 = u.pm * BM + wr * 64 + fr, col0 = u.pn * BM + wc * 32 + 8 * fq, goff = u.aux ? 0 : 1024;
#pragma unroll
        for (int ai = 0; ai < 2; ++ai)
#pragma unroll
            for (int m = 0; m < 4; ++m) { const size_t row = (size_t)(row0 + ai * HALF + m * 16);
#pragma unroll
                for (int bj = 0; bj < 2; ++bj) { const int col = col0 + bj * HALF;
                    const u32x2 gv = *(const u32x2*)((const unsigned char*)G + row * 2048 + goff + col);
                    f32x4 v0 = acc[ai][bj][m][0], v1 = acc[ai][bj][m][1];
#pragma unroll
                    for (int e = 0; e < 4; ++e) { v0[e] *= (float)((gv.x >> (8 * e)) & 0xffu) * (1.f / 255.f); v1[e] *= (float)((gv.y >> (8 * e)) & 0xffu) * (1.f / 255.f); }
                    bf16_t* dst = MG + row * 1024 + col;
                    if (u.aux) { const u32x4 ov = *(const u32x4*)dst;
                        v0[0] += bflo(ov.x); v0[1] += bfhi(ov.x); v0[2] += bflo(ov.y); v0[3] += bfhi(ov.y); v1[0] += bflo(ov.z); v1[1] += bfhi(ov.z); v1[2] += bflo(ov.w); v1[3] += bfhi(ov.w); }
                    u32x4 w; w.x = cvt_pk_bf16(v0[0], v0[1]); w.y = cvt_pk_bf16(v0[2], v0[3]); w.z = cvt_pk_bf16(v1[0], v1[1]); w.w = cvt_pk_bf16(v1[2], v1[3]);
                    *(u32x4*)dst = w; } }
    }
};
struct EpiWout {
    static constexpr bool PERM = true, AFTER_DRAIN = false; static constexpr int VMOPS = 48;
    const float* x; bf16_t* X1;
    __device__ __forceinline__ void operator()(const f32x4 (&acc)[2][2][4][2], const Unit& u, int wr, int wc, int fr, int fq) const {
        const int row0 = u.pm * BM + wr * 64 + fr, col0 = u.pn * BM + wc * 32 + 8 * fq;
#pragma unroll
        for (int ai = 0; ai < 2; ++ai) {
            f32x4 xv[4][2][2];
#pragma unroll
            for (int m = 0; m < 4; ++m) { const size_t off = (size_t)(row0 + ai * HALF + m * 16) * 1024 + col0;
#pragma unroll
                for (int bj = 0; bj < 2; ++bj) { xv[m][bj][0] = *(const f32x4*)(x + off + bj * HALF); xv[m][bj][1] = *(const f32x4*)(x + off + bj * HALF + 4); } }
            __builtin_amdgcn_sched_barrier(0);
#pragma unroll
            for (int m = 0; m < 4; ++m) { const size_t off = (size_t)(row0 + ai * HALF + m * 16) * 1024 + col0;
#pragma unroll
                for (int bj = 0; bj < 2; ++bj) { const f32x4 v0 = xv[m][bj][0] + acc[ai][bj][m][0], v1 = xv[m][bj][1] + acc[ai][bj][m][1];
                    u32x4 w; w.x = cvt_pk_bf16(v0[0], v0[1]); w.y = cvt_pk_bf16(v0[2], v0[3]); w.z = cvt_pk_bf16(v1[0], v1[1]); w.w = cvt_pk_bf16(v1[2], v1[3]);
                    *(u32x4*)(X1 + off + bj * HALF) = w; } }
            asm volatile("" ::: "memory");
            __builtin_amdgcn_sched_barrier(0);
        }
    }
};
struct EpiMoe1 {
    static constexpr bool PERM = true, AFTER_DRAIN = false, HAS_MID = false; static constexpr int MID_T = 0; static constexpr int VMOPS = 24;
    bf16_t* HID; const float* SWA; const float* SWB; const float* SRS;
    __device__ __forceinline__ void operator()(const f32x4 (&acc)[2][2][4][2], const Unit& u, int wr, int wc, int fr, int fq) const {
        const int row0 = u.pm * BM + wr * 64 + fr, slot = u.pn >> 2, hc = slot * 512 + (u.pn & 3) * 128 + 16 * wc + 4 * fq;
        const float* SW = slot ? SWB : SWA;
        float wrow[2][4], rrow[2][4];
#pragma unroll
        for (int ai = 0; ai < 2; ++ai)
#pragma unroll
            for (int m = 0; m < 4; ++m) { wrow[ai][m] = SW[row0 + ai * HALF + m * 16]; rrow[ai][m] = SRS[row0 + ai * HALF + m * 16]; }
        __builtin_amdgcn_sched_barrier(0);
#pragma unroll
        for (int ai = 0; ai < 2; ++ai)
#pragma unroll
            for (int mp = 0; mp < 2; ++mp)
#pragma unroll
                for (int bj = 0; bj < 2; ++bj) { u32x2 oo[2];
#pragma unroll
                    for (int mm = 0; mm < 2; ++mm) { const int m = 2 * mp + mm; const float rs = rrow[ai][m], w = wrow[ai][m] * rs; const f32x4 v0 = acc[ai][bj][m][0], v1 = acc[ai][bj][m][1];
                        float h0 = w * silu_e(rs * v0[0]) * v0[1], h1 = w * silu_e(rs * v0[2]) * v0[3], h2 = w * silu_e(rs * v1[0]) * v1[1], h3 = w * silu_e(rs * v1[2]) * v1[3];
                        if (w == 0.f) { h0 = 0.f; h1 = 0.f; h2 = 0.f; h3 = 0.f; }
                        oo[mm].x = cvt_pk_bf16(h0, h1); oo[mm].y = cvt_pk_bf16(h2, h3); }
                    auto r0 = __builtin_amdgcn_permlane16_swap(oo[0].x, oo[1].x, false, false); auto r1 = __builtin_amdgcn_permlane16_swap(oo[0].y, oo[1].y, false, false);
                    const u32x4 wv = {(unsigned)r0[0], (unsigned)r1[0], (unsigned)r0[1], (unsigned)r1[1]};
                    const size_t row = (size_t)(row0 + ai * HALF + (2 * mp + (fq & 1)) * 16);
                    *(u32x4*)(HID + row * 1024 + slot * 512 + (u.pn & 3) * 128 + 16 * wc + 4 * (fq & ~1) + 64 * bj) = wv; }
    }
};
struct EpiMoe2 {
    static constexpr bool PERM = false, AFTER_DRAIN = false, HAS_MID = false; static constexpr int MID_T = 0; static constexpr int VMOPS = 32;
    float* out; const int* perm; const bf16_t* X1;
    __device__ __forceinline__ void operator()(const f32x4 (&acc)[2][2][4][2], const Unit& u, int wr, int wc, int fr, int fq) const {
        const int row0 = u.pm * BM + wr * 64 + fr, col0 = u.pn * BM + wc * 32 + 4 * fq;
        int tok[2][4];
#pragma unroll
        for (int ai = 0; ai < 2; ++ai)
#pragma unroll
            for (int m = 0; m < 4; ++m) { const int P = (u.aux >> 8) & 7, q = u.aux >> 12;
                const bool mine = (P <= 1) || (P == 2 ? ai == q : (ai == (q >> 1) && (m >> 1) == (q & 1)));
                tok[ai][m] = mine ? perm[row0 + ai * HALF + m * 16] : -1; }
#pragma unroll
        for (int ai = 0; ai < 2; ++ai) {
            u32x2 xv[4][2][2];
#pragma unroll
            for (int m = 0; m < 4; ++m) { const size_t off = (size_t)(tok[ai][m] < 0 ? 0 : tok[ai][m]) * 1024 + col0;
#pragma unroll
                for (int bj = 0; bj < 2; ++bj)
#pragma unroll
                    for (int n = 0; n < 2; ++n) xv[m][bj][n] = *(const u32x2*)(X1 + off + bj * HALF + n * 16); }
#pragma unroll
            for (int m = 0; m < 4; ++m) { if (tok[ai][m] >= 0) { const size_t off = (size_t)tok[ai][m] * 1024 + col0;
#pragma unroll
                for (int bj = 0; bj < 2; ++bj)
#pragma unroll
                    for (int n = 0; n < 2; ++n) { const u32x2 x = xv[m][bj][n];
                        const f32x4 r = {bflo(x.x) + acc[ai][bj][m][n][0], bfhi(x.x) + acc[ai][bj][m][n][1], bflo(x.y) + acc[ai][bj][m][n][2], bfhi(x.y) + acc[ai][bj][m][n][3]};
                        *(f32x4*)(out + off + bj * HALF + n * 16) = r; } } }
            asm volatile("" ::: "memory");
        }
    }
};
template <class Epi, class Sched, bool ALIGN_EPI = false, bool SP2 = false, bool GATHER = false, bool RELAX = false>
__device__ __forceinline__ void gemm_phase2(PG8_LAS unsigned char* lds, const int pitchA, const int pitchB, const int nt, const Sched& S, const Epi& E) {
    int tid_ = threadIdx.x; asm volatile("" : "+v"(tid_));
    const int tid = tid_, wid = __builtin_amdgcn_readfirstlane(tid >> 6), lane = tid & 63, wr = wid >> 2, wc = wid & 3, fr = lane & 15, fq = lane >> 4;
    unsigned voffA[2], voffB[2];
#pragma unroll
    for (int i = 0; i < 2; ++i) { int R, C; stage_rc(tid * 16 + i * 8192, R, C); const int Rb = Epi::PERM ? ((R & ~31) + perm32(R & 31)) : R;
        voffA[i] = (unsigned)(R * pitchA + C) * 2u; voffB[i] = (unsigned)(Rb * pitchB + C) * 2u; }
    unsigned uAc[2][2] = {{0u, 0u}, {0u, 0u}}, uAn[2][2] = {{0u, 0u}, {0u, 0u}};
    int gR[2], gC[2];
#pragma unroll
    for (int i = 0; i < 2; ++i) stage_rc(tid * 16 + i * 8192, gR[i], gC[i]);
#if PG8_ASM_DMA
#define PG8_DMA1(kptr, off32, boff) pg8_dma16((const void*)(kptr), (off32), (unsigned)(size_t)(lds + (boff) + ldsw))
#else
#define PG8_DMA1(kptr, off32, boff) __builtin_amdgcn_global_load_lds((const unsigned*)((const char*)(kptr) + (off32)), (PG8_LAS unsigned*)(lds + (boff) + ldsw), 16, 0, 0)
#endif
#define PG8_ROWOFFS(dst, un) do { if constexpr (GATHER) { _Pragma("unroll") for (int h_ = 0; h_ < 2; ++h_) _Pragma("unroll") for (int i_ = 0; i_ < 2; ++i_) \
        dst[h_][i_] = (unsigned)S.arow(un, h_ * HALF + gR[i_]) * (unsigned)(pitchA * 2) + (unsigned)(gC[i_] * 2); } } while (0)
#define PG8_STAGE_AH(bufoff, kptr, h, NEXT) do { if constexpr (GATHER) { _Pragma("unroll") for (int _i = 0; _i < 2; ++_i) \
        PG8_DMA1((kptr), ((NEXT) ? uAn[h][_i] : uAc[h][_i]), (bufoff) + _i * 8192); } \
      else { PG8_STAGE(bufoff, (const char*)(kptr) + ((h) ? hstepA : 0), voffA); } } while (0)
    const size_t kstep = (size_t)(BK * 2);
    const size_t hstepA = (size_t)HALF * pitchA * 2, hstepB = (size_t)HALF * pitchB * 2;
    const unsigned ldsw = (unsigned)wid * 1024u;
    const int aoff = lds_byte(wr * 64 + fr, fq * 8), boff = lds_byte(wc * 32 + fr, fq * 8);
#define PG8_SA(b, h) (((b) * 2 + (h)) * HTB)
#define PG8_SB(b, h) ((4 + (b) * 2 + (h)) * HTB)
#if PG8_ASM_DMA
#define PG8_STAGE(bufoff, gbase, voff) do { _Pragma("unroll") for (int _i = 0; _i < 2; ++_i) \
        pg8_dma16((const void*)(gbase), (voff)[_i], (unsigned)(size_t)(lds + (bufoff) + ldsw + _i * 8192)); } while (0)
#else
#define PG8_STAGE(bufoff, gbase, voff) do { _Pragma("unroll") for (int _i = 0; _i < 2; ++_i) \
        __builtin_amdgcn_global_load_lds((const unsigned*)((const char*)(gbase) + (voff)[_i]), (PG8_LAS unsigned*)(lds + (bufoff) + ldsw + _i * 8192), 16, 0, 0); } while (0)
#endif
#define PG8_LDA(dst, b, h) do { _Pragma("unroll") for (int m = 0; m < 4; ++m) _Pragma("unroll") for (int k = 0; k < 2; ++k) dst[m][k] = *(const PG8_LAS bf16x8*)(lds + PG8_SA(b, h) + aoff + m * 2048 + k * 1024); } while (0)
#define PG8_LDB(dst, b, h) do { _Pragma("unroll") for (int n = 0; n < 2; ++n) _Pragma("unroll") for (int k = 0; k < 2; ++k) dst[n][k] = *(const PG8_LAS bf16x8*)(lds + PG8_SB(b, h) + boff + n * 2048 + k * 1024); } while (0)
#define PG8_MMA(ai, bj, At, Bt) do { __builtin_amdgcn_s_setprio(1); _Pragma("unroll") for (int m = 0; m < 4; ++m) _Pragma("unroll") for (int n = 0; n < 2; ++n) _Pragma("unroll") for (int k = 0; k < 2; ++k) \
        acc[ai][bj][m][n] = __builtin_amdgcn_mfma_f32_16x16x32_bf16(Bt[n][k], At[m][k], acc[ai][bj][m][n], 0, 0, 0); __builtin_amdgcn_s_setprio(0); } while (0)
#define PG8_WAIT_V(n) asm volatile("s_waitcnt vmcnt(" #n ")" ::: "memory")
#define PG8_WAIT_VR asm volatile("s_waitcnt vmcnt(%0)" :: "n"(8 + (Epi::VMOPS > 55 ? 55 : Epi::VMOPS)) : "memory")
#define PG8_WAIT_L(n) asm volatile("s_waitcnt lgkmcnt(" #n ")" ::: "memory")
#define PG8_BAR __builtin_amdgcn_s_barrier()
#define PG8_SCHED __builtin_amdgcn_sched_barrier(0)
    Unit cur, nxt; int ui = 0;
    if (!S.next(0, cur)) return;
    f32x4 acc[2][2][4][2];
#pragma unroll
    for (int a = 0; a < 2; ++a)
#pragma unroll
        for (int b = 0; b < 2; ++b)
#pragma unroll
            for (int m = 0; m < 4; ++m)
#pragma unroll
                for (int n = 0; n < 2; ++n) acc[a][b][m][n] = (f32x4){0.f, 0.f, 0.f, 0.f};
    bf16x8 At[4][2], B0[2][2], B1[2][2];
    PG8_ROWOFFS(uAc, cur);
    const char* cA = S.aptr(cur, 0); const char* cB = S.bptr(cur, 0); const char* cA1 = S.aptr(cur, 1); const char* cB1 = S.bptr(cur, 1);
    if constexpr (SP2) {
        PG8_STAGE(PG8_SB(0, 0), cB, voffB); PG8_STAGE(PG8_SB(0, 1), cB + hstepB, voffB); PG8_STAGE_AH(PG8_SA(0, 0), cA, 0, false); PG8_STAGE_AH(PG8_SA(0, 1), cA, 1, false);
        if (wr == 1) PG8_BAR;
        PG8_WAIT_V(2); PG8_BAR;
        PG8_STAGE(PG8_SB(1, 0), cB1, voffB); PG8_STAGE_AH(PG8_SA(1, 0), cA1, 0, false); PG8_STAGE(PG8_SB(1, 1), cB1 + hstepB, voffB);
        if constexpr (RELAX) { PG8_WAIT_V(0); } else { PG8_WAIT_V(6); } PG8_BAR;
    } else {
        PG8_STAGE(PG8_SB(0, 0), cB, voffB); PG8_STAGE_AH(PG8_SA(0, 0), cA, 0, false); PG8_STAGE(PG8_SB(0, 1), cB + hstepB, voffB); PG8_STAGE_AH(PG8_SA(0, 1), cA, 1, false);
        if (wr == 1) PG8_BAR;
        PG8_WAIT_V(4); PG8_BAR;
        PG8_STAGE(PG8_SB(1, 0), cB1, voffB); PG8_STAGE_AH(PG8_SA(1, 0), cA1, 0, false); PG8_STAGE(PG8_SB(1, 1), cB1 + hstepB, voffB);
        PG8_WAIT_V(6); PG8_BAR;
    }
    for (;;) {
        const bool has_next = S.next(ui + 1, nxt);
        const Unit nu = has_next ? nxt : cur;
        int rawn[2][2] = {{0, 0}, {0, 0}};
        if constexpr (GATHER) { _Pragma("unroll") for (int h_ = 0; h_ < 2; ++h_) _Pragma("unroll") for (int i_ = 0; i_ < 2; ++i_) rawn[h_][i_] = S.arow_raw(nu, h_ * HALF + gR[i_]); }
        const char* nA = S.aptr(nu, 0); const char* nB = S.bptr(nu, 0); const char* nA1 = S.aptr(nu, 1); const char* nB1 = S.bptr(nu, 1);
#define PG8_ITER(t, last, WV) do { \
            if constexpr (Epi::HAS_MID) { if ((t) == Epi::MID_T) E.mid(acc, cur, wr, wc, fr, fq); } \
            const char* a1 = S.aptr(cur, (t) + 1); \
            const char* a2 = (last) ? nA : S.aptr(cur, (t) + 2); const char* b2 = (last) ? nB : S.bptr(cur, (t) + 2); \
            const char* a3 = (last) ? nA1 : S.aptr(cur, (t) + 3); const char* b3 = (last) ? nB1 : S.bptr(cur, (t) + 3); \
            PG8_LDB(B0, 0, 0); PG8_LDB(B1, 0, 1); PG8_SCHED; PG8_LDA(At, 0, 0); PG8_STAGE_AH(PG8_SA(1, 1), a1, 1, false); \
            WV; PG8_WAIT_L(0); PG8_BAR; PG8_MMA(0, 0, At, B0); PG8_MMA(0, 1, At, B1); PG8_BAR; PG8_SCHED; \
            PG8_LDA(At, 0, 1); PG8_STAGE(PG8_SB(0, 0), b2, voffB); PG8_STAGE(PG8_SB(0, 1), b2 + hstepB, voffB); PG8_STAGE_AH(PG8_SA(0, 0), a2, 0, last); \
            WV; PG8_WAIT_L(0); PG8_BAR; PG8_MMA(1, 0, At, B0); PG8_MMA(1, 1, At, B1); PG8_BAR; PG8_SCHED; \
            PG8_LDB(B0, 1, 0); PG8_LDB(B1, 1, 1); PG8_SCHED; PG8_LDA(At, 1, 0); PG8_STAGE_AH(PG8_SA(0, 1), a2, 1, last); \
            PG8_WAIT_V(8); PG8_WAIT_L(0); PG8_BAR; PG8_MMA(0, 0, At, B0); PG8_MMA(0, 1, At, B1); PG8_BAR; PG8_SCHED; \
            PG8_LDA(At, 1, 1); PG8_STAGE(PG8_SB(1, 0), b3, voffB); PG8_STAGE(PG8_SB(1, 1), b3 + hstepB, voffB); PG8_STAGE_AH(PG8_SA(1, 0), a3, 0, last); \
            PG8_WAIT_V(8); PG8_WAIT_L(0); PG8_BAR; PG8_MMA(1, 0, At, B0); PG8_MMA(1, 1, At, B1); PG8_BAR; PG8_SCHED; } while (0)
        static_assert(SP2, "only the SP2 loop is kept");
        if constexpr (GATHER) {
            if constexpr (RELAX) { PG8_ITER(0, false, PG8_WAIT_VR); for (int t = 2; t < nt - 2; t += 2) { PG8_ITER(t, false, PG8_WAIT_V(8)); } }
            else { for (int t = 0; t < nt - 2; t += 2) { PG8_ITER(t, false, PG8_WAIT_V(8)); } }
            asm volatile("" : "+v"(rawn[0][0]), "+v"(rawn[0][1]), "+v"(rawn[1][0]), "+v"(rawn[1][1]));
            _Pragma("unroll") for (int h_ = 0; h_ < 2; ++h_) _Pragma("unroll") for (int i_ = 0; i_ < 2; ++i_) { const int r_ = rawn[h_][i_]; uAn[h_][i_] = (unsigned)(r_ < 0 ? 0 : r_) * (unsigned)(pitchA * 2) + (unsigned)(gC[i_] * 2); }
            PG8_ITER(nt - 2, true, PG8_WAIT_V(8));
        } else {
            if constexpr (RELAX) { PG8_ITER(0, false, PG8_WAIT_VR); for (int t = 2; t < nt; t += 2) { const bool last = (t == nt - 2); PG8_ITER(t, last, PG8_WAIT_V(8)); } }
            else { for (int t = 0; t < nt; t += 2) { const bool last = (t == nt - 2); PG8_ITER(t, last, PG8_WAIT_V(8)); } }
        }
#undef PG8_ITER
        if constexpr (ALIGN_EPI) { if (wr == 0) PG8_BAR; }
        if constexpr (!Epi::AFTER_DRAIN) { int fr2 = fr, fq2 = fq; asm volatile("" : "+v"(fr2), "+v"(fq2)); E(acc, cur, wr, wc, fr2, fq2); }
        if (!has_next) break;
#pragma unroll
        for (int a = 0; a < 2; ++a)
#pragma unroll
            for (int b = 0; b < 2; ++b)
#pragma unroll
                for (int m = 0; m < 4; ++m)
#pragma unroll
                    for (int n = 0; n < 2; ++n) acc[a][b][m][n] = (f32x4){0.f, 0.f, 0.f, 0.f};
        cur = nxt; ++ui;
        if constexpr (GATHER) { _Pragma("unroll") for (int h_ = 0; h_ < 2; ++h_) _Pragma("unroll") for (int i_ = 0; i_ < 2; ++i_) uAc[h_][i_] = uAn[h_][i_]; }
        if constexpr (ALIGN_EPI) { if (wr == 1) PG8_BAR; }
    }
    PG8_WAIT_V(0);
    if constexpr (!ALIGN_EPI) { if (wr == 0) PG8_BAR; }
    PG8_BAR;
    if constexpr (Epi::AFTER_DRAIN) { E.fused(acc, cur, wr, wc, fr, fq, lds, wid, lane); }
#undef PG8_SA
#undef PG8_SB
#undef PG8_STAGE
#undef PG8_LDA
#undef PG8_LDB
#undef PG8_MMA
#undef PG8_WAIT_V
#undef PG8_WAIT_VR
#undef PG8_WAIT_L
#undef PG8_BAR
#undef PG8_SCHED
#undef PG8_ROWOFFS
#undef PG8_STAGE_AH
#undef PG8_DMA1
}


struct SchedMerged2 {
    int vcu, G; const char *A_attn, *A_ssd, *B_a, *B_s; size_t tstep;
    __device__ __forceinline__ bool next(int i, Unit& u) const { const int tile = vcu + i * G; if (tile >= 512) return false; u.pm = tile >> 2; u.pn = tile & 3; u.aux = 0; return true; }
    __device__ __forceinline__ const char* aptr(const Unit& u, int t) const { return (t < 8 ? A_attn : A_ssd) + (size_t)u.pm * tstep + (size_t)(t & 7) * (BK * 2); }
    __device__ __forceinline__ const char* bptr(const Unit& u, int t) const { return (t < 8 ? B_a : B_s) + (size_t)u.pn * tstep + (size_t)(t & 7) * (BK * 2); }
};
struct EpiMerged2 {
    static constexpr bool PERM = true, AFTER_DRAIN = false, HAS_MID = true; static constexpr int MID_T = 8; static constexpr int VMOPS = 32;
    const unsigned char* G8; bf16_t* MG;
    __device__ __forceinline__ void mid(f32x4 (&acc)[2][2][4][2], const Unit& u, int wr, int wc, int fr, int fq) const {
        const int row0 = u.pm * BM + wr * 64 + fr, col0 = u.pn * BM + wc * 32 + 8 * fq;
#pragma unroll
        for (int ai = 0; ai < 2; ++ai) {
            u32x2 ga[4][2], gs[4][2];
#pragma unroll
            for (int m = 0; m < 4; ++m) { const unsigned char* gp = G8 + (size_t)(row0 + ai * HALF + m * 16) * 2048 + col0;
#pragma unroll
                for (int bj = 0; bj < 2; ++bj) { ga[m][bj] = *(const u32x2*)(gp + bj * HALF); gs[m][bj] = *(const u32x2*)(gp + 1024 + bj * HALF); } }
            __builtin_amdgcn_sched_barrier(0);
#pragma unroll
            for (int m = 0; m < 4; ++m)
#pragma unroll
                for (int bj = 0; bj < 2; ++bj)
#pragma unroll
                    for (int e = 0; e < 4; ++e) {
                        const unsigned s0 = (gs[m][bj].x >> (8 * e)) & 0xffu, s1 = (gs[m][bj].y >> (8 * e)) & 0xffu;
                        acc[ai][bj][m][0][e] *= (float)((ga[m][bj].x >> (8 * e)) & 0xffu) * __builtin_amdgcn_rcpf((float)(s0 ? s0 : 1u));
                        acc[ai][bj][m][1][e] *= (float)((ga[m][bj].y >> (8 * e)) & 0xffu) * __builtin_amdgcn_rcpf((float)(s1 ? s1 : 1u)); }
            asm volatile("" ::: "memory");
            __builtin_amdgcn_sched_barrier(0);
        }
    }
    __device__ __forceinline__ void operator()(const f32x4 (&acc)[2][2][4][2], const Unit& u, int wr, int wc, int fr, int fq) const {
        const int row0 = u.pm * BM + wr * 64 + fr, col0 = u.pn * BM + wc * 32 + 8 * fq;
        u32x2 gs[2][4][2];
#pragma unroll
        for (int ai = 0; ai < 2; ++ai)
#pragma unroll
            for (int m = 0; m < 4; ++m) { const size_t row = (size_t)(row0 + ai * HALF + m * 16);
#pragma unroll
                for (int bj = 0; bj < 2; ++bj) gs[ai][m][bj] = *(const u32x2*)(G8 + row * 2048 + 1024 + col0 + bj * HALF); }
        __builtin_amdgcn_sched_barrier(0);
#pragma unroll
        for (int ai = 0; ai < 2; ++ai)
#pragma unroll
            for (int m = 0; m < 4; ++m) { const size_t row = (size_t)(row0 + ai * HALF + m * 16);
#pragma unroll
                for (int bj = 0; bj < 2; ++bj) { const int col = col0 + bj * HALF; const u32x2 g = gs[ai][m][bj];
                    f32x4 v0 = acc[ai][bj][m][0], v1 = acc[ai][bj][m][1];
#pragma unroll
                    for (int e = 0; e < 4; ++e) { const unsigned s0 = (g.x >> (8 * e)) & 0xffu, s1 = (g.y >> (8 * e)) & 0xffu;
                        v0[e] *= (float)(s0 ? s0 : 1u) * (1.f / 255.f); v1[e] *= (float)(s1 ? s1 : 1u) * (1.f / 255.f); }
                    u32x4 w; w.x = cvt_pk_bf16(v0[0], v0[1]); w.y = cvt_pk_bf16(v0[2], v0[3]); w.z = cvt_pk_bf16(v1[0], v1[1]); w.w = cvt_pk_bf16(v1[2], v1[3]);
                    *(u32x4*)(MG + row * 1024 + col) = w; } }
    }
};

struct SchedMoe2b {
    int vcu, G, ntile; const int* tbk; const char *A, *W2T; size_t tstepA; int ax0, ax1, ax2, ax3;
    __device__ __forceinline__ bool locate(int i, int& unit, int& code) const { const int uid = vcu + i * G, total = ntile * 4, nfull = (total / G) * G, ntail = total - nfull;
        const int P = MOE2_SPLIT_TAIL ? (ntail * 4 <= G ? 4 : (ntail * 2 <= G ? 2 : 1)) : 1;
        unit = uid; code = 0;
        if (uid >= nfull) { const int r = uid - nfull; if (r >= ntail * P) return false; unit = nfull + r / P; code = (P << 8) | ((r % P) << 12); }
        return true; }
    __device__ __forceinline__ void preload() { int a[4];
#pragma unroll
        for (int i = 0; i < 4; ++i) { int unit, code; const bool ok = locate(i, unit, code); a[i] = tbk[ok ? (unit >> 2) : 0]; }
        ax0 = __builtin_amdgcn_readfirstlane(a[0]); ax1 = __builtin_amdgcn_readfirstlane(a[1]); ax2 = __builtin_amdgcn_readfirstlane(a[2]); ax3 = __builtin_amdgcn_readfirstlane(a[3]); }
    __device__ __forceinline__ bool next(int i, Unit& u) const { int unit, code; if (!locate(i, unit, code)) return false;
        u.pm = unit >> 2; u.pn = unit & 3;
        u.aux = (i == 0 ? ax0 : (i == 1 ? ax1 : (i == 2 ? ax2 : (i == 3 ? ax3 : __builtin_amdgcn_readfirstlane(tbk[u.pm]))))) | code; return true; }
    __device__ __forceinline__ const char* aptr(const Unit& u, int t) const { return A + (size_t)u.pm * tstepA + (size_t)t * (BK * 2); }
    __device__ __forceinline__ const char* bptr(const Unit& u, int t) const { const int bk = u.aux & 255, g = bk / 6; int a, b; pair_of2(bk % 6, a, b); const int e = g * 4 + (t < 8 ? a : b);
        return W2T + ((size_t)e * 1024 + (size_t)u.pn * 256) * (512 * 2) + (size_t)(t & 7) * (BK * 2); }
};

struct SchedMoe1g {
    int vcu, G, ntile; const int* tbk; const int* perm; const char *H2, *W13; int ax0, ax1, ax2, ax3, ax4;
    __device__ __forceinline__ void preload() { int a[5]; const int nt = tbk[TS / 256];
#pragma unroll
        for (int i = 0; i < 5; ++i) { const int pm = (vcu + i * G) >> 3; a[i] = tbk[pm < TS / 256 ? pm : TS / 256 - 1]; }
        __builtin_amdgcn_sched_barrier(0);
        ntile = __builtin_amdgcn_readfirstlane(nt);
        ax0 = __builtin_amdgcn_readfirstlane(a[0]); ax1 = __builtin_amdgcn_readfirstlane(a[1]); ax2 = __builtin_amdgcn_readfirstlane(a[2]); ax3 = __builtin_amdgcn_readfirstlane(a[3]); ax4 = __builtin_amdgcn_readfirstlane(a[4]); }
    __device__ __forceinline__ bool next(int i, Unit& u) const { const int uid = vcu + i * G; if (uid >= ntile * 8) return false; u.pm = uid >> 3; u.pn = uid & 7;
        u.aux = i == 0 ? ax0 : (i == 1 ? ax1 : (i == 2 ? ax2 : (i == 3 ? ax3 : (i == 4 ? ax4 : __builtin_amdgcn_readfirstlane(tbk[u.pm]))))); return true; }
    __device__ __forceinline__ int arow(const Unit& u, int r) const { const int t = perm[u.pm * 256 + r]; return t < 0 ? 0 : t; }
    __device__ __forceinline__ int arow_raw(const Unit& u, int r) const { int v; const int* a = perm + u.pm * 256 + r; asm volatile("global_load_dword %0, %1, off" : "=v"(v) : "v"(a) : "memory"); return v; }
    __device__ __forceinline__ const char* aptr(const Unit&, int t) const { return H2 + (size_t)t * (BK * 2); }
    __device__ __forceinline__ const char* bptr(const Unit& u, int t) const { const int g = u.aux / 6; int a, b; pair_of2(u.aux % 6, a, b); const int e = g * 4 + (u.pn < 4 ? a : b);
        return W13 + ((size_t)e * 1024 + (size_t)(u.pn & 3) * 256) * (1024 * 2) + (size_t)t * (BK * 2); }
};
}

namespace ssd {
typedef __attribute__((address_space(3))) unsigned char LB;
typedef __attribute__((address_space(3))) const bf16x8 Lbf8;
typedef __attribute__((address_space(3))) const u32x2 Lu2;
typedef __attribute__((address_space(3))) const f32x4 Lf4;
typedef unsigned u32x2v __attribute__((ext_vector_type(2)));
constexpr int XT_P = 272, BS_P = 144;
constexpr int OFF_XT = 0, OFF_BS = 256 * XT_P, OFF_BST = OFF_BS + 128 * BS_P, OFF_CS = OFF_BST + 64 * XT_P, OFF_F = OFF_CS + 128 * BS_P;
constexpr int F_DT0 = OFF_F, F_DT1 = OFF_F + 2048, F_CUM = OFF_F + 4096, F_SUF = OFF_F + 6144, F_WF = OFF_F + 8192, F_WB = OFF_F + 10240, LDS_END = OFF_F + 12288;
static_assert(LDS_END <= 147456 - 256, "ssd chunk LDS");
__device__ __forceinline__ unsigned cvtpk(float lo, float hi) { return gm2::cvt_pk_bf16(lo, hi); }
__device__ __forceinline__ float wave_incl_scan(float v, int lane) {
#pragma unroll
    for (int o = 1; o < 64; o <<= 1) { const float t = __shfl_up(v, o); if (lane >= o) v += t; }
    return v;
}
__device__ __forceinline__ void chunk_phase(const Params& p, LB* lds_) {
    LB* const lds = (LB*)(size_t)0;
    (void)lds_;
    const int tid = tid_opaque(), lane = tid & 63, wid = __builtin_amdgcn_readfirstlane(tid >> 6), r32 = lane & 31, hh = lane >> 5;
    const bf16_t* XBC = (const bf16_t*)(p.ws + WS_XBC); const float* DT = (const float*)(p.ws + WS_DT);
    bf16_t* YD = (bf16_t*)(p.ws + WS_YD); bf16_t* CC = (bf16_t*)(p.ws + WS_CC); float* ACUM = (float*)(p.ws + WS_ACUM); float* ST = (float*)(p.ws + WS_ST);
    for (int item = blockIdx.x; item < BATCH * NCHUNK * SSD_G; item += gridDim.x) {
        const int g = item & 1, c = (item >> 1) % NCHUNK, b = item / (2 * NCHUNK);
        const int t0 = b * SEQ + c * CHUNK;
        __syncthreads();
        if (tid < 384) {
            const int grp = tid % 96, rq = tid / 96, cl = 4 * grp;
            const int ch = cl < 256 ? 256 * g + cl : (cl < 320 ? 512 + 64 * g + (cl - 256) : 640 + 64 * g + (cl - 320));
            float w[7][4], bias[4];
#pragma unroll
            for (int k = 0; k < 7; ++k) { const f32x4 t = *(const f32x4*)(p.conv_w + k * CONV_CH + ch); w[k][0] = t[0]; w[k][1] = t[1]; w[k][2] = t[2]; w[k][3] = t[3]; }
            { const f32x4 t = *(const f32x4*)(p.conv_b + ch); bias[0] = t[0]; bias[1] = t[1]; bias[2] = t[2]; bias[3] = t[3]; }
            const bool head_pad = (c == 0 && rq == 0), tail_pad = (c == NCHUNK - 1 && rq == 3);
            float win[7][4];
#pragma unroll
            for (int k = 0; k < 7; ++k) { win[k][0] = 0.f; win[k][1] = 0.f; win[k][2] = 0.f; win[k][3] = 0.f; }
            u32x2 vin[38];
#pragma unroll
            for (int r = 0; r < 38; ++r) {
                int pos = c * CHUNK + 32 * rq + r - 3; pos = pos < 0 ? 0 : (pos >= SEQ ? SEQ - 1 : pos);
                vin[r] = *(const u32x2*)(XBC + (size_t)(b * SEQ + pos) * CONV_CH + ch);
            }
            __builtin_amdgcn_sched_barrier(0);
#pragma unroll
            for (int r = 0; r < 38; ++r) {
                u32x2 v = vin[r];
                if (r < 3) { if (head_pad) v = (u32x2){0u, 0u}; }
                if (r >= 35) { if (tail_pad) v = (u32x2){0u, 0u}; }
#pragma unroll
                for (int k = 0; k < 6; ++k) { win[k][0] = win[k + 1][0]; win[k][1] = win[k + 1][1]; win[k][2] = win[k + 1][2]; win[k][3] = win[k + 1][3]; }
                win[6][0] = gm2::bflo(v.x); win[6][1] = gm2::bfhi(v.x); win[6][2] = gm2::bflo(v.y); win[6][3] = gm2::bfhi(v.y);
                if (r >= 6) {
                    const int i = 32 * rq + r - 6;
                    float o[4];
#pragma unroll
                    for (int e = 0; e < 4; ++e) { float a = bias[e];
#pragma unroll
                        for (int k = 0; k < 7; ++k) a += w[k][e] * win[k][e];
                        o[e] = gm2::silu_e(a); }
                    const unsigned p01 = cvtpk(o[0], o[1]), p23 = cvtpk(o[2], o[3]);
                    if (cl < 256) {
                        __attribute__((address_space(3))) unsigned short* d = (__attribute__((address_space(3))) unsigned short*)(lds + OFF_XT + cl * XT_P + i * 2);
                        d[0] = (unsigned short)p01; d[XT_P / 2] = (unsigned short)(p01 >> 16); d[XT_P] = (unsigned short)p23; d[3 * XT_P / 2] = (unsigned short)(p23 >> 16);
                    } else if (cl < 320) {
                        const int n = cl - 256;
                        *(__attribute__((address_space(3))) u32x2*)(lds + OFF_BS + i * BS_P + n * 2) = (u32x2){p01, p23};
                        __attribute__((address_space(3))) unsigned short* d = (__attribute__((address_space(3))) unsigned short*)(lds + OFF_BST + n * XT_P + i * 2);
                        d[0] = (unsigned short)p01; d[XT_P / 2] = (unsigned short)(p01 >> 16); d[XT_P] = (unsigned short)p23; d[3 * XT_P / 2] = (unsigned short)(p23 >> 16);
                    } else {
                        const int n = cl - 320;
                        *(__attribute__((address_space(3))) u32x2*)(lds + OFF_CS + i * BS_P + n * 2) = (u32x2){p01, p23};
                        *(u32x2*)(CC + (size_t)(t0 + i) * 128 + 64 * g + n) = (u32x2){p01, p23};
                    }
                }
            }
        } else {
            const int i = tid - 384;
            const f32x4 d0 = *(const f32x4*)(DT + (size_t)(t0 + i) * 16 + 4 * g), d1 = *(const f32x4*)(DT + (size_t)(t0 + i) * 16 + 8 + 4 * g);
#pragma unroll
            for (int hl = 0; hl < 4; ++hl) { *(__attribute__((address_space(3))) float*)(lds + F_DT0 + (hl * 128 + i) * 4) = d0[hl]; *(__attribute__((address_space(3))) float*)(lds + F_DT1 + (hl * 128 + i) * 4) = d1[hl]; }
        }
        __syncthreads();
        {
            const int hl = wid & 3, dir = wid >> 2, h = 4 * g + hl;
            const float a = -__expf(p.a_log[dir * 8 + h]);
            const int q0 = 2 * lane, q1 = 2 * lane + 1, i0 = dir ? 127 - q0 : q0, i1 = dir ? 127 - q1 : q1;
            const int fdt = dir ? F_DT1 : F_DT0;
            const float dt_0 = *(__attribute__((address_space(3))) const float*)(lds + fdt + (hl * 128 + i0) * 4), dt_1 = *(__attribute__((address_space(3))) const float*)(lds + fdt + (hl * 128 + i1) * 4);
            const float v0 = dt_0 * a, v1 = dt_1 * a, pr = v0 + v1;
            const float incl = wave_incl_scan(pr, lane), s0 = incl - pr + v0, s1 = incl;
            const float tot = __shfl(incl, 63);
            const int fs = dir ? F_SUF : F_CUM, fw = dir ? F_WB : F_WF;
            *(__attribute__((address_space(3))) float*)(lds + fs + (hl * 128 + i0) * 4) = s0; *(__attribute__((address_space(3))) float*)(lds + fs + (hl * 128 + i1) * 4) = s1;
            *(__attribute__((address_space(3))) float*)(lds + fw + (hl * 128 + i0) * 4) = __expf(tot - s0) * dt_0; *(__attribute__((address_space(3))) float*)(lds + fw + (hl * 128 + i1) * 4) = __expf(tot - s1) * dt_1;
            ACUM[(size_t)(t0 + i0) * 16 + dir * 8 + h] = s0; ACUM[(size_t)(t0 + i1) * 16 + dir * 8 + h] = s1;
        }
        __syncthreads();
        {
            const int it = wid & 3, hp = wid >> 2, i = it * 32 + r32;
            f32x16 Gt[4];
#pragma unroll
            for (int jt = 0; jt < 4; ++jt) {
                f32x16 acc = {0.f, 0.f, 0.f, 0.f, 0.f, 0.f, 0.f, 0.f, 0.f, 0.f, 0.f, 0.f, 0.f, 0.f, 0.f, 0.f};
#pragma unroll
                for (int ks = 0; ks < 4; ++ks) {
                    const bf16x8 af = *(Lbf8*)(lds + OFF_BS + (jt * 32 + r32) * BS_P + 32 * ks + 16 * hh);
                    const bf16x8 bfr = *(Lbf8*)(lds + OFF_CS + (it * 32 + r32) * BS_P + 32 * ks + 16 * hh);
                    acc = __builtin_amdgcn_mfma_f32_32x32x16_bf16(af, bfr, acc, 0, 0, 0);
                }
                Gt[jt] = acc;
            }
#pragma unroll
            for (int hs = 0; hs < 2; ++hs) {
                const int hl = 2 * hp + hs, h = 4 * g + hl;
                const float ci = *(__attribute__((address_space(3))) const float*)(lds + F_CUM + (hl * 128 + i) * 4), si = *(__attribute__((address_space(3))) const float*)(lds + F_SUF + (hl * 128 + i) * 4);
                f32x16 Y[2];
                Y[0] = (f32x16){0.f, 0.f, 0.f, 0.f, 0.f, 0.f, 0.f, 0.f, 0.f, 0.f, 0.f, 0.f, 0.f, 0.f, 0.f, 0.f}; Y[1] = Y[0];
#pragma unroll
                for (int jt = 0; jt < 4; ++jt) {
                    unsigned mt[8];
                    const int rel = jt < it ? 0 : (jt > it ? 1 : 2);
#pragma unroll
                    for (int q = 0; q < 4; ++q) {
                        const int jb = jt * 32 + 8 * q + 4 * hh;
                        float m[4];
                        if (rel == 0) {
                            const f32x4 cj = *(Lf4*)(lds + F_CUM + (hl * 128 + jb) * 4), d0 = *(Lf4*)(lds + F_DT0 + (hl * 128 + jb) * 4);
#pragma unroll
                            for (int e = 0; e < 4; ++e) m[e] = Gt[jt][4 * q + e] * (__expf(ci - cj[e]) * d0[e]);
                        } else if (rel == 1) {
                            const f32x4 sj = *(Lf4*)(lds + F_SUF + (hl * 128 + jb) * 4), d1 = *(Lf4*)(lds + F_DT1 + (hl * 128 + jb) * 4);
#pragma unroll
                            for (int e = 0; e < 4; ++e) m[e] = Gt[jt][4 * q + e] * (__expf(si - sj[e]) * d1[e]);
                        } else {
                            const f32x4 cj = *(Lf4*)(lds + F_CUM + (hl * 128 + jb) * 4), d0 = *(Lf4*)(lds + F_DT0 + (hl * 128 + jb) * 4);
                            const f32x4 sj = *(Lf4*)(lds + F_SUF + (hl * 128 + jb) * 4), d1 = *(Lf4*)(lds + F_DT1 + (hl * 128 + jb) * 4);
#pragma unroll
                            for (int e = 0; e < 4; ++e) {
                                const int dji = (8 * q + 4 * hh + e) - r32;
                                const float wf = __expf(fminf(ci - cj[e], 0.f)) * d0[e], wb = __expf(fminf(si - sj[e], 0.f)) * d1[e];
                                m[e] = Gt[jt][4 * q + e] * ((dji <= 0 ? wf : 0.f) + (dji >= 0 ? wb : 0.f));
                            }
                        }
                        mt[2 * q] = cvtpk(m[0], m[1]); mt[2 * q + 1] = cvtpk(m[2], m[3]);
                    }
#pragma unroll
                    for (int s = 0; s < 2; ++s) {
                        const bf16x8 mf = __builtin_bit_cast(bf16x8, (u32x4){mt[4 * s], mt[4 * s + 1], mt[4 * s + 2], mt[4 * s + 3]});
#pragma unroll
                        for (int pt = 0; pt < 2; ++pt) {
                            const LB* xa = lds + OFF_XT + (hl * 64 + pt * 32 + r32) * XT_P + (jt * 32 + 16 * s + 4 * hh) * 2;
                            const u32x2 lo = *(Lu2*)(xa), hi2 = *(Lu2*)(xa + 16);
                            const bf16x8 xf = __builtin_bit_cast(bf16x8, (u32x4){lo.x, lo.y, hi2.x, hi2.y});
                            Y[pt] = __builtin_amdgcn_mfma_f32_32x32x16_bf16(xf, mf, Y[pt], 0, 0, 0);
                        }
                    }
                }
                const float dsk = p.d_skip[h];
#pragma unroll
                for (int pt = 0; pt < 2; ++pt)
#pragma unroll
                    for (int qp = 0; qp < 2; ++qp) {
                        u32x2 g[2];
#pragma unroll
                        for (int qq = 0; qq < 2; ++qq) { const int q = 2 * qp + qq, p0 = pt * 32 + 8 * q + 4 * hh;
                            float y[4];
#pragma unroll
                            for (int e = 0; e < 4; ++e) { const float xv = bf2f(*(__attribute__((address_space(3))) const unsigned short*)(lds + OFF_XT + (hl * 64 + p0 + e) * XT_P + i * 2)); y[e] = Y[pt][4 * q + e] + dsk * xv; }
                            g[qq] = (u32x2){cvtpk(y[0], y[1]), cvtpk(y[2], y[3])}; }
                        auto r0 = __builtin_amdgcn_permlane32_swap(g[0].x, g[1].x, false, false); auto r1 = __builtin_amdgcn_permlane32_swap(g[0].y, g[1].y, false, false);
                        *(u32x4*)(YD + (size_t)(t0 + i) * 512 + h * 64 + pt * 32 + 16 * qp + 8 * hh) = (u32x4){(unsigned)r0[0], (unsigned)r1[0], (unsigned)r0[1], (unsigned)r1[1]};
                    }
            }
        }
        {
            const int hl = wid & 3, dir = wid >> 2, h = 4 * g + hl, fw = dir ? F_WB : F_WF;
            f32x16 S[2][2];
#pragma unroll
            for (int a = 0; a < 2; ++a)
#pragma unroll
                for (int bb = 0; bb < 2; ++bb) S[a][bb] = (f32x16){0.f, 0.f, 0.f, 0.f, 0.f, 0.f, 0.f, 0.f, 0.f, 0.f, 0.f, 0.f, 0.f, 0.f, 0.f, 0.f};
#pragma unroll 2
            for (int ks = 0; ks < 8; ++ks) {
                const f32x4 w0 = *(Lf4*)(lds + fw + (hl * 128 + 16 * ks + 8 * hh) * 4), w1 = *(Lf4*)(lds + fw + (hl * 128 + 16 * ks + 8 * hh + 4) * 4);
                bf16x8 bfr[2];
#pragma unroll
                for (int nt = 0; nt < 2; ++nt) bfr[nt] = *(Lbf8*)(lds + OFF_BST + (nt * 32 + r32) * XT_P + 32 * ks + 16 * hh);
#pragma unroll
                for (int pt = 0; pt < 2; ++pt) {
                    const u32x4 xr = *(__attribute__((address_space(3))) const u32x4*)(lds + OFF_XT + (hl * 64 + pt * 32 + r32) * XT_P + 32 * ks + 16 * hh);
                    const u32x4 xw = {cvtpk(gm2::bflo(xr.x) * w0[0], gm2::bfhi(xr.x) * w0[1]), cvtpk(gm2::bflo(xr.y) * w0[2], gm2::bfhi(xr.y) * w0[3]),
                                      cvtpk(gm2::bflo(xr.z) * w1[0], gm2::bfhi(xr.z) * w1[1]), cvtpk(gm2::bflo(xr.w) * w1[2], gm2::bfhi(xr.w) * w1[3])};
                    const bf16x8 af = __builtin_bit_cast(bf16x8, xw);
#pragma unroll
                    for (int nt = 0; nt < 2; ++nt) S[pt][nt] = __builtin_amdgcn_mfma_f32_32x32x16_bf16(bfr[nt], af, S[pt][nt], 0, 0, 0);
                }
            }
            bf16_t* dst = (bf16_t*)ST + ((((size_t)dir * BATCH + b) * NCHUNK + c) * 8 + h) * 4096;
#pragma unroll
            for (int pt = 0; pt < 2; ++pt)
#pragma unroll
                for (int nt = 0; nt < 2; ++nt)
#pragma unroll
                    for (int gp = 0; gp < 2; ++gp) { u32x2 g[2];
#pragma unroll
                        for (int gg = 0; gg < 2; ++gg) { const int b4 = 4 * (2 * gp + gg); g[gg] = (u32x2){cvtpk(S[pt][nt][b4], S[pt][nt][b4 + 1]), cvtpk(S[pt][nt][b4 + 2], S[pt][nt][b4 + 3])}; }
                        auto r0 = __builtin_amdgcn_permlane32_swap(g[0].x, g[1].x, false, false); auto r1 = __builtin_amdgcn_permlane32_swap(g[0].y, g[1].y, false, false);
                        *(u32x4*)(dst + (pt * 32 + r32) * 64 + nt * 32 + 16 * gp + 8 * hh) = (u32x4){(unsigned)r0[0], (unsigned)r1[0], (unsigned)r0[1], (unsigned)r1[1]}; }
        }
    }
}

constexpr int VT_P = 1040;
constexpr int OFF_VT = 0, OFF_SS = 128 * VT_P, OFF_EF = OFF_SS + 8 * 128 * 4, FIN_END = OFF_EF + 2 * 8 * 128 * 4;
static_assert(FIN_END <= 147456 - 256, "ssd final LDS");
__device__ __forceinline__ void final_phase(const Params& p, LB* lds_) {
    LB* const lds = (LB*)(size_t)0; (void)lds_;
    const int tid = tid_opaque(), lane = tid & 63, h = __builtin_amdgcn_readfirstlane(tid >> 6), r32 = lane & 31, hh = lane >> 5, g = h >> 2;
    const bf16_t* YD = (const bf16_t*)(p.ws + WS_YD); const bf16_t* CC = (const bf16_t*)(p.ws + WS_CC); const float* ACUM = (const float*)(p.ws + WS_ACUM); const float* ST = (const float*)(p.ws + WS_ST);
    const bf16_t* Z = (const bf16_t*)(p.ws + WS_Z); bf16_t* SSD = (bf16_t*)(p.ws + WS_SSD);
    typedef __attribute__((address_space(3))) float LF;
    for (int item = blockIdx.x; item < BATCH * NCHUNK; item += gridDim.x) {
        const int c = item % NCHUNK, b = item / NCHUNK, t0 = b * SEQ + c * CHUNK;
        __syncthreads();
        float ac[2][2];
#pragma unroll
        for (int q = 0; q < 2; ++q) { const int i = lane + 64 * q; ac[q][0] = ACUM[(size_t)(t0 + i) * 16 + h]; ac[q][1] = ACUM[(size_t)(t0 + i) * 16 + 8 + h]; }
        bf16x8 cf[2][2][4];
#pragma unroll
        for (int dir = 0; dir < 2; ++dir) { const bf16_t* cs = (const bf16_t*)ST + ((((size_t)dir * BATCH + b) * NCHUNK + c) * 8 + h) * 4096;
#pragma unroll
            for (int pt = 0; pt < 2; ++pt)
#pragma unroll
                for (int ks = 0; ks < 4; ++ks) cf[dir][pt][ks] = *(const bf16x8*)(cs + (pt * 32 + r32) * 64 + 16 * ks + 8 * hh); }
#pragma unroll 1
        for (int it = 0; it < 4; ++it) {
            f32x16 A[2][2];
#pragma unroll
            for (int dir = 0; dir < 2; ++dir)
#pragma unroll
                for (int pt = 0; pt < 2; ++pt) A[dir][pt] = (f32x16){0.f, 0.f, 0.f, 0.f, 0.f, 0.f, 0.f, 0.f, 0.f, 0.f, 0.f, 0.f, 0.f, 0.f, 0.f, 0.f};
            bf16x8 afr[4]; unsigned short ydv[16][2], zv[16][2];
#pragma unroll
            for (int ks = 0; ks < 4; ++ks) afr[ks] = *(const bf16x8*)(CC + (size_t)(t0 + it * 32 + r32) * 128 + g * 64 + 16 * ks + 8 * hh);
#pragma unroll
            for (int rg = 0; rg < 16; ++rg) { const size_t t = (size_t)(t0 + it * 32 + (rg & 3) + 8 * (rg >> 2) + 4 * hh);
#pragma unroll
                for (int pt = 0; pt < 2; ++pt) { const int col = h * 64 + pt * 32 + r32; ydv[rg][pt] = YD[t * 512 + col]; zv[rg][pt] = Z[t * 512 + col]; } }
            __builtin_amdgcn_sched_barrier(0);
            if (it == 0) {
#pragma unroll
                for (int q = 0; q < 2; ++q) { const int i = lane + 64 * q; asm volatile("" : "+v"(ac[q][0]), "+v"(ac[q][1]));
                    *(LF*)(lds + OFF_EF + ((0 * 8 + h) * 128 + i) * 4) = __expf(ac[q][0]);
                    *(LF*)(lds + OFF_EF + ((1 * 8 + h) * 128 + i) * 4) = __expf(ac[q][1]); }
                asm volatile("s_waitcnt lgkmcnt(0)" ::: "memory");
            }
#pragma unroll
            for (int ks = 0; ks < 4; ++ks) {
#pragma unroll
                for (int dir = 0; dir < 2; ++dir)
#pragma unroll
                    for (int pt = 0; pt < 2; ++pt) A[dir][pt] = __builtin_amdgcn_mfma_f32_32x32x16_bf16(afr[ks], cf[dir][pt][ks], A[dir][pt], 0, 0, 0); }
#pragma unroll
            for (int rg = 0; rg < 16; ++rg) {
                const int i = it * 32 + (rg & 3) + 8 * (rg >> 2) + 4 * hh;
                const float ef = *(LF*)(lds + OFF_EF + ((0 * 8 + h) * 128 + i) * 4), eb = *(LF*)(lds + OFF_EF + ((1 * 8 + h) * 128 + i) * 4);
                float ss = 0.f;
#pragma unroll
                for (int pt = 0; pt < 2; ++pt) { const int col = h * 64 + pt * 32 + r32;
                    const float y = (bf2f(ydv[rg][pt]) + A[0][pt][rg] * ef + A[1][pt][rg] * eb) * bf2f(zv[rg][pt]);
                    ss += y * y;
                    *(__attribute__((address_space(3))) unsigned short*)(lds + OFF_VT + i * VT_P + col * 2) = (unsigned short)f2bf(y); }
                ss = half32_sum(ss);
                if (r32 == 0) *(LF*)(lds + OFF_SS + (h * 128 + i) * 4) = ss;
            }
        }
        __syncthreads();
        const f32x4 w0 = *(const f32x4*)(p.ssd_norm_w + lane * 8), w1 = *(const f32x4*)(p.ssd_norm_w + lane * 8 + 4);
#pragma unroll 4
        for (int q = 0; q < 16; ++q) {
            const int i = h * 16 + q;
            float tot = 0.f;
#pragma unroll
            for (int k = 0; k < 8; ++k) tot += *(LF*)(lds + OFF_SS + (k * 128 + i) * 4);
            const float rstd = 1.f / sqrtf(tot * (1.f / 512.f) + EPS);
            const u32x4 v = *(__attribute__((address_space(3))) const u32x4*)(lds + OFF_VT + i * VT_P + lane * 16);
            u32x4 o; o.x = cvtpk(gm2::bflo(v.x) * rstd * w0[0], gm2::bfhi(v.x) * rstd * w0[1]); o.y = cvtpk(gm2::bflo(v.y) * rstd * w0[2], gm2::bfhi(v.y) * rstd * w0[3]);
            o.z = cvtpk(gm2::bflo(v.z) * rstd * w1[0], gm2::bfhi(v.z) * rstd * w1[1]); o.w = cvtpk(gm2::bflo(v.w) * rstd * w1[2], gm2::bfhi(v.w) * rstd * w1[3]);
            *(u32x4*)(SSD + (size_t)(t0 + i) * 512 + lane * 8) = o;
        }
    }
}
}
#ifndef NAIVE_SSDC
#define NAIVE_SSDC 0
#endif
#ifndef NAIVE_SSDF
#define NAIVE_SSDF 0
#endif
#ifndef NAIVE_P1
#define NAIVE_P1 0
#endif
#ifndef NAIVE_P4B
#define NAIVE_P4B 0
#endif
#ifndef NAIVE_P4C
#define NAIVE_P4C 0
#endif
#ifndef NAIVE_P6
#define NAIVE_P6 0
#endif
#ifndef NAIVE_P7
#define NAIVE_P7 0
#endif
__device__ __forceinline__ int vcu_of() { const int G = gridDim.x, bx = blockIdx.x; return (G % 8 == 0) ? (bx % 8) * (G / 8) + bx / 8 : bx; }
#if USE_PG8
#define GNS pg8
#define GEMM_CALL(EPI, SCHED, K, RX) pg8::gemm_phase<pg8::EPI, pg8::SCHED, true, true, RX>(lds3, K, S, E)
#else
#define GNS gm2
#define GEMM_CALL(EPI, SCHED, K, RX) gm2::gemm_phase<gm2::EPI, gm2::SCHED>(lds3, K, S, E)
#endif
__device__ __forceinline__ void phase_p1_pg8(const Params& p, PG8_LAS unsigned char* lds3) {
#if USE_PG8
    pg8::SchedProj S; S.so.init(T, 4096, gridDim.x, blockIdx.x); S.A = (const char*)wsp<bf16_t>(p, WS_H); S.B = (const char*)wsp<bf16_t>(p, WS_WIN); S.tstep = (size_t)256 * DM * 2;
#else
    gm2::SchedProj S{vcu_of(), (int)gridDim.x, (const char*)wsp<bf16_t>(p, WS_H), (const char*)wsp<bf16_t>(p, WS_WIN), (size_t)256 * DM * 2};
#endif
#if USE_PG8
    pg8::EpiInProj E{wsp<bf16_t>(p, WS_QO), wsp<bf16_t>(p, WS_K), wsp<bf16_t>(p, WS_V), wsp<bf16_t>(p, WS_Z), wsp<bf16_t>(p, WS_XBC), wsp<bf16_t>(p, WS_G), wsp<float>(p, WS_DT), p.b_gate, p.dt_bias};
#else
    gm2::EpiInProj E{p.ws, p.b_gate};
#endif
    GEMM_CALL(EpiInProj, SchedProj, DM, RELAX_P1);
}
__device__ __forceinline__ void phase_merged_pg8(const Params& p, PG8_LAS unsigned char* lds3) {
#if USE_PG8
    pg8::SchedMerged2 S{vcu_of(), (int)gridDim.x, (const char*)wsp<bf16_t>(p, WS_QO), (const char*)wsp<bf16_t>(p, WS_SSD), (const char*)wsp<bf16_t>(p, WS_WA), (const char*)wsp<bf16_t>(p, WS_WS), (size_t)256 * 512 * 2};
    pg8::EpiMerged2 E{(const unsigned char*)(p.ws + WS_G), wsp<bf16_t>(p, WS_MERGED)};
    pg8::gemm_phase2<pg8::EpiMerged2, pg8::SchedMerged2, true, true, false, RELAX_MERGED>(lds3, 512, 512, 16, S, E);
#else
    GNS::SchedMerged S{vcu_of(), (int)gridDim.x, (const char*)wsp<bf16_t>(p, WS_SSD), (const char*)wsp<bf16_t>(p, WS_QO), (const char*)wsp<bf16_t>(p, WS_WS), (const char*)wsp<bf16_t>(p, WS_WA), (size_t)256 * 512 * 2};
    GNS::EpiMerged E{wsp<bf16_t>(p, WS_G), wsp<bf16_t>(p, WS_MERGED)};
    GEMM_CALL(EpiMerged, SchedMerged, 512, false);
#endif
}
__device__ __forceinline__ void phase_wout_pg8(const Params& p, PG8_LAS unsigned char* lds3) {
    GNS::SchedWout S{vcu_of(), (int)gridDim.x, (const char*)wsp<bf16_t>(p, WS_MERGED), (const char*)wsp<bf16_t>(p, WS_WO), (size_t)256 * DM * 2};
#if USE_PG8
    pg8::EpiWout E{p.x, wsp<bf16_t>(p, WS_X1B)};
#else
    gm2::EpiWout E{p.x, p.out};
#endif
    GEMM_CALL(EpiWout, SchedWout, DM, RELAX_WOUT);
}
__device__ __forceinline__ int phase_moe1_pg8(const Params& p, PG8_LAS unsigned char* lds3) {
    const int* tbk = (const int*)(p.ws + WS_ROUTE + RT_TB);
#if USE_PG8 && FUSE_GATHER
    pg8::SchedMoe1g S{vcu_of(), (int)gridDim.x, 0, tbk, (const int*)(p.ws + WS_ROUTE + RT_PERM), (const char*)wsp<bf16_t>(p, WS_X1B), (const char*)wsp<bf16_t>(p, WS_W13), 0, 0, 0, 0, 0}; S.preload();
    pg8::EpiMoe1 E{wsp<bf16_t>(p, WS_HID), (const float*)(p.ws + WS_ROUTE + RT_SWA), (const float*)(p.ws + WS_ROUTE + RT_SWB), (const float*)(p.ws + WS_ROUTE + RT_SRS)};
    pg8::gemm_phase2<pg8::EpiMoe1, pg8::SchedMoe1g, true, true, true, RELAX_MOE1>(lds3, DM, DM, 16, S, E);
    return S.ntile;
#else
    GNS::SchedMoe1 S{vcu_of(), (int)gridDim.x, __builtin_amdgcn_readfirstlane(tbk[TS / 256]), tbk, (const char*)wsp<bf16_t>(p, WS_XS), (const char*)wsp<bf16_t>(p, WS_W13), (size_t)256 * DM * 2};
    GNS::EpiMoe1 E{wsp<bf16_t>(p, WS_HID), (const float*)(p.ws + WS_ROUTE + RT_SWA), (const float*)(p.ws + WS_ROUTE + RT_SWB)};
    GEMM_CALL(EpiMoe1, SchedMoe1, DM, false);
    return S.ntile;
#endif
}
__device__ __forceinline__ void phase_moe2_pg8(const Params& p, PG8_LAS unsigned char* lds3, const int ntile_) {
    const int* tbk = (const int*)(p.ws + WS_ROUTE + RT_TB);
#if USE_PG8
    pg8::SchedMoe2b S{vcu_of(), (int)gridDim.x, ntile_, tbk, (const char*)wsp<bf16_t>(p, WS_HID), (const char*)wsp<bf16_t>(p, WS_W2P), (size_t)256 * 1024 * 2, 0, 0, 0, 0}; S.preload();
    pg8::EpiMoe2 E{p.out, (const int*)(p.ws + WS_ROUTE + RT_PERM), wsp<bf16_t>(p, WS_X1B)};
    pg8::gemm_phase2<pg8::EpiMoe2, pg8::SchedMoe2b, true, true, false, RELAX_MOE2>(lds3, 1024, 512, 16, S, E);
#else
    GNS::SchedMoe2 S{vcu_of(), (int)gridDim.x, __builtin_amdgcn_readfirstlane(tbk[TS / 256]), tbk, (const char*)wsp<bf16_t>(p, WS_HID), (const char*)wsp<bf16_t>(p, WS_W2P), (size_t)256 * 1024 * 2};
    GNS::EpiMoe2 E{p.out, (const int*)(p.ws + WS_ROUTE + RT_PERM)};
    GEMM_CALL(EpiMoe2, SchedMoe2, 1024, false);
#endif
}

__device__ __forceinline__ void phase_tr_w13(const Params& p, unsigned char* lds) {
    const int tid = tid_opaque(), lane = tid & 63, wave = tid >> 6;
    phase_tr_range(p, (float*)lds + wave * (64 * 33), lane, TR_EARLY, TR_W2, (int)blockIdx.x * 8 + wave, (int)gridDim.x * 8);
    __syncthreads();
}
__device__ __forceinline__ void phase_tr_w2(const Params& p, unsigned char* lds, const int ntile) {
    const int tid = tid_opaque(), lane = tid & 63, wave = tid >> 6;
    const int* tbk = (const int*)(p.ws + WS_ROUTE + RT_TB);
    const int G = (int)gridDim.x, rot = (ntile * 8) % G, vcu = vcu_of();
    if (vcu >= rot) phase_tr_range(p, (float*)lds + wave * (64 * 33), lane, TR_W2, TR_TOTAL, (vcu - rot) * 8 + wave, (G - rot) * 8);
}
constexpr int LDS_BYTES = 147456;
__global__ void __launch_bounds__(512, 2) k_mega(Params p) {
    extern __shared__ __attribute__((aligned(16))) unsigned char lds[];
    PG8_LAS unsigned char* lds3 = (PG8_LAS unsigned char*)lds;
    volatile LAS unsigned* MISC = (volatile LAS unsigned*)(lds3 + MISC_OFF);
    if (threadIdx.x < 64) MISC[threadIdx.x] = 0u;
    __syncthreads();
    XcdBarrier bar = xcd_barrier_post((unsigned*)(p.ws + WS_CTL) + CW_BAR, MISC + 8);
#define GRID_BAR() xcd_barrier(bar)
#if BARRIER_WORK
#define GRID_BAR_W(k) xcd_barrier_work(bar, p, lds, TR_WIN + (k) * 1152, TR_WIN + ((k) + 1) * 1152)
#else
#define GRID_BAR_W(k) xcd_barrier(bar)
#endif
    phase_p0(p, lds); GRID_BAR_W(0);
#if NAIVE_P1
    phase_p1(p);
#else
    phase_p1_pg8(p, lds3); phase_dt(p, lds);
#endif
    GRID_BAR_W(1);
    phase_rope(p);
#if NAIVE_SSDC
    phase_ssd_chunk_naive(p, lds);
#else
    ssd::chunk_phase(p, (ssd::LB*)lds);
#endif
    GRID_BAR_W(2);
#if !BARRIER_WORK
    phase_scan(p);
#endif
#if NAIVE_ATTN
    phase_attn_naive(p);
#else
    phase_attn(p, lds);
#endif
    GRID_BAR_W(3);
#if NAIVE_SSDF
    phase_ssd_final_naive(p, lds);
#else
    ssd::final_phase(p, (ssd::LB*)lds);
#endif
    GRID_BAR_W(4);
#if NAIVE_P4B
    phase_merged_naive(p);
#else
    phase_merged_pg8(p, lds3);
#endif
    GRID_BAR_W(5);
#if NAIVE_P4C
    phase_wout_naive(p);
#else
    phase_wout_pg8(p, lds3);
#endif
    GRID_BAR_W(6);
    phase_route(p, lds); GRID_BAR_W(7);
    phase_gather(p, lds); GRID_BAR();
#if NAIVE_P6
    phase_moe1_naive(p);
#else
    const int ntile_s = phase_moe1_pg8(p, lds3);
#endif
    phase_tr_w2(p, lds, ntile_s);
    GRID_BAR();
#if NAIVE_P7
    phase_moe2_naive(p);
#else
    phase_moe2_pg8(p, lds3, ntile_s);
#endif
}

extern "C" void kernel_launch(void* const* d_in, const int* in_sizes, int n_in, void* d_out, int out_size, void* d_ws, size_t ws_size, hipStream_t stream) {
    if (n_in != 23 || out_size != T * DM || ws_size < WS_END) { fprintf(stderr, "kernel_launch: unexpected shapes (n_in %d out %d ws %zu need %zu)\n", n_in, out_size, ws_size, (size_t)WS_END); return; }
    Params p{};
    const float** f = (const float**)&p;
    for (int i = 0; i < 23; ++i) f[i] = (const float*)d_in[i];
    p.out = (float*)d_out; p.ws = (unsigned char*)d_ws;
    static int grid_blocks = 0;
    if (!grid_blocks) {
        int dev = 0, cus = 0, per_cu = 0;
        (void)hipGetDevice(&dev); (void)hipDeviceGetAttribute(&cus, hipDeviceAttributeMultiprocessorCount, dev);
        (void)hipFuncSetAttribute((const void*)k_mega, hipFuncAttributeMaxDynamicSharedMemorySize, LDS_BYTES);
        (void)hipOccupancyMaxActiveBlocksPerMultiprocessor(&per_cu, (const void*)k_mega, 512, LDS_BYTES);
        if (per_cu < 1) { fprintf(stderr, "kernel_launch: occupancy query says %d blocks/CU\n", per_cu); per_cu = 1; }
        grid_blocks = cus * 1;
        fprintf(stderr, "kernel_launch: cus %d per_cu %d grid %d\n", cus, per_cu, grid_blocks);
    }
    (void)hipMemsetAsync((char*)d_ws + WS_CTL, 0, 32 * 1024, stream);
    void* args[] = {&p};
    hipError_t e = hipLaunchCooperativeKernel((const void*)k_mega, dim3(grid_blocks), dim3(512), args, LDS_BYTES, stream);
    if (e != hipSuccess) fprintf(stderr, "cooperative launch failed: %s (grid %d)\n", hipGetErrorString(e), grid_blocks);
}
```
